# Optimizing an MI355X kernel written in HIP

```python
import jax
import jax.numpy as jnp
from jax import lax
import numpy as np

D_MODEL = 1024
BATCH = 4
SEQ = 8192
DEPTH = 4

GRID_W = 64
CTX_LEN = 256
N_BRANCH = 4
BRANCH_W = D_MODEL // 2
CONV_W = 3
MLSTM_HEADS = 4
MLSTM_HD = BRANCH_W // MLSTM_HEADS
MLSTM_CHUNK = 64
POOL_WINDOWS = (2, 4, 8, 16)
POOL_GW = BRANCH_W // len(POOL_WINDOWS)
ATT_HEAD_DIM = 64
ATT_Q_HEADS = BRANCH_W // ATT_HEAD_DIM
ATT_KV_HEADS = 2
ATT_WINDOW = 128
ATT_BLOCK = 128
ROPE_BASE = 10000.0
SC_W = BRANCH_W
D_FF = 2816
EPS = 1e-6

SPLITS = (BRANCH_W, BRANCH_W, BRANCH_W, BRANCH_W, 4 * MLSTM_HEADS,
          BRANCH_W,
          ATT_Q_HEADS * ATT_HEAD_DIM, ATT_KV_HEADS * ATT_HEAD_DIM, ATT_KV_HEADS * ATT_HEAD_DIM,
          SC_W, SC_W, SC_W,
          N_BRANCH * D_MODEL)
IN_WIDTH = sum(SPLITS)

kernel_name = 'hybrid_mlstm_pool_swa_conv_diffusion_block'


def split_cols(p):
    idx, acc = [], 0
    for w in SPLITS[:-1]:
        acc += w
        idx.append(acc)
    return jnp.split(p, idx, axis=-1)


def rmsnorm(x, g):
    xf = x.astype(jnp.float32)
    y = xf * lax.rsqrt(jnp.mean(xf * xf, axis=-1, keepdims=True) + EPS)
    return (y * g.astype(jnp.float32)).astype(x.dtype)


def modulate(h, shift, scale):
    return h * (1 + scale) + shift


def dwconv3(x, w):
    xp = jnp.pad(x, ((0, 0), (1, 1), (0, 0)))
    return xp[:, :-2] * w[0] + xp[:, 1:-1] * w[1] + xp[:, 2:] * w[2]


def axial_rope_tables(rows):
    row = jnp.repeat(jnp.arange(rows), GRID_W)
    col = jnp.tile(jnp.arange(GRID_W), rows)
    n_freq = ATT_HEAD_DIM // 4
    inv_freq = ROPE_BASE ** (-jnp.arange(n_freq, dtype=jnp.float32) / n_freq)
    ang = jnp.stack([row, col], axis=-1).astype(jnp.float32)[:, :, None] * inv_freq
    return jnp.cos(ang), jnp.sin(ang)


def apply_axial_rope(x, cos, sin):
    B, S, H, dh = x.shape
    xf = x.astype(jnp.float32).reshape(B, S, H, 2, 2, dh // 4)
    x1, x2 = xf[..., 0, :], xf[..., 1, :]
    c, s = cos[:, None], sin[:, None]
    out = jnp.stack([x1 * c - x2 * s, x1 * s + x2 * c], axis=-2)
    return out.reshape(B, S, H, dh).astype(x.dtype)


def mlstm_chunkwise(q, k, v, ig, lf, state):
    B, H, T, Dh = q.shape
    nc = T // MLSTM_CHUNK

    def chunks(a):
        return jnp.moveaxis(a.reshape(B, H, nc, MLSTM_CHUNK, *a.shape[3:]), 2, 0)

    tri = jnp.tril(jnp.ones((MLSTM_CHUNK, MLSTM_CHUNK), dtype=bool))

    def step(carry, inp):
        C, n, m = carry
        qc, kc, vc, ic, fc = inp
        b = jnp.cumsum(fc, axis=-1)
        a = b + m[..., None]
        dmat = jnp.where(tri, b[..., :, None] - b[..., None, :] + ic[..., None, :], -jnp.inf)
        mt = jnp.maximum(a, dmat.max(-1))
        inter = jnp.exp(a - mt)
        s = jnp.einsum('bhtd,bhsd->bhts', qc, kc) * jnp.exp(dmat - mt[..., None])
        num = jnp.einsum('bhts,bhsd->bhtd', s, vc) + inter[..., None] * jnp.einsum('bhtk,bhkv->bhtv', qc, C)
        den = s.sum(-1) + inter * jnp.einsum('bhtk,bhk->bht', qc, n)
        h = num / jnp.maximum(jnp.abs(den), jnp.exp(-mt))[..., None]
        m_new = mt[..., -1]
        decay = jnp.exp(b[..., -1] + m - m_new)
        wk = jnp.exp(b[..., -1:] - b + ic - m_new[..., None])
        C_new = decay[..., None, None] * C + jnp.einsum('bhs,bhsk,bhsv->bhkv', wk, kc, vc)
        n_new = decay[..., None] * n + jnp.einsum('bhs,bhsk->bhk', wk, kc)
        return (C_new, n_new, m_new), h

    state, hs = lax.scan(step, state, tuple(chunks(a) for a in (q, k, v, ig, lf)))
    return jnp.moveaxis(hs, 0, 2).reshape(B, H, T, Dh), state


def mlstm_inputs(q, k, v, g, qk_conv, gate_bias):
    B, T, _ = q.shape
    H, Dh = MLSTM_HEADS, MLSTM_HD
    qk = jax.nn.silu(dwconv3(jnp.concatenate([q, k], axis=-1), qk_conv)).astype(jnp.float32)
    heads = lambda a: a.reshape(B, T, H, Dh).transpose(0, 2, 1, 3)
    qh = heads(qk[..., :BRANCH_W])
    kh = heads(qk[..., BRANCH_W:]) * Dh ** -0.5
    vh = heads(v.astype(jnp.float32))
    gp = (g.astype(jnp.float32).reshape(B, T, 4, H) + gate_bias.astype(jnp.float32)).transpose(2, 0, 3, 1)
    return qh, kh, vh, gp[0:2], jax.nn.log_sigmoid(gp[2:4])


def mlstm_bidir(xin, cin, ctx_out):
    qx, kx, vx, ix, fx = xin
    qc, kc, vc, ic, fc = cin
    B, H, _, Dh = qx.shape
    zero = (jnp.zeros((B, H, Dh, Dh), jnp.float32), jnp.zeros((B, H, Dh), jnp.float32), jnp.zeros((B, H), jnp.float32))
    rev = lambda a: jnp.flip(a, axis=2)
    hc_f, st_f = mlstm_chunkwise(qc, kc, vc, ic[0], fc[0], zero)
    hc_b, st_b = mlstm_chunkwise(rev(qc), rev(kc), rev(vc), rev(ic[1]), rev(fc[1]), zero)
    hx_f, _ = mlstm_chunkwise(qx, kx, vx, ix[0], fx[0], st_f)
    hx_b, _ = mlstm_chunkwise(rev(qx), rev(kx), rev(vx), rev(ix[1]), rev(fx[1]), st_b)
    merge_heads = lambda a: a.transpose(0, 2, 1, 3).reshape(a.shape[0], a.shape[2], -1)
    hx = merge_heads(hx_f + rev(hx_b))
    hc = merge_heads(hc_f + rev(hc_b)) if ctx_out else None
    return hx, hc


def multiscale_pool(p, w_pool, scale):
    B, T, _ = p.shape
    G = len(POOL_WINDOWS)
    pf = p.astype(jnp.float32).reshape(B, T, G, POOL_GW)
    cs = jnp.pad(jnp.cumsum(pf, axis=1), ((0, 0), (1, 0), (0, 0), (0, 0)))
    half = jnp.array(POOL_WINDOWS) // 2
    t = jnp.arange(T)[:, None]
    lo = jnp.clip(t - half, 0, T)
    hi = jnp.clip(t + half, 0, T)
    g = jnp.arange(G)[None, :]
    mean = (cs[:, hi, g] - cs[:, lo, g]) / (hi - lo).astype(jnp.float32)[..., None]
    y = jnp.einsum('btgc,gcd->btgd', mean - pf, w_pool.astype(jnp.float32))
    return (y.reshape(B, T, -1) * scale.astype(jnp.float32)).astype(p.dtype)


def window_attention(q, k, v, k_ctx, v_ctx, sink):
    B, S, G, R, dh = q.shape
    nb = S // ATT_BLOCK
    scale = dh ** -0.5
    qb = q.reshape(B, nb, ATT_BLOCK, G, R, dh)

    def band(a):
        ab = jnp.pad(a.reshape(B, nb, ATT_BLOCK, G, dh), ((0, 0), (1, 1), (0, 0), (0, 0), (0, 0)))
        return jnp.concatenate([ab[:, :-2], ab[:, 1:-1], ab[:, 2:]], axis=2)

    kb, vb = band(k), band(v)
    blk = jnp.arange(nb)[:, None]
    qpos = blk * ATT_BLOCK + jnp.arange(ATT_BLOCK)[None]
    kpos = (blk - 1) * ATT_BLOCK + jnp.arange(3 * ATT_BLOCK)[None]
    valid = (jnp.abs(qpos[:, :, None] - kpos[:, None, :]) <= ATT_WINDOW) & ((kpos >= 0) & (kpos < S))[:, None, :]
    s_loc = jnp.einsum('bnqgrd,bnkgd->bngrqk', qb, kb).astype(jnp.float32) * scale
    s_loc = jnp.where(valid[None, :, None, None], s_loc, -jnp.inf)
    s_ctx = jnp.einsum('bnqgrd,blgd->bngrql', qb, k_ctx).astype(jnp.float32) * scale
    sk = sink.astype(jnp.float32).reshape(1, 1, G, R, 1)
    m = jnp.maximum(jnp.maximum(s_loc.max(-1), s_ctx.max(-1)), sk)
    e_loc = jnp.exp(s_loc - m[..., None])
    e_ctx = jnp.exp(s_ctx - m[..., None])
    den = e_loc.sum(-1) + e_ctx.sum(-1) + jnp.exp(sk - m)
    o = (jnp.einsum('bngrqk,bnkgd->bnqgrd', e_loc, vb.astype(jnp.float32))
         + jnp.einsum('bngrql,blgd->bnqgrd', e_ctx, v_ctx.astype(jnp.float32)))
    o = o / jnp.moveaxis(den, -1, 2)[..., None]
    return o.reshape(B, S, G * R * dh).astype(q.dtype)


def context_attention(q, k, v, sink):
    B, L, G, R, dh = q.shape
    s = jnp.einsum('blgrd,bmgd->bgrlm', q, k).astype(jnp.float32) * dh ** -0.5
    sk = jnp.broadcast_to(sink.astype(jnp.float32).reshape(1, G, R, 1, 1), s.shape[:-1] + (1,))
    p = jax.nn.softmax(jnp.concatenate([sk, s], axis=-1), axis=-1)[..., 1:]
    o = jnp.einsum('bgrlm,bmgd->blgrd', p, v.astype(jnp.float32))
    return o.reshape(B, L, G * R * dh).astype(q.dtype)


def merge_branches(p, h_mlstm, y_att, pool_w, pool_scale, sconv_w, w_branch, w_out):
    B, T, _ = h_mlstm.shape
    ya = (jax.nn.sigmoid(p[3]) * h_mlstm).astype(p[3].dtype)
    yb = multiscale_pool(p[5], pool_w, pool_scale)
    yd = p[9] * dwconv3(p[10] * p[11], sconv_w)
    ys = jnp.stack([ya, yb, y_att, yd], axis=2)
    proj = jnp.einsum('btnw,nwd->btnd', ys, w_branch)
    gates = jax.nn.sigmoid(p[12].reshape(B, T, N_BRANCH, -1))
    return jnp.einsum('btnd,btnd->btd', gates, proj) @ w_out


def token_mixers(ux, uc, w_in, qk_conv, gate_bias, pool_w, pool_scale, sink, sconv_w, w_branch, w_out, rope, ctx_out):
    B, S, _ = ux.shape
    L = uc.shape[1]
    px = split_cols(ux @ w_in)
    pc = split_cols(uc @ w_in)
    hx, hc = mlstm_bidir(mlstm_inputs(px[0], px[1], px[2], px[4], qk_conv, gate_bias),
                         mlstm_inputs(pc[0], pc[1], pc[2], pc[4], qk_conv, gate_bias), ctx_out)
    G, R, dh = ATT_KV_HEADS, ATT_Q_HEADS // ATT_KV_HEADS, ATT_HEAD_DIM
    k_ctx = pc[7].reshape(B, L, G, dh)
    v_ctx = pc[8].reshape(B, L, G, dh)
    q_x = apply_axial_rope(px[6].reshape(B, S, G * R, dh), *rope).reshape(B, S, G, R, dh)
    k_x = apply_axial_rope(px[7].reshape(B, S, G, dh), *rope)
    att_x = window_attention(q_x, k_x, px[8].reshape(B, S, G, dh), k_ctx, v_ctx, sink)
    out_x = merge_branches(px, hx, att_x, pool_w, pool_scale, sconv_w, w_branch, w_out)
    if not ctx_out:
        return out_x, None
    att_c = context_attention(pc[6].reshape(B, L, G, R, dh), k_ctx, v_ctx, sink)
    out_c = merge_branches(pc, hc, att_c, pool_w, pool_scale, sconv_w, w_branch, w_out)
    return out_x, out_c


def conv_ffn(u, w_up, w_conv, w_down):
    a = dwconv3(u @ w_up, w_conv)
    gate, val = jnp.split(a, 2, axis=-1)
    return (jax.nn.silu(gate) * val) @ w_down


def setup_inputs(seed: int = 0) -> dict:
    key = jax.random.key(seed)
    ks = jax.random.split(key, 20)
    D = D_MODEL
    nrm = lambda k, shape, s: jax.random.normal(k, shape, jnp.float32) * s
    x = nrm(ks[0], (BATCH, SEQ, D), 1.0)
    c = nrm(ks[1], (BATCH, D), 1.0)
    ctx = nrm(ks[2], (BATCH, CTX_LEN, D), 1.0)
    c_ctx = nrm(ks[3], (D,), 1.0)
    w_mod = nrm(ks[4], (DEPTH, D, 6 * D), 0.5 * D ** -0.5)
    b_mod = nrm(ks[5], (DEPTH, 6 * D), 0.01)
    norm_g = 1.0 + nrm(ks[6], (DEPTH, 4, D), 0.05)
    w_in = nrm(ks[7], (DEPTH, D, IN_WIDTH), D ** -0.5)
    mlstm_qk_conv = nrm(ks[8], (DEPTH, CONV_W, 2 * BRANCH_W), CONV_W ** -0.5)
    in_bias = nrm(ks[9], (DEPTH, 2, MLSTM_HEADS), 0.1)
    f_bias = jnp.linspace(3.0, 6.0, MLSTM_HEADS)[None, None] + nrm(ks[10], (DEPTH, 2, MLSTM_HEADS), 0.1)
    mlstm_gate_bias = jnp.concatenate([in_bias, f_bias], axis=1)
    pool_w = nrm(ks[11], (DEPTH, len(POOL_WINDOWS), POOL_GW, POOL_GW), POOL_GW ** -0.5)
    pool_scale = 1.0 + nrm(ks[12], (DEPTH, BRANCH_W), 0.05)
    attn_sink = nrm(ks[13], (DEPTH, ATT_Q_HEADS), 0.5)
    sconv_w = nrm(ks[14], (DEPTH, CONV_W, SC_W), CONV_W ** -0.5)
    w_branch = nrm(ks[15], (DEPTH, N_BRANCH, BRANCH_W, D), BRANCH_W ** -0.5)
    w_out = nrm(ks[16], (DEPTH, D, D), D ** -0.5)
    ffn_up = nrm(ks[17], (DEPTH, D, 2 * D_FF), D ** -0.5)
    ffn_conv = nrm(ks[18], (DEPTH, CONV_W, 2 * D_FF), CONV_W ** -0.5)
    ffn_down = nrm(ks[19], (DEPTH, D_FF, D), D_FF ** -0.5)
    return {'x': x, 'c': c, 'ctx': ctx, 'c_ctx': c_ctx, 'w_mod': w_mod, 'b_mod': b_mod, 'norm_g': norm_g,
            'w_in': w_in, 'mlstm_qk_conv': mlstm_qk_conv, 'mlstm_gate_bias': mlstm_gate_bias,
            'pool_w': pool_w, 'pool_scale': pool_scale, 'attn_sink': attn_sink, 'sconv_w': sconv_w,
            'w_branch': w_branch, 'w_out': w_out, 'ffn_up': ffn_up, 'ffn_conv': ffn_conv, 'ffn_down': ffn_down}


def reference(x, c, ctx, c_ctx, w_mod, b_mod, norm_g, w_in, mlstm_qk_conv, mlstm_gate_bias, pool_w, pool_scale,
              attn_sink, sconv_w, w_branch, w_out, ffn_up, ffn_conv, ffn_down):
    B, S, D = x.shape
    rows = S // GRID_W
    rope = axial_rope_tables(rows)
    sc_x = jax.nn.silu(c)[:, None, :]
    sc_c = jax.nn.silu(c_ctx)[None, None, :]
    h = ctx
    for l in range(DEPTH):
        ctx_out = l < DEPTH - 1
        mod_x = jnp.split(sc_x @ w_mod[l] + b_mod[l], 6, axis=-1)
        mod_c = jnp.split(sc_c @ w_mod[l] + b_mod[l], 6, axis=-1)
        ux = modulate(rmsnorm(x, norm_g[l, 0]), mod_x[0], mod_x[1])
        uc = modulate(rmsnorm(h, norm_g[l, 0]), mod_c[0], mod_c[1])
        mx, mc = token_mixers(ux, uc, w_in[l], mlstm_qk_conv[l], mlstm_gate_bias[l], pool_w[l], pool_scale[l],
                              attn_sink[l], sconv_w[l], w_branch[l], w_out[l], rope, ctx_out)
        x = x + mod_x[2] * rmsnorm(mx, norm_g[l, 1])
        fx = conv_ffn(modulate(rmsnorm(x, norm_g[l, 2]), mod_x[3], mod_x[4]), ffn_up[l], ffn_conv[l], ffn_down[l])
        x = x + mod_x[5] * rmsnorm(fx, norm_g[l, 3])
        if ctx_out:
            h = h + mod_c[2] * rmsnorm(mc, norm_g[l, 1])
            fc = conv_ffn(modulate(rmsnorm(h, norm_g[l, 2]), mod_c[3], mod_c[4]), ffn_up[l], ffn_conv[l], ffn_down[l])
            h = h + mod_c[5] * rmsnorm(fc, norm_g[l, 3])
    return x
```

```cpp
#include <hip/hip_runtime.h>
#include <cstdio>
#include <cstdint>

#ifndef MK_PER_PHASE
#define MK_PER_PHASE 0
#endif

#ifndef MK_ONLY
#define MK_ONLY -1
#endif
#define KON(k) (MK_ONLY < 0 || MK_ONLY == (k))
#define LAS __attribute__((address_space(3)))
typedef unsigned short bf16_t;
typedef short bf16x8 __attribute__((ext_vector_type(8)));
typedef short s16x4 __attribute__((ext_vector_type(4)));
typedef float f32x4 __attribute__((ext_vector_type(4)));
typedef float f32x2 __attribute__((ext_vector_type(2)));
typedef unsigned u32x4 __attribute__((ext_vector_type(4)));
typedef unsigned u32x2 __attribute__((ext_vector_type(2)));
typedef __bf16 bf16v2 __attribute__((ext_vector_type(2)));

constexpr int D = 1024, NB = 4, SEQ = 8192, CTX = 256, DEPTH = 4;
constexpr int ML = NB * SEQ, MC = NB * CTX, MT = ML + MC;
constexpr int INW = 8976;
constexpr int NLSTM = 2304, NREST = 2816, NGATE = 4096, DFF = 2816, NUPH = 2816;
constexpr int PROJ_LD = 4160;
constexpr int NBLK = 33;
constexpr int NCHAIN_UNITS = NB * 4 * 2 * NBLK;
constexpr int ST_ELEMS = 129 * 128;
constexpr float EPS = 1e-6f;
constexpr int PR_POOL = 0, PR_AQ = 512, PR_AK = 1024, PR_AV = 1152, PR_SB = 1280, PR_SC = 1792, PR_SX = 2304;

constexpr size_t WS_CTL = 0;
constexpr size_t WS_MOD = 131072;
constexpr size_t WS_ROPE = WS_MOD + (size_t)DEPTH * 5 * 6144 * 4;
constexpr size_t WS_DEC = WS_ROPE + 128 * 16 * 2 * 4;
constexpr size_t WS_W = 1048576;
constexpr size_t W_LSTM = WS_W;
constexpr size_t W_REST = W_LSTM + (size_t)NLSTM * 1024 * 2;
constexpr size_t W_GATE = W_REST + (size_t)NREST * 1024 * 2;
constexpr size_t W_B = W_GATE + (size_t)NGATE * 1024 * 2;
constexpr size_t W_O = W_B + (size_t)4 * 1024 * 512 * 2;
constexpr size_t W_UP = W_O + (size_t)1024 * 1024 * 2;
constexpr size_t W_DN = W_UP + (size_t)2 * NUPH * 1024 * 2;
constexpr size_t WS_H = W_DN + (size_t)1024 * DFF * 2;
constexpr size_t WS_U = WS_H + (size_t)MC * 1024 * 4;
constexpr size_t WS_BIG = WS_U + (size_t)MT * 1024 * 2;
constexpr size_t YS_STRIDE = (size_t)MT * 512 * 2;
constexpr size_t B_PLSTM = 0;
constexpr size_t B_ST = (size_t)MT * NLSTM * 2;
constexpr size_t B_PREST = B_ST + (size_t)NCHAIN_UNITS * ST_ELEMS * 2;
constexpr size_t B_YSB = 0;
constexpr size_t B_PROJ = 3 * YS_STRIDE;
constexpr size_t B_YSA = B_PROJ + (size_t)MT * PROJ_LD * 2;
constexpr size_t B_MERGED = 0, B_MX = B_PROJ, B_ACT = (size_t)MT * NUPH * 2, B_FX = 0;
constexpr size_t B_HB = B_ACT + (size_t)MT * DFF * 2;
constexpr size_t B_GT = B_HB + 1048576;
constexpr size_t BIG_BYTES = B_YSA + YS_STRIDE;
constexpr size_t WS_END = WS_BIG + BIG_BYTES;
static_assert(B_PREST + (size_t)MT * NREST * 2 <= B_YSA && B_PREST % 256 == 0 && B_PROJ % 256 == 0 && B_YSA % 256 == 0, "layout");
static_assert(B_HB + (size_t)(MT / 256) * 4 * 5632 * 4 <= BIG_BYTES && B_GT >= B_PREST + (size_t)MT * NREST * 2 && B_GT + (size_t)NCHAIN_UNITS * 512 * 4 <= B_YSA, "act + halo rows overflow / gate table placement");
static_assert(W_LSTM % 256 == 0 && WS_U % 256 == 0 && WS_BIG % 256 == 0, "alignment");

constexpr int LDS_WORK = 155648;
constexpr int LDS_BYTES = LDS_WORK + 256;

struct Params { const float* in[19]; float* out; unsigned char* ws; int ph_lo, ph_hi, bar_region, pad; };

__device__ __forceinline__ float bf2f(bf16_t b) { return __uint_as_float(((unsigned)b) << 16); }
__device__ __forceinline__ unsigned pk2(float lo, float hi) { f32x2 v = {lo, hi}; bf16v2 r = __builtin_convertvector(v, bf16v2); return __builtin_bit_cast(unsigned, r); }
__device__ __forceinline__ bf16_t f2bf(float f) { return (bf16_t)(pk2(f, 0.f) & 0xffffu); }
__device__ __forceinline__ float lo16(unsigned w) { return __uint_as_float(w << 16); }
__device__ __forceinline__ float hi16(unsigned w) { return __uint_as_float(w & 0xffff0000u); }
__device__ __forceinline__ void unpack8(const u32x4 v, float (&f)[8]) { f[0] = lo16(v.x); f[1] = hi16(v.x); f[2] = lo16(v.y); f[3] = hi16(v.y); f[4] = lo16(v.z); f[5] = hi16(v.z); f[6] = lo16(v.w); f[7] = hi16(v.w); }
__device__ __forceinline__ u32x4 pack8(const float (&f)[8]) { u32x4 r; r.x = pk2(f[0], f[1]); r.y = pk2(f[2], f[3]); r.z = pk2(f[4], f[5]); r.w = pk2(f[6], f[7]); return r; }
__device__ __forceinline__ float sigmoidf_(float x) { return 1.0f / (1.0f + __expf(-x)); }
__device__ __forceinline__ float siluf_(float x) { return x / (1.0f + __expf(-x)); }
__device__ __forceinline__ float logsigmoidf_(float x) { return fminf(x, 0.f) - __logf(1.0f + __expf(-fabsf(x))); }
__device__ __forceinline__ float lshfl(float v, int src) { return __int_as_float(__builtin_amdgcn_ds_bpermute(src << 2, __float_as_int(v))); }
__device__ __forceinline__ float wave_sum(float v, int lane) {
#pragma unroll
    for (int o = 32; o >= 1; o >>= 1) v += lshfl(v, lane ^ o);
    return v; }
__device__ __forceinline__ u32x4 ldg16(const bf16_t* p) { return *(const u32x4*)p; }
#define MFMA16(a, b, c) __builtin_amdgcn_mfma_f32_16x16x32_bf16((a), (b), (c), 0, 0, 0)

__device__ __forceinline__ int hw_lane() { int l; asm volatile("v_mbcnt_lo_u32_b32 %0, -1, 0\n\tv_mbcnt_hi_u32_b32 %0, -1, %0" : "=v"(l)); return l; }
#define XB_TMO      128
#define XB_XCNT(j)  (256  + 64 * (j))
#define XB_XSUB(j)  (1280 + 64 * (j))
#define XB_XGEN(j)  (2304 + 64 * (j))
#define XB_TOP      3328
#define XB_TOPGEN   3392
#define XCD_BAR_WORDS 3456
#define XB_SPIN_CAP (1u << 22)
__device__ __forceinline__ unsigned xb_ld(unsigned* p)              { return __hip_atomic_load(p, __ATOMIC_RELAXED, __HIP_MEMORY_SCOPE_AGENT); }
__device__ __forceinline__ unsigned xb_add(unsigned* p, unsigned v) { return __hip_atomic_fetch_add(p, v, __ATOMIC_RELAXED, __HIP_MEMORY_SCOPE_AGENT); }
__device__ __forceinline__ unsigned xb_xcc_id() { return (unsigned)__builtin_amdgcn_s_getreg((3 << 11) | 20) & 0xFu; }
#define XB_SPIN(cond, bar) do { unsigned _sp = 0; while (cond) { __builtin_amdgcn_s_sleep(1); \
    if ((++_sp & 255u) == 0u) { if (xb_ld(&(bar)[XB_TMO])) break; if (_sp > XB_SPIN_CAP) { atomicAdd(&(bar)[XB_TMO], 1u); break; } } } } while (0)
struct XcdBarrier { unsigned* bar; unsigned x; volatile LAS unsigned* st; };
__device__ __forceinline__ XcdBarrier xcd_barrier_post(unsigned* bar, volatile LAS unsigned* st, bool leader) {
    XcdBarrier b; b.bar = bar; b.x = xb_xcc_id(); b.st = st;
    if (leader) (void)xb_add(&bar[XB_XCNT(b.x)], 1u);
    return b;
}
__device__ __forceinline__ void xcd_barrier_complete(unsigned* bar, unsigned x, unsigned& nloc, unsigned& nx) {
    const unsigned G = gridDim.x * gridDim.y * gridDim.z;
    unsigned sum, cnt, mine, sp = 0u;
    for (;;) {
        sum = 0u; cnt = 0u; mine = 0u;
#pragma unroll
        for (unsigned j = 0; j < 16; ++j) { const unsigned c = xb_ld(&bar[XB_XCNT(j)]); sum += c; cnt += (c > 0u) ? 1u : 0u; }
        mine = xb_ld(&bar[XB_XCNT(x)]);
        if (sum == G) break;
        __builtin_amdgcn_s_sleep(1);
        if ((++sp & 255u) == 0u) { if (xb_ld(&bar[XB_TMO])) break; if (sp > XB_SPIN_CAP) { atomicAdd(&bar[XB_TMO], 1u); break; } }
    }
    nloc = mine > 0u ? mine : 1u; nx = cnt > 0u ? cnt : 1u;
}
__device__ __forceinline__ void xcd_barrier(const XcdBarrier& b, bool leader) {
    asm volatile("s_waitcnt vmcnt(0)" ::: "memory");
    __syncthreads();
    if (leader) {
        unsigned* bar = b.bar;
        __builtin_amdgcn_s_waitcnt(0);
        unsigned nloc = b.st[0], nx = b.st[1];
        if (nloc == 0u) { xcd_barrier_complete(bar, b.x, nloc, nx); b.st[0] = nloc; b.st[1] = nx; }
        const unsigned old = xb_add(&bar[XB_XSUB(b.x)], 1u);
        const unsigned gen = old / nloc;
        if (old + 1u == (gen + 1u) * nloc) {
            __builtin_amdgcn_fence(__ATOMIC_RELEASE, "agent");
            asm volatile("s_waitcnt vmcnt(0)" ::: "memory");
            const unsigned og = xb_add(&bar[XB_TOP], 1u);
            const unsigned tg = og / nx;
            if (og + 1u == (tg + 1u) * nx) xb_add(&bar[XB_TOPGEN], 1u);
            else XB_SPIN(xb_ld(&bar[XB_TOPGEN]) == tg, bar);
            __builtin_amdgcn_fence(__ATOMIC_ACQUIRE, "agent");
            xb_add(&bar[XB_XGEN(b.x)], 1u);
            asm volatile("s_waitcnt vmcnt(0)" ::: "memory");
        } else {
            XB_SPIN(xb_ld(&bar[XB_XGEN(b.x)]) == gen, bar);
            __builtin_amdgcn_fence(__ATOMIC_ACQUIRE, "agent");
            asm volatile("s_waitcnt vmcnt(0)" ::: "memory");
        }
    }
    __syncthreads();
}

namespace pg8 {
constexpr int BM = 256, BK = 64, HALF = 128, HTB = HALF * BK * 2, STAGE_BYTES = 8 * HTB, NXCD = 8, WGM = 8;
__device__ __forceinline__ int lds_byte(int r, int c) { const int st = (r >> 4) * 2 + (c >> 5), rr = r & 15, cc = c & 31, ob = rr * 64 + cc * 2; return st * 1024 + (ob ^ (((ob >> 9) & 1) << 5)); }
__device__ __forceinline__ void stage_rc(int b, int& R, int& C) { const int st = b / 1024, sb = b % 1024, swz = sb ^ (((sb >> 9) & 1) << 5); R = (st >> 1) * 16 + swz / 64; C = (st & 1) * 32 + (swz % 64) / 2; }
__device__ __forceinline__ int perm32(int rho) { const int n = rho >> 4, i = rho & 15; return 8 * (i >> 2) + 4 * n + (i & 3); }
struct Unit { const char* a; const char* b; int orow, ocol; };
struct Sched {
    const char* A0; const char* A1; const char* A2; const char* A3; const char* B;
    int lda, ldb, nM, nN, grp, G, c;
    __device__ __forceinline__ bool next(int i, Unit& u) const {
        const int nwg = nM * nN; const int L = i * G + c; if (L >= nwg) return false;
        int wgid = L; { const int q = nwg / NXCD, r = nwg % NXCD, xcd = wgid % NXCD, off = wgid / NXCD; wgid = (xcd < r ? xcd * (q + 1) : r * (q + 1) + (xcd - r) * q) + off; }
        const int nig = WGM * nN, gid = wgid / nig, fm = gid * WGM, gsz = (nM - fm) < WGM ? (nM - fm) : WGM;
        const int pm = fm + ((wgid % nig) % gsz), pn = (wgid % nig) / gsz;
        const int ag = pn / grp; const char* ab = ag == 0 ? A0 : (ag == 1 ? A1 : (ag == 2 ? A2 : A3));
        u.a = ab + (size_t)pm * BM * lda * 2; u.b = B + (size_t)pn * BM * ldb * 2; u.orow = pm * BM; u.ocol = pn * BM; return true;
    }
};
struct EpiStore {
    static constexpr bool PERM = true, QUAD = true;
    template <int AI, int BJ> __device__ __forceinline__ void quad(const f32x4 (&acc)[2][2][4][2], const Unit& u, int wr, int wc, int fr, int fq) const {
        const int row0 = u.orow + wr * 64 + fr + AI * HALF, col0 = u.ocol + wc * 32 + 8 * fq + BJ * HALF;
#pragma unroll
        for (int m = 0; m < 4; ++m) { const f32x4 v0 = acc[AI][BJ][m][0], v1 = acc[AI][BJ][m][1];
            u32x4 w; w.x = pk2(v0[0], v0[1]); w.y = pk2(v0[2], v0[3]); w.z = pk2(v1[0], v1[1]); w.w = pk2(v1[2], v1[3]);
            *(u32x4*)(O + (size_t)(row0 + m * 16) * ldc + col0) = w; }
    }
    bf16_t* O; int ldc;
    __device__ __forceinline__ void operator()(const f32x4 (&acc)[2][2][4][2], const Unit& u, int wr, int wc, int fr, int fq) const {
        const int row0 = u.orow + wr * 64 + fr, col0 = u.ocol + wc * 32 + 8 * fq;
#pragma unroll
        for (int ai = 0; ai < 2; ++ai)
#pragma unroll
            for (int m = 0; m < 4; ++m) { bf16_t* rowp = O + (size_t)(row0 + ai * HALF + m * 16) * ldc + col0;
#pragma unroll
                for (int bj = 0; bj < 2; ++bj) { const f32x4 v0 = acc[ai][bj][m][0], v1 = acc[ai][bj][m][1];
                    u32x4 w; w.x = pk2(v0[0], v0[1]); w.y = pk2(v0[2], v0[3]); w.z = pk2(v1[0], v1[1]); w.w = pk2(v1[2], v1[3]);
                    *(u32x4*)(rowp + bj * HALF) = w; } }
    }
};
struct EpiMerge {
    static constexpr bool PERM = false, QUAD = false;
    const bf16_t* PROJ; bf16_t* O;
    __device__ __forceinline__ void operator()(f32x4 (&acc)[2][2][4][2], const Unit& u, int wr, int wc, int fr, int fq) const {
        const int row0 = u.orow + wr * 64 + fr, d0 = (u.ocol >> 8) * 64 + wc * 16 + 4 * fq;
        u32x2 pv[2][4][4];
#pragma unroll
        for (int ai = 0; ai < 2; ++ai)
#pragma unroll
            for (int m = 0; m < 4; ++m) { const bf16_t* pp = PROJ + (size_t)(row0 + ai * HALF + m * 16) * PROJ_LD + d0;
#pragma unroll
                for (int nb = 0; nb < 4; ++nb) pv[ai][m][nb] = *(const u32x2*)(pp + nb * 1024); }
        __builtin_amdgcn_sched_barrier(0);
#pragma unroll
        for (int ai = 0; ai < 2; ++ai)
#pragma unroll
            for (int bj = 0; bj < 2; ++bj)
#pragma unroll
                for (int m = 0; m < 4; ++m)
#pragma unroll
                    for (int n = 0; n < 2; ++n) { f32x4 a = acc[ai][bj][m][n]; a[0] = sigmoidf_(a[0]); a[1] = sigmoidf_(a[1]); a[2] = sigmoidf_(a[2]); a[3] = sigmoidf_(a[3]); acc[ai][bj][m][n] = a; }
        __builtin_amdgcn_sched_barrier(0);
#pragma unroll
        for (int ai = 0; ai < 2; ++ai)
#pragma unroll
            for (int m = 0; m < 4; ++m) { f32x4 s = {0.f, 0.f, 0.f, 0.f};
#pragma unroll
                for (int bj = 0; bj < 2; ++bj)
#pragma unroll
                    for (int n = 0; n < 2; ++n) { const u32x2 p2 = pv[ai][m][2 * bj + n]; const f32x4 a = acc[ai][bj][m][n];
                        s[0] += a[0] * lo16(p2.x); s[1] += a[1] * hi16(p2.x); s[2] += a[2] * lo16(p2.y); s[3] += a[3] * hi16(p2.y); }
                u32x2 w; w.x = pk2(s[0], s[1]); w.y = pk2(s[2], s[3]);
                *(u32x2*)(O + (size_t)(row0 + ai * HALF + m * 16) * 1024 + d0) = w; }
    }
};

__device__ __forceinline__ float dpp_prev_keep(float edge, float cur) { return __int_as_float(__builtin_amdgcn_update_dpp(__float_as_int(edge), __float_as_int(cur), 0x111, 0xf, 0xf, false)); }
__device__ __forceinline__ float dpp_next_keep(float edge, float cur) { return __int_as_float(__builtin_amdgcn_update_dpp(__float_as_int(edge), __float_as_int(cur), 0x101, 0xf, 0xf, false)); }
__device__ __forceinline__ float dpp_ror1(float v) { return __int_as_float(__builtin_amdgcn_update_dpp(0, __float_as_int(v), 0x121, 0xf, 0xf, true)); }
__device__ __forceinline__ float dpp_ror15(float v) { return __int_as_float(__builtin_amdgcn_update_dpp(0, __float_as_int(v), 0x12f, 0xf, 0xf, true)); }
struct EpiFfn {
    static constexpr bool PERM = true, QUAD = false;
    bf16_t* act; float* HB; const float* cw; LAS float* XB;
    __device__ __forceinline__ void operator()(f32x4 (&acc)[2][2][4][2], const Unit& u, int wr, int wc, int fr, int fq) const {
        asm volatile("" : "+v"(fr), "+v"(fq));
        const int pm = u.orow >> 8, pt = u.ocol >> 8, ch0 = pt * 128 + wc * 32 + 8 * fq, wv = wr * 4 + wc;
#pragma unroll
        for (int ai = 0; ai < 2; ++ai) {
            if (fr == 0) { LAS f32x4* d = (LAS f32x4*)(XB + (((wv * 4) + ai * 2 + 0) * 4 + fq) * 16); d[0] = acc[ai][0][0][0]; d[1] = acc[ai][0][0][1]; d[2] = acc[ai][1][0][0]; d[3] = acc[ai][1][0][1]; }
            if (fr == 15) { LAS f32x4* d = (LAS f32x4*)(XB + (((wv * 4) + ai * 2 + 1) * 4 + fq) * 16); d[0] = acc[ai][0][3][0]; d[1] = acc[ai][0][3][1]; d[2] = acc[ai][1][3][0]; d[3] = acc[ai][1][3][1]; } }
        if (wr == 0 && fr < 2) { float* h = HB + ((size_t)pm * 4 + fr) * 5632 + ch0;
            *(f32x4*)h = acc[0][0][0][0]; *(f32x4*)(h + 4) = acc[0][0][0][1]; *(f32x4*)(h + 2816) = acc[0][1][0][0]; *(f32x4*)(h + 2820) = acc[0][1][0][1]; }
        if (wr == 1 && fr >= 14) { float* h = HB + ((size_t)pm * 4 + (fr - 12)) * 5632 + ch0;
            *(f32x4*)h = acc[1][0][3][0]; *(f32x4*)(h + 4) = acc[1][0][3][1]; *(f32x4*)(h + 2816) = acc[1][1][3][0]; *(f32x4*)(h + 2820) = acc[1][1][3][1]; }
        asm volatile("s_waitcnt lgkmcnt(0)" ::: "memory"); __builtin_amdgcn_s_barrier(); asm volatile("" ::: "memory");
        __builtin_amdgcn_s_barrier(); asm volatile("" ::: "memory");
#pragma unroll
        for (int bj = 0; bj < 2; ++bj)
#pragma unroll
            for (int nn = 0; nn < 2; ++nn) {
                const f32x4 w0 = *(const f32x4*)(cw + bj * 2816 + ch0 + 4 * nn), w1 = *(const f32x4*)(cw + 5632 + bj * 2816 + ch0 + 4 * nn), w2 = *(const f32x4*)(cw + 2 * 5632 + bj * 2816 + ch0 + 4 * nn);
#pragma unroll
                for (int ai = 0; ai < 2; ++ai) {
                    f32x4 xp = {0.f, 0.f, 0.f, 0.f}, xn = xp;
                    if (wr == 1 || ai == 1) { const int swv = wr == 1 ? wc : 4 + wc, sslot = wr == 1 ? ai * 2 + 1 : 1; xp = *(const LAS f32x4*)(XB + (((swv * 4) + sslot) * 4 + fq) * 16 + bj * 8 + nn * 4); }
                    if (wr == 0 || ai == 0) { const int swv = wr == 0 ? 4 + wc : wc, sslot = wr == 0 ? ai * 2 : 2; xn = *(const LAS f32x4*)(XB + (((swv * 4) + sslot) * 4 + fq) * 16 + bj * 8 + nn * 4); }
                    f32x4 po = xp;
#pragma unroll
                    for (int m = 0; m < 4; ++m) { const f32x4 c = acc[ai][bj][m][nn]; f32x4 rr;
#pragma unroll
                        for (int j = 0; j < 4; ++j) {
                            const float pe = m > 0 ? dpp_ror1(po[j]) : xp[j];
                            const float ne = m < 3 ? dpp_ror15(acc[ai][bj][m < 3 ? m + 1 : 3][nn][j]) : xn[j];
                            const float pv = dpp_prev_keep(pe, c[j]), nv = dpp_next_keep(ne, c[j]);
                            rr[j] = w0[j] * pv + w1[j] * c[j] + w2[j] * nv; }
                        asm volatile("" : "+v"(rr[0]), "+v"(rr[1]), "+v"(rr[2]), "+v"(rr[3]));
                        po = c; acc[ai][bj][m][nn] = rr; }
                    __builtin_amdgcn_sched_barrier(0);
                }
            }
        const int row0 = u.orow + wr * 64 + fr;
#pragma unroll
        for (int ai = 0; ai < 2; ++ai)
#pragma unroll
            for (int m = 0; m < 4; ++m) { const f32x4 g0 = acc[ai][0][m][0], g1 = acc[ai][0][m][1], v0 = acc[ai][1][m][0], v1 = acc[ai][1][m][1];
                u32x4 o; o.x = pk2(siluf_(g0[0]) * v0[0], siluf_(g0[1]) * v0[1]); o.y = pk2(siluf_(g0[2]) * v0[2], siluf_(g0[3]) * v0[3]);
                o.z = pk2(siluf_(g1[0]) * v1[0], siluf_(g1[1]) * v1[1]); o.w = pk2(siluf_(g1[2]) * v1[2], siluf_(g1[3]) * v1[3]);
                *(u32x4*)(act + (size_t)(row0 + ai * HALF + m * 16) * DFF + ch0) = o; __builtin_amdgcn_sched_barrier(0); }
    }
};

template <class Epi>
__device__ __forceinline__ void gemm_phase(LAS unsigned char* lds, const int tid, const int K, const Sched& S, const Epi& E) {
    const int wid = __builtin_amdgcn_readfirstlane(tid >> 6), lane = tid & 63, wr = wid >> 2, wc = wid & 3, fr = lane & 15, fq = lane >> 4;
    const int nt = K / BK; const int lda = S.lda, ldb = S.ldb;
    unsigned voffA, voffB; { int R, C; stage_rc(tid * 16, R, C); const int Rb = Epi::PERM ? ((R & ~31) + perm32(R & 31)) : R;
        voffA = (unsigned)(R * lda + C) * 2u; voffB = (unsigned)(Rb * ldb + C) * 2u; }
    const unsigned skipoffA = (unsigned)(64 * lda * 2), skipoffB = (unsigned)(64 * ldb * 2);
    constexpr unsigned kstep = BK * 2;
    const unsigned hstepA = (unsigned)(HALF * lda * 2), hstepB = (unsigned)(HALF * ldb * 2);
    const unsigned ldsw = (unsigned)wid * 1024u;
    const int aoff = lds_byte(wr * 64 + fr, fq * 8), boff = lds_byte(wc * 32 + fr, fq * 8);
#define PG8_SA(b, h) (((b) * 2 + (h)) * HTB)
#define PG8_SB(b, h) ((4 + (b) * 2 + (h)) * HTB)
#define PG8_STAGE(bufoff, gbase, voff) do { _Pragma("unroll") for (int _i = 0; _i < 2; ++_i) \
        __builtin_amdgcn_global_load_lds((const unsigned*)((const char*)(gbase) + (_i ? skip##voff : 0u) + (v##voff)), (LAS unsigned*)(lds + (bufoff) + ldsw + _i * 8192), 16, 0, 0); } while (0)
#define PG8_LDA(dst, b, h) do { _Pragma("unroll") for (int m = 0; m < 4; ++m) _Pragma("unroll") for (int k = 0; k < 2; ++k) dst[m][k] = *(const LAS bf16x8*)(lds + PG8_SA(b, h) + aoff + m * 2048 + k * 1024); } while (0)
#define PG8_LDB(dst, b, h) do { _Pragma("unroll") for (int n = 0; n < 2; ++n) _Pragma("unroll") for (int k = 0; k < 2; ++k) dst[n][k] = *(const LAS bf16x8*)(lds + PG8_SB(b, h) + boff + n * 2048 + k * 1024); } while (0)
#define PG8_MMA(ai, bj, At, Bt) do { __builtin_amdgcn_s_setprio(1); _Pragma("unroll") for (int m = 0; m < 4; ++m) _Pragma("unroll") for (int n = 0; n < 2; ++n) _Pragma("unroll") for (int k = 0; k < 2; ++k) \
        acc[ai][bj][m][n] = __builtin_amdgcn_mfma_f32_16x16x32_bf16(Bt[n][k], At[m][k], acc[ai][bj][m][n], 0, 0, 0); __builtin_amdgcn_s_setprio(0); } while (0)
#define PG8_WAIT_V(n) asm volatile("s_waitcnt vmcnt(" #n ")" ::: "memory")
#define PG8_WAIT_L(n) asm volatile("s_waitcnt lgkmcnt(" #n ")" ::: "memory")
#define PG8_BAR __builtin_amdgcn_s_barrier()
#define PG8_SCHED __builtin_amdgcn_sched_barrier(0)
#define PG8_MMAZ(Z, ai, bj, At, Bt) do { __builtin_amdgcn_s_setprio(1); _Pragma("unroll") for (int m = 0; m < 4; ++m) _Pragma("unroll") for (int n = 0; n < 2; ++n) _Pragma("unroll") for (int k = 0; k < 2; ++k) \
        acc[ai][bj][m][n] = __builtin_amdgcn_mfma_f32_16x16x32_bf16(Bt[n][k], At[m][k], ((Z) && k == 0) ? (f32x4){0.f, 0.f, 0.f, 0.f} : acc[ai][bj][m][n], 0, 0, 0); __builtin_amdgcn_s_setprio(0); } while (0)
#define PG8_TRIP(FIRST, LAST) do { PG8_SCHED; asm volatile("" : "+v"(voffA), "+v"(voffB));     \
        const char* a1 = cur.a + (unsigned)(t + 1) * kstep; \
        const char* a2 = (LAST) ? nA : cur.a + (unsigned)(t + 2) * kstep; const char* b2 = (LAST) ? nB : cur.b + (unsigned)(t + 2) * kstep; \
        const char* a3 = a2 + kstep; const char* b3 = b2 + kstep; \
        PG8_LDB(B0, 0, 0); PG8_SCHED; PG8_LDA(At, 0, 0); PG8_STAGE(PG8_SA(1, 1), a1 + hstepA, offA); \
        PG8_WAIT_L(8); PG8_BAR; PG8_WAIT_L(0); PG8_MMAZ(FIRST, 0, 0, At, B0); PG8_BAR; PG8_SCHED; \
        PG8_LDB(B1, 0, 1); PG8_STAGE(PG8_SB(0, 0), b2, offB); \
        PG8_BAR; PG8_WAIT_L(0); PG8_MMAZ(FIRST, 0, 1, At, B1); PG8_BAR; \
        PG8_LDA(At, 0, 1); PG8_STAGE(PG8_SA(0, 0), a2, offA); \
        PG8_BAR; PG8_WAIT_L(0); PG8_MMAZ(FIRST, 1, 0, At, B0); PG8_BAR; PG8_SCHED; \
        PG8_STAGE(PG8_SB(0, 1), b2 + hstepB, offB); \
        PG8_WAIT_V(6); PG8_BAR; PG8_MMAZ(FIRST, 1, 1, At, B1); PG8_BAR; \
        PG8_LDB(B0, 1, 0); PG8_SCHED; PG8_LDA(At, 1, 0); PG8_STAGE(PG8_SA(0, 1), a2 + hstepA, offA); \
        PG8_WAIT_L(8); PG8_BAR; PG8_WAIT_L(0); PG8_MMA(0, 0, At, B0); PG8_BAR; PG8_SCHED; \
        PG8_LDB(B1, 1, 1); PG8_STAGE(PG8_SB(1, 0), b3, offB); \
        PG8_BAR; PG8_WAIT_L(0); PG8_MMA(0, 1, At, B1); if constexpr ((LAST) && Epi::QUAD) { const int l_ = hw_lane(); E.template quad<0, 0>(acc, cur, wr, wc, l_ & 15, l_ >> 4); }; PG8_BAR; \
        PG8_LDA(At, 1, 1); PG8_STAGE(PG8_SA(1, 0), a3, offA); \
        PG8_BAR; PG8_WAIT_L(0); PG8_MMA(1, 0, At, B0); if constexpr ((LAST) && Epi::QUAD) { const int l_ = hw_lane(); E.template quad<0, 1>(acc, cur, wr, wc, l_ & 15, l_ >> 4); }; PG8_BAR; PG8_SCHED; \
        PG8_STAGE(PG8_SB(1, 1), b3 + hstepB, offB); \
        if constexpr ((LAST) && Epi::QUAD) PG8_WAIT_V(14); else PG8_WAIT_V(6); \
        PG8_BAR; PG8_MMA(1, 1, At, B1); if constexpr ((LAST) && Epi::QUAD) { const int l_ = hw_lane(); E.template quad<1, 0>(acc, cur, wr, wc, l_ & 15, l_ >> 4); }; PG8_BAR; PG8_SCHED; \
    } while (0)
    Unit cur, nxt; int ui = 0;
    if (!S.next(0, cur)) return;
    f32x4 acc[2][2][4][2];
    bf16x8 At[4][2], B0[2][2], B1[2][2];
    PG8_STAGE(PG8_SB(0, 0), cur.b, offB); PG8_STAGE(PG8_SA(0, 0), cur.a, offA); PG8_STAGE(PG8_SB(0, 1), cur.b + hstepB, offB); PG8_STAGE(PG8_SA(0, 1), cur.a + hstepA, offA);
    if (wr == 1) PG8_BAR;
    PG8_WAIT_V(4); PG8_BAR;
    PG8_STAGE(PG8_SB(1, 0), cur.b + kstep, offB); PG8_STAGE(PG8_SA(1, 0), cur.a + kstep, offA); PG8_STAGE(PG8_SB(1, 1), cur.b + hstepB + kstep, offB);
    PG8_WAIT_V(6); PG8_BAR;
    for (;;) {
        const bool has_next = S.next(ui + 1, nxt);
        const char* nA = has_next ? nxt.a : cur.a; const char* nB = has_next ? nxt.b : cur.b;
        { const int t = 0; PG8_TRIP(true, false); }
        for (int t = 2; t < nt - 2; t += 2) PG8_TRIP(false, false);
        { const int t = nt - 2; PG8_TRIP(false, true); }
        { const int l_ = hw_lane(); if constexpr (Epi::QUAD) E.template quad<1, 1>(acc, cur, wr, wc, l_ & 15, l_ >> 4); else E(acc, cur, wr, wc, l_ & 15, l_ >> 4); }
        if (!has_next) break;
        cur = nxt; ++ui;
    }
    PG8_WAIT_V(0);
    if (wr == 0) PG8_BAR;
    PG8_BAR;
#undef PG8_SA
#undef PG8_SB
#undef PG8_STAGE
#undef PG8_LDA
#undef PG8_LDB
#undef PG8_MMA
#undef PG8_MMAZ
#undef PG8_TRIP
#undef PG8_WAIT_V
#undef PG8_WAIT_L
#undef PG8_BAR
#undef PG8_SCHED
}
}

struct Frame { LAS unsigned char* lds; int tid, lane, wave, G, bid; const Params* P; };
struct PView {
    const Params* p; unsigned char* ws; unsigned char* big; float* out;
    __device__ __forceinline__ const float* in(int k) const { return p->in[k]; }
};
__device__ __forceinline__ PView pview(const Frame& F) { PView v; v.p = F.P; v.out = F.P->out; v.ws = F.P->ws; v.big = v.ws + WS_BIG; return v; }
__device__ __forceinline__ Frame uniform_frame(Frame F) {
    int wv = F.wave, g = F.G, b = F.bid; unsigned lb = (unsigned)(size_t)F.lds;
    asm volatile("" : "+s"(wv), "+s"(g), "+s"(b), "+s"(lb));
    int t = wv * 64 + hw_lane(); asm volatile("" : "+v"(t));
    F.tid = t; F.lane = t & 63; F.wave = wv; F.G = g; F.bid = b; F.lds = (LAS unsigned char*)(size_t)lb; return F; }
#define RFL(x) __builtin_amdgcn_readfirstlane(x)
__device__ __forceinline__ Frame unit_frame(Frame F) { int t = F.tid; asm volatile("" : "+v"(t)); F.tid = t; F.lane = t & 63; return F; }

__device__ __forceinline__ void mod_unit(const Frame& F, const PView& V, int l, int nt) {
    LAS float* sc = (LAS float*)F.lds; LAS float* red = sc + 5 * 1024;
    const float* c = V.in(1); const float* cc = V.in(3);
    __syncthreads();
    for (int i = F.tid; i < 5 * 1024; i += 512) { const float v = i < 4096 ? c[i] : cc[i - 4096]; sc[i] = siluf_(v); }
    __syncthreads();
    const int nl = F.tid & 63, kg = F.tid >> 6, n = nt * 64 + nl;
    const float* w = V.in(4) + (size_t)l * 1024 * 6144 + n;
    float a0 = 0.f, a1 = 0.f, a2 = 0.f, a3 = 0.f, a4 = 0.f;
    for (int k = kg * 128; k < kg * 128 + 128; ++k) { const float wv = w[(size_t)k * 6144];
        a0 += sc[k] * wv; a1 += sc[1024 + k] * wv; a2 += sc[2048 + k] * wv; a3 += sc[3072 + k] * wv; a4 += sc[4096 + k] * wv; }
    red[(kg * 5 + 0) * 64 + nl] = a0; red[(kg * 5 + 1) * 64 + nl] = a1; red[(kg * 5 + 2) * 64 + nl] = a2; red[(kg * 5 + 3) * 64 + nl] = a3; red[(kg * 5 + 4) * 64 + nl] = a4;
    __syncthreads();
    if (F.tid < 320) { const int bi = F.tid >> 6; float s = 0.f;
#pragma unroll
        for (int g = 0; g < 8; ++g) s += red[(g * 5 + bi) * 64 + nl];
        float* mod = (float*)(V.ws + WS_MOD);
        mod[((size_t)l * 5 + bi) * 6144 + n] = s + V.in(5)[(size_t)l * 6144 + n]; }
}
__device__ __forceinline__ void rope_table(const Frame& F, const PView& V) {
    float* rt = (float*)(V.ws + WS_ROPE);
    for (int i = F.tid; i < 128 * 16; i += 512) { const int pos = i >> 4, f = i & 15;
        const float inv = powf(10000.0f, -(float)f / 16.0f); const float ang = (float)pos * inv;
        rt[2 * i] = cosf(ang); rt[2 * i + 1] = sinf(ang); }
}
__device__ __forceinline__ int srcmap(int kind, int n) {
    switch (kind) {
        case 0: return n < 2048 ? n : (n < 2064 ? n : -1);
        case 1: return 2064 + n;
        case 2: { const int dt = n >> 8, c = n & 255, bj = c >> 7, wc = (c >> 5) & 3, nn = (c >> 4) & 1, fq = (c >> 2) & 3, j = c & 3;
                  return 4880 + (2 * bj + nn) * 1024 + dt * 64 + wc * 16 + fq * 4 + j; }
        case 3: return n;
        default: { const int pt = n >> 8, c = n & 255; return (c >> 7) * 2816 + pt * 128 + (c & 127); }
    }
}
struct TileDesc { const float* src; bf16_t* dst; int ldsrc, K, n0, k0, kind; };
__device__ __forceinline__ void convert_tiles4(const Frame& F, const TileDesc (&td)[4], int ntiles) {
    LAS float* tile = (LAS float*)F.lds;
    const int nn = F.tid & 63, kq = F.tid >> 6; float v[4][8];
#pragma unroll
    for (int q = 0; q < 4; ++q) { const int sc = q < ntiles ? srcmap(td[q].kind, td[q].n0 + nn) : -1;
#pragma unroll
        for (int i = 0; i < 8; ++i) { const int kk = kq * 8 + i; v[q][i] = sc >= 0 ? td[q].src[(size_t)(td[q].k0 + kk) * td[q].ldsrc + sc] : 0.f; } }
    __syncthreads();
#pragma unroll
    for (int q = 0; q < 4; ++q)
#pragma unroll
        for (int i = 0; i < 8; ++i) tile[q * 4160 + (kq * 8 + i) * 65 + nn] = v[q][i];
    __syncthreads();
    const int n2 = F.tid >> 3, k8 = (F.tid & 7) * 8;
#pragma unroll
    for (int q = 0; q < 4; ++q) if (q < ntiles) { float f[8];
#pragma unroll
        for (int i = 0; i < 8; ++i) f[i] = tile[q * 4160 + (k8 + i) * 65 + n2];
        *(u32x4*)(td[q].dst + (size_t)(td[q].n0 + n2) * td[q].K + td[q].k0 + k8) = pack8(f); }
}
__device__ __forceinline__ void weff_unit(const Frame& F, const PView& V, int l, int g, int et) {
    LAS float* pw = (LAS float*)F.lds; LAS float* sw = pw + 128 * 129;
    const float* poolw = V.in(10) + ((size_t)l * 4 + g) * 128 * 128; const float* scale = V.in(11) + (size_t)l * 512 + g * 128;
    const float* wb1 = V.in(14) + (((size_t)l * 4 + 1) * 512 + g * 128) * 1024 + et * 64;
    __syncthreads();
    for (int i = F.tid; i < 128 * 128; i += 512) pw[(i >> 7) * 129 + (i & 127)] = poolw[i];
    for (int i = F.tid; i < 128 * 64; i += 512) { const int d = i >> 6, e = i & 63; sw[d * 65 + e] = scale[d] * wb1[(size_t)d * 1024 + e]; }
    __syncthreads();
    const int el = F.tid & 63, cg = F.tid >> 6; float acc[16];
#pragma unroll
    for (int i = 0; i < 16; ++i) acc[i] = 0.f;
    for (int d = 0; d < 128; ++d) { const float s = sw[d * 65 + el];
#pragma unroll
        for (int i = 0; i < 16; ++i) acc[i] += pw[(cg * 16 + i) * 129 + d] * s; }
    bf16_t* dst = (bf16_t*)(V.ws + W_B) + ((size_t)1024 + et * 64 + el) * 512 + g * 128 + cg * 16;
    float f0[8], f1[8];
#pragma unroll
    for (int i = 0; i < 8; ++i) { f0[i] = acc[i]; f1[i] = acc[8 + i]; }
    *(u32x4*)dst = pack8(f0); *(u32x4*)(dst + 8) = pack8(f1);
}
__device__ __forceinline__ TileDesc tile_desc(const PView& V, int l, int t) {
    unsigned char* ws = V.ws; const float* w_in = V.in(7) + (size_t)l * 1024 * INW; TileDesc d;
    const int T0 = 36 * 16, T1 = T0 + 44 * 16, T2 = T1 + 64 * 16, T3 = T2 + 3 * 16 * 8, T4 = T3 + 16 * 16, T5 = T4 + 88 * 16;
    if (t < T0) { d.src = w_in; d.ldsrc = INW; d.K = 1024; d.dst = (bf16_t*)(ws + W_LSTM); d.n0 = (t / 16) * 64; d.k0 = (t % 16) * 64; d.kind = 0; }
    else if (t < T1) { const int q = t - T0; d.src = w_in; d.ldsrc = INW; d.K = 1024; d.dst = (bf16_t*)(ws + W_REST); d.n0 = (q / 16) * 64; d.k0 = (q % 16) * 64; d.kind = 1; }
    else if (t < T2) { const int q = t - T1; d.src = w_in; d.ldsrc = INW; d.K = 1024; d.dst = (bf16_t*)(ws + W_GATE); d.n0 = (q / 16) * 64; d.k0 = (q % 16) * 64; d.kind = 2; }
    else if (t < T3) { const int q = t - T2, bi = q / 128, r = q % 128; const int nb = bi == 0 ? 0 : bi + 1;
        d.src = V.in(14) + ((size_t)l * 4 + nb) * 512 * 1024; d.ldsrc = 1024; d.K = 512; d.dst = (bf16_t*)(ws + W_B) + (size_t)nb * 1024 * 512; d.n0 = (r / 8) * 64; d.k0 = (r % 8) * 64; d.kind = 3; }
    else if (t < T4) { const int q = t - T3; d.src = V.in(15) + (size_t)l * 1024 * 1024; d.ldsrc = 1024; d.K = 1024; d.dst = (bf16_t*)(ws + W_O); d.n0 = (q / 16) * 64; d.k0 = (q % 16) * 64; d.kind = 3; }
    else if (t < T5) { const int q = t - T4; d.src = V.in(16) + (size_t)l * 1024 * 5632; d.ldsrc = 5632; d.K = 1024; d.dst = (bf16_t*)(ws + W_UP); d.n0 = (q / 16) * 64; d.k0 = (q % 16) * 64; d.kind = 4; }
    else { const int q = t - T5; d.src = V.in(18) + (size_t)l * DFF * 1024; d.ldsrc = 1024; d.K = DFF; d.dst = (bf16_t*)(ws + W_DN); d.n0 = (q / 44) * 64; d.k0 = (q % 44) * 64; d.kind = 3; }
    return d;
}
__device__ __forceinline__ void prep_weights(const Frame& F, const PView& V, int l, int t0, int t1, int wid, int nw, bool with_weff) {
#pragma unroll 1
    for (int t = t0 + wid; t < t1; t += 4 * nw) { TileDesc td[4]; int nt = 0;
#pragma unroll
        for (int q = 0; q < 4; ++q) { const int tq = t + q * nw; td[q] = tile_desc(V, l, tq < t1 ? tq : t); nt += tq < t1 ? 1 : 0; }
        convert_tiles4(F, td, nt); }
    if (with_weff) for (int q = wid; q < 64; q += nw) weff_unit(F, V, l, q >> 4, q & 15);
}
constexpr int PREP_T0 = 36 * 16, PREP_T1 = PREP_T0 + 44 * 16, PREP_T2 = PREP_T1 + 64 * 16, PREP_T3 = PREP_T2 + 3 * 16 * 8, PREP_T4 = PREP_T3 + 16 * 16, PREP_T5 = PREP_T4 + 88 * 16, PREP_NT = PREP_T5 + 16 * 44;
__device__ __forceinline__ void tail_prep(const Frame& F, const PView& V, int l, int units, int t0, int t1, int u0, int u1, bool with_weff) {
    const int nbusy = units % F.G;
    int wid = F.bid, nw = F.G;
    if (nbusy > 0) { if (F.bid < nbusy) return; wid = F.bid - nbusy; nw = F.G - nbusy; }
    prep_weights(F, V, l, t0, t1, wid, nw, with_weff);
    if (u1 > u0) prep_weights(F, V, l, u0, u1, wid, nw, false);
}

__device__ __forceinline__ void rows_phase(const Frame& F, const PView& V, int Mrows, const float* xsl, const float* xsc, float* xdl, float* xdc, const bf16_t* y, const float* gpost, const float* modcur, int kgate,
                           bool has_next, const float* gpre, const float* modnext, int kshift, int kscale, bf16_t* U, int wg, int nwg, int pass_lo, int pass_hi) {
    const int lane = F.lane; const int wv = wg * 8 + F.wave, nwv = nwg * 8;
#pragma unroll 1
    for (int pass = pass_lo; pass < pass_hi; ++pass) {
        const int per = nwv >> 2; const int bi = pass == 0 ? wv / per : 4;
        int r = pass == 0 ? bi * SEQ + (wv % per) : ML + wv; const int rstep = pass == 0 ? per : nwv; const int rend = pass == 0 ? (bi + 1) * SEQ : Mrows;
        if (pass == 0 && bi > 3) continue;
        if (r >= rend) continue;
        float cA[16], cB[16], cC[16];
#pragma unroll
        for (int i = 0; i < 2; ++i)
#pragma unroll
            for (int j = 0; j < 8; ++j) { const int c = 512 * i + 8 * lane + j; cA[8 * i + j] = 0.f; cB[8 * i + j] = 0.f; cC[8 * i + j] = 0.f;
                if (y) cA[8 * i + j] = modcur[(size_t)bi * 6144 + kgate * 1024 + c] * gpost[c];
                if (has_next) { cB[8 * i + j] = gpre[c] * (1.0f + modnext[(size_t)bi * 6144 + kscale * 1024 + c]); cC[8 * i + j] = modnext[(size_t)bi * 6144 + kshift * 1024 + c]; } }
#pragma unroll 1
        for (; r < rend; r += rstep) {
            const float* xs = r < ML ? xsl + (size_t)r * 1024 : xsc + (size_t)(r - ML) * 1024;
            float* xd = r < ML ? xdl + (size_t)r * 1024 : xdc + (size_t)(r - ML) * 1024;
            float xv[16];
#pragma unroll
            for (int i = 0; i < 2; ++i) { const int c0 = 512 * i + 8 * lane; const f32x4 a = *(const f32x4*)(xs + c0), b = *(const f32x4*)(xs + c0 + 4);
                xv[8 * i + 0] = a[0]; xv[8 * i + 1] = a[1]; xv[8 * i + 2] = a[2]; xv[8 * i + 3] = a[3]; xv[8 * i + 4] = b[0]; xv[8 * i + 5] = b[1]; xv[8 * i + 6] = b[2]; xv[8 * i + 7] = b[3]; }
            if (y) {
                float yv[16]; float ss = 0.f;
#pragma unroll
                for (int i = 0; i < 2; ++i) { float f[8]; unpack8(ldg16(y + (size_t)r * 1024 + 512 * i + 8 * lane), f);
#pragma unroll
                    for (int j = 0; j < 8; ++j) { yv[8 * i + j] = f[j]; ss += f[j] * f[j]; } }
                ss = wave_sum(ss, lane); const float rs = rsqrtf(ss * (1.0f / 1024.0f) + EPS);
#pragma unroll
                for (int i = 0; i < 16; ++i) xv[i] += cA[i] * (yv[i] * rs);
            }
#pragma unroll
            for (int i = 0; i < 2; ++i) { const int c0 = 512 * i + 8 * lane;
                *(f32x4*)(xd + c0) = (f32x4){xv[8 * i], xv[8 * i + 1], xv[8 * i + 2], xv[8 * i + 3]}; *(f32x4*)(xd + c0 + 4) = (f32x4){xv[8 * i + 4], xv[8 * i + 5], xv[8 * i + 6], xv[8 * i + 7]}; }
            if (has_next) {
                float ss = 0.f;
#pragma unroll
                for (int i = 0; i < 16; ++i) ss += xv[i] * xv[i];
                ss = wave_sum(ss, lane); const float rs = rsqrtf(ss * (1.0f / 1024.0f) + EPS);
#pragma unroll
                for (int i = 0; i < 2; ++i) { float f[8];
#pragma unroll
                    for (int j = 0; j < 8; ++j) f[j] = (xv[8 * i + j] * rs) * cB[8 * i + j] + cC[8 * i + j];
                    *(u32x4*)(U + (size_t)r * 1024 + 512 * i + 8 * lane) = pack8(f); }
            }
        }
    }
}

__device__ __forceinline__ int blk_rowbase(int b, int blk) { return blk == 0 ? ML + b * 256 : b * SEQ + (blk - 1) * 256; }
__device__ __forceinline__ float scan256(LAS float* ws, float v, int tid, bool suffix) {
    const int lane = tid & 63, w = tid >> 6; float x = v;
    if (!suffix) {
#pragma unroll
        for (int o = 1; o < 64; o <<= 1) { const float yv = lshfl(x, (lane - o) & 63); if (lane >= o) x += yv; }
    } else {
#pragma unroll
        for (int o = 1; o < 64; o <<= 1) { const float yv = lshfl(x, (lane + o) & 63); if (lane + o < 64) x += yv; }
    }
    __syncthreads();
    if (w < 4 && lane == (suffix ? 0 : 63)) ws[w] = x;
    __syncthreads();
    if (w < 4) {
        if (!suffix) { for (int j = 0; j < w; ++j) x += ws[j]; }
        else { for (int j = w + 1; j < 4; ++j) x += ws[j]; }
    }
    return x;
}
__device__ __forceinline__ void conv_silu8(const u32x4 pv, const u32x4 cv, const u32x4 nv, const LAS float* w0, const LAS float* w1, const LAS float* w2, float scale, float (&o)[8]) {
    float p[8], c[8], n[8]; unpack8(pv, p); unpack8(cv, c); unpack8(nv, n);
#pragma unroll
    for (int i = 0; i < 8; ++i) { const float yv = p[i] * w0[i] + c[i] * w1[i] + n[i] * w2[i]; o[i] = siluf_(yv) * scale; }
}

__device__ __forceinline__ void lstm_pass1_unit(const Frame& F, const PView& V, int l, int ub) {
    const int tid = F.tid, lane = F.lane, w = F.wave, r = lane & 15, quad = lane >> 4;
    const int blk = ub % NBLK, h = (ub / NBLK) & 3, b = ub / (4 * NBLK);
    const int uf = ((b * 4 + h) * 2 + 0) * NBLK + blk, ubk = uf + NBLK;
    const int rowbase = blk_rowbase(b, blk); const bool seq_first = blk <= 1, seq_last = (blk == 0 || blk == 32);
    const bf16_t* PL = (const bf16_t*)(V.big + B_PLSTM);
    LAS float* wgt = (LAS float*)F.lds;
    LAS float* sws = wgt + 512;
    LAS float* cw = wgt + 528;
    LAS bf16_t* Kt = (LAS bf16_t*)(F.lds + 4096);
    LAS bf16_t* Vt = (LAS bf16_t*)(F.lds + 4096 + 128 * 264 * 2);
    __syncthreads();
    if (tid < 384) cw[tid] = V.in(8)[(size_t)l * 3072 + (tid >> 7) * 1024 + 512 + h * 128 + (tid & 127)];
    float gif = 0.f, gib = 0.f, lff = 0.f, lfb = 0.f;
    if (tid < 256) { const bf16_t* gp = PL + (size_t)(rowbase + tid) * NLSTM + 2048; const float* gb = V.in(9) + (size_t)l * 16;
        gif = bf2f(gp[h]) + gb[h]; gib = bf2f(gp[4 + h]) + gb[4 + h]; lff = logsigmoidf_(bf2f(gp[8 + h]) + gb[8 + h]); lfb = logsigmoidf_(bf2f(gp[12 + h]) + gb[12 + h]); }
    const float cif = scan256(sws, lff, tid, false);
    const float cib = scan256(sws + 4, lfb, tid, false);
    __syncthreads();
    if (tid == 255) { sws[8] = cif; sws[9] = cib; }
    __syncthreads();
    const float totf = sws[8], totb = sws[9];
    if (tid < 256) { wgt[tid] = __expf(totf - cif + gif); wgt[256 + tid] = __expf(cib - lfb + gib);
        float* gt = (float*)(V.big + B_GT); gt[(size_t)uf * 512 + tid] = cif; gt[(size_t)uf * 512 + 256 + tid] = gif;
        gt[(size_t)ubk * 512 + tid] = totb - cib + lfb; gt[(size_t)ubk * 512 + 256 + tid] = gib; }
    if (tid == 0) { float* dec = (float*)(V.ws + WS_DEC); dec[uf] = __expf(totf); dec[ubk] = __expf(totb); }
    __syncthreads();
#pragma unroll 1
    for (int hb = 0; hb < 2; ++hb) {
        u32x4 cv[2][2], pv[2][2], nv[2][2], vv[2][2];
#pragma unroll
        for (int it = 0; it < 2; ++it) { const int pt = (hb * 2 + it) * 512 + tid, chunk = pt >> 7, tp = pt & 127;
#pragma unroll
            for (int e = 0; e < 2; ++e) { const int tau = 2 * tp + e; const int row = rowbase + tau;
                const bf16_t* kp = PL + (size_t)row * NLSTM + 512 + h * 128 + chunk * 8;
                cv[it][e] = ldg16(kp); pv[it][e] = (u32x4){0u, 0u, 0u, 0u}; nv[it][e] = pv[it][e];
                if (!(seq_first && tau == 0)) pv[it][e] = ldg16(kp - NLSTM);
                if (!(seq_last && tau == 255)) nv[it][e] = ldg16(kp + NLSTM);
                vv[it][e] = ldg16(PL + (size_t)row * NLSTM + 1024 + h * 128 + chunk * 8); } }
#pragma unroll
        for (int it = 0; it < 2; ++it) { const int pt = (hb * 2 + it) * 512 + tid, CH = pt >> 7, tp = pt & 127, kc2 = 2 * tp;
            float o0[8], o1[8];
            conv_silu8(pv[it][0], cv[it][0], nv[it][0], cw + CH * 8, cw + 128 + CH * 8, cw + 256 + CH * 8, 0.08838834764831845f, o0);
            conv_silu8(pv[it][1], cv[it][1], nv[it][1], cw + CH * 8, cw + 128 + CH * 8, cw + 256 + CH * 8, 0.08838834764831845f, o1);
#pragma unroll
            for (int i = 0; i < 8; ++i) *(LAS unsigned*)(Kt + (CH * 8 + i) * 264 + kc2) = pk2(o0[i], o1[i]);
            const u32x4 va = vv[it][0], vb = vv[it][1];
            *(LAS unsigned*)(Vt + ((CH) * 8 + 0) * 264 + kc2) = (va.x & 0xffffu) | (vb.x << 16); *(LAS unsigned*)(Vt + ((CH) * 8 + 1) * 264 + kc2) = (va.x >> 16) | (vb.x & 0xffff0000u); *(LAS unsigned*)(Vt + ((CH) * 8 + 2) * 264 + kc2) = (va.y & 0xffffu) | (vb.y << 16); *(LAS unsigned*)(Vt + ((CH) * 8 + 3) * 264 + kc2) = (va.y >> 16) | (vb.y & 0xffff0000u); *(LAS unsigned*)(Vt + ((CH) * 8 + 4) * 264 + kc2) = (va.z & 0xffffu) | (vb.z << 16); *(LAS unsigned*)(Vt + ((CH) * 8 + 5) * 264 + kc2) = (va.z >> 16) | (vb.z & 0xffff0000u); *(LAS unsigned*)(Vt + ((CH) * 8 + 6) * 264 + kc2) = (va.w & 0xffffu) | (vb.w << 16); *(LAS unsigned*)(Vt + ((CH) * 8 + 7) * 264 + kc2) = (va.w >> 16) | (vb.w & 0xffff0000u); }
    }
    __syncthreads();
    bf16x8 af[8];
#pragma unroll
    for (int ks = 0; ks < 8; ++ks) af[ks] = *(const LAS bf16x8*)(Kt + (16 * w + r) * 264 + 32 * ks + 8 * quad);
    const bf16x8 ones = {(short)0x3f80, (short)0x3f80, (short)0x3f80, (short)0x3f80, (short)0x3f80, (short)0x3f80, (short)0x3f80, (short)0x3f80};
    const bf16x8 zeros = {0, 0, 0, 0, 0, 0, 0, 0};
#pragma unroll 1
    for (int dir = 0; dir < 2; ++dir) {
        asm volatile("" ::: "memory");
        bf16x8 ad[8];
#pragma unroll
        for (int ks = 0; ks < 8; ++ks) { const f32x4 w0 = *(const LAS f32x4*)(wgt + dir * 256 + 32 * ks + 8 * quad), w1 = *(const LAS f32x4*)(wgt + dir * 256 + 32 * ks + 8 * quad + 4);
            float f[8]; unpack8(__builtin_bit_cast(u32x4, af[ks]), f);
            f[0] *= w0[0]; f[1] *= w0[1]; f[2] *= w0[2]; f[3] *= w0[3]; f[4] *= w1[0]; f[5] *= w1[1]; f[6] *= w1[2]; f[7] *= w1[3];
            ad[ks] = __builtin_bit_cast(bf16x8, pack8(f)); }
        bf16_t* st = (bf16_t*)(V.big + B_ST) + (size_t)(dir == 0 ? uf : ubk) * ST_ELEMS;
#pragma unroll
        for (int db = 0; db < 9; ++db) { f32x4 acc = {0.f, 0.f, 0.f, 0.f};
#pragma unroll
            for (int ks = 0; ks < 8; ++ks) { bf16x8 bfr;
                if (db < 8) bfr = *(const LAS bf16x8*)(Vt + (16 * db + r) * 264 + 32 * ks + 8 * quad); else bfr = (r == 0) ? ones : zeros;
                acc = MFMA16(ad[ks], bfr, acc); }
            u32x2 pw; pw.x = pk2(acc[0], acc[1]); pw.y = pk2(acc[2], acc[3]);
            if (db < 8) *(u32x2*)(st + (size_t)(16 * db + r) * 128 + 16 * w + 4 * quad) = pw;
            else if (r == 0) *(u32x2*)(st + (size_t)128 * 128 + 16 * w + 4 * quad) = pw; }
    }
}
__device__ __forceinline__ void lstm_scan(const Frame& F, const PView& V) {
    bf16_t* ST = (bf16_t*)(V.big + B_ST); const float* DEC = (const float*)(V.ws + WS_DEC);
    const int per = ST_ELEMS / 8;
    for (int gid = F.bid * 512 + F.tid; gid < 32 * per; gid += F.G * 512) {
        const int chain = gid / per, e8 = gid % per, dir = chain & 1; const int ub = chain * NBLK;
        float sv[8];
#pragma unroll
        for (int q = 0; q < 8; ++q) sv[q] = 0.f;
#pragma unroll 1
        for (int g = 0; g < 3; ++g) { u32x4 tmp[11]; float dc[11];
#pragma unroll
            for (int j = 0; j < 11; ++j) { const int i = g * 11 + j; const int blk = (dir == 0 || i == 0) ? i : 33 - i;
                tmp[j] = *(const u32x4*)(ST + (size_t)(ub + blk) * ST_ELEMS + e8 * 8); dc[j] = DEC[ub + blk]; }
#pragma unroll
            for (int j = 0; j < 11; ++j) { const int i = g * 11 + j; const int blk = (dir == 0 || i == 0) ? i : 33 - i;
                *(u32x4*)(ST + (size_t)(ub + blk) * ST_ELEMS + e8 * 8) = pack8(sv); float f[8]; unpack8(tmp[j], f);
#pragma unroll
                for (int q = 0; q < 8; ++q) sv[q] = sv[q] * dc[j] + f[q]; } }
    }
}
__device__ __forceinline__ void lstm_pass2_unit(const Frame& F, const PView& V, int l, int b, int h, int blk, int qh) {
    const int tid = F.tid, lane = F.lane, w = F.wave, r = lane & 15, quad = lane >> 4;
    const int rowbase = blk_rowbase(b, blk); const bool seq_first = blk <= 1, seq_last = (blk == 0 || blk == 32);
    const bf16_t* PL = (const bf16_t*)(V.big + B_PLSTM);
    LAS float* cf = (LAS float*)F.lds; LAS float* cb = cf + 256; LAS float* igf = cf + 512; LAS float* igb = cf + 768;
    LAS float* sws = cf + 1024;
    LAS float* cwq = cf + 1056;
    LAS float* cwk = cwq + 384;
    LAS bf16_t* CTf = (LAS bf16_t*)(F.lds + 7424);
    LAS bf16_t* CTb = (LAS bf16_t*)(F.lds + 42512);
    LAS bf16_t* Kh = (LAS bf16_t*)(F.lds + 77600);
    LAS bf16_t* Vt = (LAS bf16_t*)(F.lds + 112416);
    const int qi = 8 * qh + w, t = 16 * qi + r; const int qrow = rowbase + t;
    __syncthreads();
    float cwq_v = 0.f, cwk_v = 0.f;
    if (tid < 384) { cwq_v = V.in(8)[(size_t)l * 3072 + (tid >> 7) * 1024 + h * 128 + (tid & 127)]; cwk_v = V.in(8)[(size_t)l * 3072 + (tid >> 7) * 1024 + 512 + h * 128 + (tid & 127)]; }
    float cfv = 0.f, cbv = 0.f, gif = 0.f, gib = 0.f;
    if (tid < 256) { const float* gtf = (const float*)(V.big + B_GT) + (size_t)(((b * 4 + h) * 2 + 0) * NBLK + blk) * 512; const float* gtb = gtf + (size_t)NBLK * 512;
        cfv = gtf[tid]; gif = gtf[256 + tid]; cbv = gtb[tid]; gib = gtb[256 + tid]; }
    u32x4 qc[4], qp_[4], qn[4];
#pragma unroll
    for (int ks = 0; ks < 4; ++ks) { const bf16_t* qp = PL + (size_t)qrow * NLSTM + h * 128 + 32 * ks + 8 * quad;
        qc[ks] = ldg16(qp); qp_[ks] = (u32x4){0u, 0u, 0u, 0u}; qn[ks] = qp_[ks];
        if (!(seq_first && t == 0)) qp_[ks] = ldg16(qp - NLSTM);
        if (!(seq_last && t == 255)) qn[ks] = ldg16(qp + NLSTM); }
    u32x2 og[8];
    const bf16_t* sf = (const bf16_t*)(V.big + B_ST) + (size_t)(((b * 4 + h) * 2 + 0) * NBLK + blk) * ST_ELEMS; const bf16_t* sb = sf + (size_t)NBLK * ST_ELEMS;
    const bool carried = blk != 0;
    if (tid < 384) { cwq[tid] = cwq_v; cwk[tid] = cwk_v; }
    if (tid < 256) { cf[tid] = cfv; cb[tid] = cbv; igf[tid] = gif; igb[tid] = gib; }
    __builtin_amdgcn_sched_barrier(0);
    if (carried) { u32x4 fa[5], fc[5];
#pragma unroll
        for (int it = 0; it < 5; ++it) { const int i = tid + 512 * it; fa[it] = (u32x4){0u, 0u, 0u, 0u}; fc[it] = fa[it];
            if (i < ST_ELEMS / 8) { fa[it] = *(const u32x4*)(sf + (size_t)i * 8); fc[it] = *(const u32x4*)(sb + (size_t)i * 8); } }
#pragma unroll
        for (int it = 0; it < 5; ++it) { const int i = tid + 512 * it; if (i < ST_ELEMS / 8) { const int row = i >> 4, c8 = (i & 15) * 8;
            *(LAS u32x4*)(CTf + row * 136 + c8) = fa[it]; *(LAS u32x4*)(CTb + row * 136 + c8) = fc[it]; } } }
    __builtin_amdgcn_sched_barrier(0);
    u32x4 kc[4], kp_[4], kn[4], vv[4];
#define P2_KV_LOAD(kh_) do { _Pragma("unroll") for (int it = 0; it < 4; ++it) { const int task = it * 512 + tid, chunk = task & 15, key = task >> 4, tau = 128 * (kh_) + key; \
        const bf16_t* kp = PL + (size_t)(rowbase + tau) * NLSTM + 512 + h * 128 + chunk * 8; \
        kc[it] = ldg16(kp); kp_[it] = (u32x4){0u, 0u, 0u, 0u}; kn[it] = kp_[it]; \
        if (!(seq_first && tau == 0)) kp_[it] = ldg16(kp - NLSTM); \
        if (!(seq_last && tau == 255)) kn[it] = ldg16(kp + NLSTM); \
        } } while (0)
#define P2_V_LOAD(kh_) do { _Pragma("unroll") for (int it = 0; it < 2; ++it) { const int pt = it * 512 + tid; \
        const bf16_t* vp = PL + (size_t)(rowbase + 128 * (kh_) + 2 * (pt & 63)) * NLSTM + 1024 + h * 128 + (pt >> 6) * 8; vv[2 * it] = ldg16(vp); vv[2 * it + 1] = ldg16(vp + NLSTM); } } while (0)
#define P2_KV_STORE(KD, VD) do { _Pragma("unroll") for (int it = 0; it < 4; ++it) { const int task = it * 512 + tid, chunk = task & 15, key = task >> 4; \
        float o[8]; conv_silu8(kp_[it], kc[it], kn[it], cwk + chunk * 8, cwk + 128 + chunk * 8, cwk + 256 + chunk * 8, 0.08838834764831845f, o); \
        *(LAS u32x4*)((KD) + key * 136 + chunk * 8) = pack8(o); } \
        _Pragma("unroll") for (int it = 0; it < 2; ++it) { const int pt = it * 512 + tid; const int CH = pt >> 6, kc2 = 2 * (pt & 63); LAS bf16_t* vd_ = (VD); const u32x4 va = vv[2 * it], vb = vv[2 * it + 1]; \
        *(LAS unsigned*)(vd_ + ((CH) * 8 + 0) * 136 + kc2) = (va.x & 0xffffu) | (vb.x << 16); \
         *(LAS unsigned*)(vd_ + ((CH) * 8 + 1) * 136 + kc2) = (va.x >> 16) | (vb.x & 0xffff0000u); \
         *(LAS unsigned*)(vd_ + ((CH) * 8 + 2) * 136 + kc2) = (va.y & 0xffffu) | (vb.y << 16); \
         *(LAS unsigned*)(vd_ + ((CH) * 8 + 3) * 136 + kc2) = (va.y >> 16) | (vb.y & 0xffff0000u); \
         *(LAS unsigned*)(vd_ + ((CH) * 8 + 4) * 136 + kc2) = (va.z & 0xffffu) | (vb.z << 16); \
         *(LAS unsigned*)(vd_ + ((CH) * 8 + 5) * 136 + kc2) = (va.z >> 16) | (vb.z & 0xffff0000u); \
         *(LAS unsigned*)(vd_ + ((CH) * 8 + 6) * 136 + kc2) = (va.w & 0xffffu) | (vb.w << 16); \
         *(LAS unsigned*)(vd_ + ((CH) * 8 + 7) * 136 + kc2) = (va.w >> 16) | (vb.w & 0xffff0000u); } } while (0)
    __syncthreads();
    bf16x8 qf[4];
#pragma unroll
    for (int ks = 0; ks < 4; ++ks) { const int c0 = 32 * ks + 8 * quad; float o[8]; conv_silu8(qp_[ks], qc[ks], qn[ks], cwq + c0, cwq + 128 + c0, cwq + 256 + c0, 1.0f, o);
        qf[ks] = __builtin_bit_cast(bf16x8, pack8(o)); }
    __builtin_amdgcn_sched_barrier(0);
    P2_KV_LOAD(0);
    __builtin_amdgcn_sched_barrier(0);
    const bf16x8 ones = {(short)0x3f80, (short)0x3f80, (short)0x3f80, (short)0x3f80, (short)0x3f80, (short)0x3f80, (short)0x3f80, (short)0x3f80};
    const bf16x8 zeros = {0, 0, 0, 0, 0, 0, 0, 0};
    f32x4 accf[9], accb[9];
#pragma unroll
    for (int db = 0; db < 9; ++db) { accf[db] = (f32x4){0.f, 0.f, 0.f, 0.f}; accb[db] = accf[db]; }
    if (carried) { const float ef = __expf(cf[t]), eb = __expf(cb[t]);
#pragma unroll
        for (int db = 0; db < 9; ++db) { f32x4 a = {0.f, 0.f, 0.f, 0.f}, c = {0.f, 0.f, 0.f, 0.f};
#pragma unroll
            for (int ks = 0; ks < 4; ++ks) { bf16x8 xf, xb;
                if (db < 8) { xf = *(const LAS bf16x8*)(CTf + (16 * db + r) * 136 + 32 * ks + 8 * quad); xb = *(const LAS bf16x8*)(CTb + (16 * db + r) * 136 + 32 * ks + 8 * quad); }
                else { xf = zeros; xb = zeros; if (r == 0) { xf = *(const LAS bf16x8*)(CTf + 128 * 136 + 32 * ks + 8 * quad); xb = *(const LAS bf16x8*)(CTb + 128 * 136 + 32 * ks + 8 * quad); } }
                a = MFMA16(xf, qf[ks], a); c = MFMA16(xb, qf[ks], c); }
            accf[db] = a * ef; accb[db] = c * eb; } }
    const float cft = cf[t], cbt = cb[t];
    P2_V_LOAD(0);
    P2_KV_STORE(Kh, Vt);
    __syncthreads();
    P2_KV_LOAD(1); P2_V_LOAD(1);
    P2_KV_STORE(CTf, CTf + 128 * 136);
    __syncthreads();
#pragma unroll 1
    for (int kh = 0; kh < 2; ++kh) {
        const LAS bf16_t* Kc = kh == 0 ? Kh : CTf; const LAS bf16_t* Vc = kh == 0 ? Vt : CTf + 128 * 136;
#pragma unroll
        for (int dir = 0; dir < 2; ++dir) {
            int s0, s1;
            if (dir == 0) { if (kh > qh) continue; s0 = 0; s1 = (kh < qh) ? 4 : (w >> 1) + 1; }
            else { if (kh < qh) continue; s1 = 4; s0 = (kh > qh) ? 0 : (w >> 1); }
            const LAS float* cs = dir == 0 ? cf : cb; const LAS float* gs = dir == 0 ? igf : igb; const float ct = dir == 0 ? cft : cbt;
#pragma unroll 1
            for (int st = s0; st < s1; ++st) {
                f32x4 T0 = {0.f, 0.f, 0.f, 0.f}, T1 = {0.f, 0.f, 0.f, 0.f};
#pragma unroll
                for (int ks = 0; ks < 4; ++ks) { const bf16x8 k0 = *(const LAS bf16x8*)(Kc + (32 * st + r) * 136 + 32 * ks + 8 * quad), k1 = *(const LAS bf16x8*)(Kc + (32 * st + 16 + r) * 136 + 32 * ks + 8 * quad);
                    T0 = MFMA16(k0, qf[ks], T0); T1 = MFMA16(k1, qf[ks], T1); }
                const int sg0 = 128 * kh + 32 * st + 4 * quad;
                const f32x4 c0 = *(const LAS f32x4*)(cs + sg0), c1 = *(const LAS f32x4*)(cs + sg0 + 16), e0 = *(const LAS f32x4*)(gs + sg0), e1 = *(const LAS f32x4*)(gs + sg0 + 16);
                float p[8];
#pragma unroll
                for (int j = 0; j < 4; ++j) { const int sa = sg0 + j, sb = sg0 + 16 + j;
                    const bool va = dir == 0 ? (sa <= t) : (sa >= t), vb = dir == 0 ? (sb <= t) : (sb >= t);
                    const float da = __expf(ct - c0[j] + e0[j]), dbb = __expf(ct - c1[j] + e1[j]);
                    p[j] = va ? T0[j] * da : 0.f; p[4 + j] = vb ? T1[j] * dbb : 0.f; }
                const bf16x8 pf = __builtin_bit_cast(bf16x8, pack8(p));
#pragma unroll
                for (int db = 0; db < 9; ++db) { bf16x8 vf;
                    if (db < 8) { const s16x4 lo = *(const LAS s16x4*)(Vc + (16 * db + r) * 136 + 32 * st + 4 * quad), hi = *(const LAS s16x4*)(Vc + (16 * db + r) * 136 + 32 * st + 16 + 4 * quad);
                        vf = __builtin_shufflevector(lo, hi, 0, 1, 2, 3, 4, 5, 6, 7); }
                    else vf = (r == 0) ? ones : zeros;
                    if (dir == 0) accf[db] = MFMA16(vf, pf, accf[db]); else accb[db] = MFMA16(vf, pf, accb[db]); }
            }
        }
    }
#undef P2_KV_LOAD
#undef P2_V_LOAD
#undef P2_KV_STORE
#pragma unroll
    for (int db = 0; db < 8; ++db) og[db] = *(const u32x2*)(PL + (size_t)qrow * NLSTM + 1536 + h * 128 + 16 * db + 4 * quad);
    const float denf = lshfl(accf[8][0], r), denb = lshfl(accb[8][0], r);
    const float invf = 1.0f / fmaxf(fabsf(denf), 1.0f), invb = 1.0f / fmaxf(fabsf(denb), 1.0f);
    bf16_t* ya = (bf16_t*)(V.big + B_YSA);
#pragma unroll
    for (int db = 0; db < 8; ++db) { const int dv = 16 * db + 4 * quad; const u32x2 ov = og[db];
        const float o0 = lo16(ov.x), o1 = hi16(ov.x), o2 = lo16(ov.y), o3 = hi16(ov.y);
        const f32x4 hv = accf[db] * invf + accb[db] * invb;
        u32x2 wv; wv.x = pk2(sigmoidf_(o0) * hv[0], sigmoidf_(o1) * hv[1]); wv.y = pk2(sigmoidf_(o2) * hv[2], sigmoidf_(o3) * hv[3]);
        *(u32x2*)(ya + (size_t)qrow * 512 + h * 128 + dv) = wv; }
}

__device__ __forceinline__ void attn_unit(const Frame& F, const PView& V, int l, bool isctx, int b, int g, int qs) {
    const int tid = F.tid, lane = F.lane, w = F.wave, r = lane & 15, quad = lane >> 4;
    const bf16_t* PR = (const bf16_t*)(V.big + B_PREST); const LAS float* ropel = (const LAS float*)(F.lds + 36864);
    LAS bf16_t* Ks = (LAS bf16_t*)F.lds;
    LAS bf16_t* Vt = (LAS bf16_t*)(F.lds + 18432);
    const int head = g * 4 + (w >> 1), qhalf = w & 1;
    const int qrow0 = isctx ? ML + b * 256 + qs * 64 : b * SEQ + qs * 64;
    const float sink = V.in(12)[l * 8 + head];
    bf16x8 qf[2][2];
#pragma unroll
    for (int qk = 0; qk < 2; ++qk) { const int qi = qhalf * 32 + qk * 16 + r, tpos = qs * 64 + qi; const bf16_t* qp = PR + (size_t)(qrow0 + qi) * NREST + PR_AQ + head * 64;
#pragma unroll
        for (int ks = 0; ks < 2; ++ks) { const int d0 = 32 * ks + 8 * quad; float own[8], par[8], o[8]; unpack8(ldg16(qp + d0), own); unpack8(ldg16(qp + (d0 ^ 16)), par);
            if (!isctx) { const int pos = ks == 0 ? (tpos >> 6) : (tpos & 63); const LAS float* rp = ropel + (pos * 16 + 8 * (quad & 1)) * 2;
#pragma unroll
                for (int j = 0; j < 8; ++j) { const float c = rp[2 * j], sn = rp[2 * j + 1]; o[j] = (quad < 2) ? own[j] * c - par[j] * sn : par[j] * sn + own[j] * c; } }
            else {
#pragma unroll
                for (int j = 0; j < 8; ++j) o[j] = own[j]; }
#pragma unroll
            for (int j = 0; j < 8; ++j) o[j] *= 0.18033688011112042f;
            qf[qk][ks] = __builtin_bit_cast(bf16x8, pack8(o)); } }
    float mrun[2], lsum[2]; f32x4 acc[2][4];
    const float sinkl = sink * 1.4426950408889634f;
#pragma unroll
    for (int qk = 0; qk < 2; ++qk) { mrun[qk] = sinkl; lsum[qk] = 0.f;
#pragma unroll
        for (int db = 0; db < 4; ++db) acc[qk][db] = (f32x4){0.f, 0.f, 0.f, 0.f}; }
    const int ntile = isctx ? 2 : 5; const int ltm = 4 * quad - r - 32 * qhalf; const int qb = qs >> 1;
    const unsigned vmask = isctx ? 3u : (3u | (qb >= 1 ? 4u : 0u) | 8u | (qb <= 62 ? 16u : 0u));
    const int skey = tid >> 2, sa = (tid >> 1) & 1, sfh = tid & 1;
    u32x4 pk1, pk2v, pv0, pv1;
#define ATT_LOAD(tl) do { const int _kr = (tl) < 2 ? ML + b * 256 + (tl) * 128 : b * SEQ + (qb + (tl) - 3) * 128; \
        const bf16_t* _kp = PR + (size_t)(_kr + skey) * NREST + PR_AK + g * 64 + sa * 32 + sfh * 8; pk1 = ldg16(_kp); pk2v = ldg16(_kp + 16); \
        const bf16_t* _vp = PR + (size_t)(_kr + 2 * (tid & 63)) * NREST + PR_AV + g * 64 + (tid >> 6) * 8; pv0 = ldg16(_vp); pv1 = ldg16(_vp + NREST); } while (0)
    ATT_LOAD(0);
#pragma unroll 1
    for (int tile = 0; tile < ntile; ++tile) {
        if (!((vmask >> tile) & 1u)) continue;
        int kb = 0, base = 0; bool band = false;
        if (tile >= 2) { kb = qb + tile - 3; band = true; base = 128 * kb - 64 * qs; }
        __syncthreads();
        { float x1[8], x2[8], o1[8], o2[8]; unpack8(pk1, x1); unpack8(pk2v, x2);
            if (band) { const int kpos = kb * 128 + skey, pos = sa == 0 ? (kpos >> 6) : (kpos & 63); const LAS float* rp = ropel + (pos * 16 + sfh * 8) * 2;
#pragma unroll
                for (int j = 0; j < 8; ++j) { const float c = rp[2 * j], sn = rp[2 * j + 1]; o1[j] = x1[j] * c - x2[j] * sn; o2[j] = x1[j] * sn + x2[j] * c; } }
            else {
#pragma unroll
                for (int j = 0; j < 8; ++j) { o1[j] = x1[j]; o2[j] = x2[j]; } }
            *(LAS u32x4*)(Ks + skey * 72 + sa * 32 + sfh * 8) = pack8(o1); *(LAS u32x4*)(Ks + skey * 72 + sa * 32 + 16 + sfh * 8) = pack8(o2); }
        { const int CH = tid >> 6, kc2 = 2 * (tid & 63); *(LAS unsigned*)(Vt + ((CH) * 8 + 0) * 136 + kc2) = (pv0.x & 0xffffu) | (pv1.x << 16); *(LAS unsigned*)(Vt + ((CH) * 8 + 1) * 136 + kc2) = (pv0.x >> 16) | (pv1.x & 0xffff0000u); *(LAS unsigned*)(Vt + ((CH) * 8 + 2) * 136 + kc2) = (pv0.y & 0xffffu) | (pv1.y << 16); *(LAS unsigned*)(Vt + ((CH) * 8 + 3) * 136 + kc2) = (pv0.y >> 16) | (pv1.y & 0xffff0000u); *(LAS unsigned*)(Vt + ((CH) * 8 + 4) * 136 + kc2) = (pv0.z & 0xffffu) | (pv1.z << 16); *(LAS unsigned*)(Vt + ((CH) * 8 + 5) * 136 + kc2) = (pv0.z >> 16) | (pv1.z & 0xffff0000u); *(LAS unsigned*)(Vt + ((CH) * 8 + 6) * 136 + kc2) = (pv0.w & 0xffffu) | (pv1.w << 16); *(LAS unsigned*)(Vt + ((CH) * 8 + 7) * 136 + kc2) = (pv0.w >> 16) | (pv1.w & 0xffff0000u); }
        __syncthreads();
        { int nx = tile + 1; while (nx < ntile && !((vmask >> nx) & 1u)) ++nx; if (nx < ntile) ATT_LOAD(nx); }
        const bool domask = band && base != 0 && base != -64;
        f32x4 T[2][8];
#pragma unroll
        for (int kt = 0; kt < 8; ++kt) { f32x4 a0 = {0.f, 0.f, 0.f, 0.f}, a1 = {0.f, 0.f, 0.f, 0.f};
#pragma unroll
            for (int ks = 0; ks < 2; ++ks) { const bf16x8 kf = *(const LAS bf16x8*)(Ks + (16 * kt + r) * 72 + 32 * ks + 8 * quad); a0 = MFMA16(kf, qf[0][ks], a0); a1 = MFMA16(kf, qf[1][ks], a1); }
            T[0][kt] = a0; T[1][kt] = a1; }
        bf16x8 pf[2][4];
#pragma unroll
        for (int qk = 0; qk < 2; ++qk) {
            if (domask) {
#pragma unroll
                for (int kt = 0; kt < 8; ++kt)
#pragma unroll
                    for (int j = 0; j < 4; ++j) { const int dlt = base + (16 * kt + j - 16 * qk) + ltm; if (dlt > 128 || dlt < -128) T[qk][kt][j] = -8e30f; }
            }
            float tmax = -1e30f;
#pragma unroll
            for (int kt = 0; kt < 8; ++kt)
#pragma unroll
                for (int j = 0; j < 4; ++j) tmax = fmaxf(tmax, T[qk][kt][j]);
            tmax = fmaxf(tmax, lshfl(tmax, lane ^ 16)); tmax = fmaxf(tmax, lshfl(tmax, lane ^ 32));
            const float mnew = fmaxf(mrun[qk], tmax), alpha = __builtin_amdgcn_exp2f(mrun[qk] - mnew); mrun[qk] = mnew;
            float psum = 0.f;
#pragma unroll
            for (int kt = 0; kt < 8; ++kt)
#pragma unroll
                for (int j = 0; j < 4; ++j) { const float pv = __builtin_amdgcn_exp2f(T[qk][kt][j] - mnew); T[qk][kt][j] = pv; psum += pv; }
            lsum[qk] = lsum[qk] * alpha + psum;
#pragma unroll
            for (int db = 0; db < 4; ++db) acc[qk][db] = acc[qk][db] * alpha;
#pragma unroll
            for (int st = 0; st < 4; ++st) { float p[8];
#pragma unroll
                for (int j = 0; j < 4; ++j) { p[j] = T[qk][2 * st][j]; p[4 + j] = T[qk][2 * st + 1][j]; }
                pf[qk][st] = __builtin_bit_cast(bf16x8, pack8(p)); }
        }
#pragma unroll
        for (int st = 0; st < 4; ++st)
#pragma unroll
            for (int db = 0; db < 4; ++db) { const s16x4 lo = *(const LAS s16x4*)(Vt + (16 * db + r) * 136 + 32 * st + 4 * quad), hi = *(const LAS s16x4*)(Vt + (16 * db + r) * 136 + 32 * st + 16 + 4 * quad);
                const bf16x8 vf = __builtin_shufflevector(lo, hi, 0, 1, 2, 3, 4, 5, 6, 7);
                acc[0][db] = MFMA16(vf, pf[0][st], acc[0][db]); acc[1][db] = MFMA16(vf, pf[1][st], acc[1][db]); }
    }
    bf16_t* yc = (bf16_t*)(V.big + B_YSB + 1 * YS_STRIDE);
#pragma unroll
    for (int qk = 0; qk < 2; ++qk) { const int qi = qhalf * 32 + qk * 16 + r; float lt = lsum[qk]; lt += lshfl(lt, lane ^ 16); lt += lshfl(lt, lane ^ 32); lt += __builtin_amdgcn_exp2f(sinkl - mrun[qk]);
        const float inv = 1.0f / lt;
#pragma unroll
        for (int db = 0; db < 4; ++db) { const f32x4 o = acc[qk][db] * inv; u32x2 wv; wv.x = pk2(o[0], o[1]); wv.y = pk2(o[2], o[3]);
            *(u32x2*)(yc + (size_t)(qrow0 + qi) * 512 + head * 64 + 16 * db + 4 * quad) = wv; } }
#undef ATT_LOAD
}
__device__ __forceinline__ void seq_of_row(int row0, int& seqbase, int& T) { seqbase = row0 < ML ? (row0 & ~(SEQ - 1)) : ML + ((row0 - ML) & ~(CTX - 1)); T = row0 < ML ? SEQ : CTX; }
__device__ __forceinline__ void pool_tasks(const Frame& F, const PView& V, int Mrows) {
    const bf16_t* PR = (const bf16_t*)(V.big + B_PREST); bf16_t* yb = (bf16_t*)(V.big + B_YSB + 0 * YS_STRIDE);
    const int ntask = (Mrows / 8) * 64;
#pragma unroll 1
    for (int t = F.bid * 512 + F.tid; t < ntask; t += F.G * 512) {
        const int cg = t & 15, rbl = (t >> 4) & 3, g = (t >> 6) & 3, rb = ((t >> 8) << 2) + rbl, half = 1 << g;
        const int row0 = rb * 8; int seqbase, T; seq_of_row(row0, seqbase, T); const int t0 = row0 - seqbase;
        const bf16_t* base = PR + (size_t)row0 * NREST + PR_POOL + (g * 16 + cg) * 8;
        u32x4 rw[24];
#pragma unroll
        for (int i = 0; i < 24; ++i) { const int tt = t0 - half + i; rw[i] = (u32x4){0u, 0u, 0u, 0u};
            if (i < 8 + 2 * half && tt >= 0 && tt < T) rw[i] = ldg16(base + (ptrdiff_t)(i - half) * NREST); }
        float sum[8];
#pragma unroll
        for (int j = 0; j < 8; ++j) sum[j] = 0.f;
#pragma unroll
        for (int i = 0; i < 16; ++i) if (i < 2 * half) { float f[8]; unpack8(rw[i], f);
#pragma unroll
            for (int j = 0; j < 8; ++j) sum[j] += f[j]; }
#pragma unroll
        for (int i = 0; i < 8; ++i) {
            const int tc = t0 + i, lo = tc - half < 0 ? 0 : tc - half, hi = tc + half > T ? T : tc + half; const float inv = 1.0f / (float)(hi - lo);
            float c[8], o[8];
            if (g == 0) unpack8(rw[i + 1], c); else if (g == 1) unpack8(rw[i + 2], c); else if (g == 2) unpack8(rw[i + 4], c); else unpack8(rw[i + 8], c);
#pragma unroll
            for (int j = 0; j < 8; ++j) o[j] = sum[j] * inv - c[j];
            *(u32x4*)(yb + (size_t)(row0 + i) * 512 + (g * 16 + cg) * 8) = pack8(o);
            if (i < 7) { float fa[8], fs[8]; unpack8(rw[i], fs);
                if (g == 0) unpack8(rw[i + 2], fa); else if (g == 1) unpack8(rw[i + 4], fa); else if (g == 2) unpack8(rw[i + 8], fa); else unpack8(rw[i + 16], fa);
#pragma unroll
                for (int j = 0; j < 8; ++j) sum[j] += fa[j] - fs[j]; }
        }
    }
}
__device__ __forceinline__ void sconv_tasks(const Frame& F, const PView& V, int l, int Mrows) {
    const bf16_t* PR = (const bf16_t*)(V.big + B_PREST); bf16_t* yd = (bf16_t*)(V.big + B_YSB + 2 * YS_STRIDE);
    const int ntask = (Mrows / 8) * 64;
#pragma unroll 1
    for (int t = F.bid * 512 + F.tid; t < ntask; t += F.G * 512) {
        const int chunk = t & 63, rb = t >> 6; const int row0 = rb * 8; int seqbase, T; seq_of_row(row0, seqbase, T); const int t0 = row0 - seqbase;
        const float* cw = V.in(13) + (size_t)l * 1536 + chunk * 8;
        const bf16_t* base = PR + (size_t)row0 * NREST + chunk * 8;
        u32x4 cr[10], xr[10], br[8];
#pragma unroll
        for (int i = 0; i < 10; ++i) { const int tt = t0 - 1 + i; cr[i] = (u32x4){0u, 0u, 0u, 0u}; xr[i] = cr[i];
            if (tt >= 0 && tt < T) { cr[i] = ldg16(base + (ptrdiff_t)(i - 1) * NREST + PR_SC); xr[i] = ldg16(base + (ptrdiff_t)(i - 1) * NREST + PR_SX); } }
#pragma unroll
        for (int i = 0; i < 8; ++i) br[i] = ldg16(base + (size_t)i * NREST + PR_SB);
        float w0[8], w1[8], w2[8];
#pragma unroll
        for (int j = 0; j < 8; ++j) { w0[j] = cw[j]; w1[j] = cw[512 + j]; w2[j] = cw[1024 + j]; }
        float pa[8], pb[8], pc[8], c[8], x[8];
        unpack8(cr[0], c); unpack8(xr[0], x);
#pragma unroll
        for (int j = 0; j < 8; ++j) pa[j] = c[j] * x[j];
        unpack8(cr[1], c); unpack8(xr[1], x);
#pragma unroll
        for (int j = 0; j < 8; ++j) pb[j] = c[j] * x[j];
#pragma unroll
        for (int i = 0; i < 8; ++i) { unpack8(cr[i + 2], c); unpack8(xr[i + 2], x); float bv[8], o[8]; unpack8(br[i], bv);
#pragma unroll
            for (int j = 0; j < 8; ++j) { pc[j] = c[j] * x[j]; o[j] = bv[j] * (w0[j] * pa[j] + w1[j] * pb[j] + w2[j] * pc[j]); pa[j] = pb[j]; pb[j] = pc[j]; }
            *(u32x4*)(yd + (size_t)(row0 + i) * 512 + chunk * 8) = pack8(o); }
    }
}
constexpr int PH_PER_LAYER = 15, N_PHASES = 2 + DEPTH * PH_PER_LAYER - 1;
constexpr int F3C_WGS = ((MT - ML) / 256) * 4;
__device__ __forceinline__ void ph_prologue(Frame F0) { const Frame F = uniform_frame(F0); const PView V = pview(F);
    for (int u = F.bid; u < DEPTH * 96; u += F.G) mod_unit(F, V, u / 96, u % 96);
    if (F.bid == F.G - 1) rope_table(F, V);
    prep_weights(F, V, 0, 0, PREP_NT, F.bid, F.G, true);
}
__device__ __forceinline__ void ph_rows(Frame F0, int kind, int l) { const Frame F = uniform_frame(F0); const PView V = pview(F); kind = RFL(kind); l = RFL(l);
    const float* modall = (const float*)(V.ws + WS_MOD); const float* modl = modall + (size_t)l * 5 * 6144; const float* ng = V.in(6) + (size_t)l * 4 * 1024;
    bf16_t* U = (bf16_t*)(V.ws + WS_U); float* H = (float*)(V.ws + WS_H); const bool ctx_out = l < DEPTH - 1; const int Mrows = ctx_out ? MT : ML;
    if (kind == 0) rows_phase(F, V, MT, V.in(0), V.in(2), V.out, H, nullptr, nullptr, nullptr, 0, true, ng, modl, 0, 1, U, F.bid, F.G, 0, 2);
    else if (kind == 1) { const int skip = ctx_out ? F3C_WGS : 0;
        if (F.bid >= skip) rows_phase(F, V, ML, V.out, H, V.out, H, (const bf16_t*)(V.big + B_MX), ng + 1024, modl, 2, true, ng + 2048, modl, 3, 4, U, F.bid - skip, F.G - skip, 0, 1); }
    else if (kind == 4) rows_phase(F, V, MT, V.out, H, V.out, H, (const bf16_t*)(V.big + B_MX), ng + 1024, modl, 2, true, ng + 2048, modl, 3, 4, U, F.bid, F.G, 1, 2);
    else if (kind == 2) { const int skip = ctx_out ? F3C_WGS : 0;
        if (F.bid >= skip) rows_phase(F, V, ML, V.out, H, V.out, H, (const bf16_t*)(V.big + B_FX), ng + 3072, modl, 5, ctx_out, ng + 4096, modl + 5 * 6144, 0, 1, U, F.bid - skip, F.G - skip, 0, 1); }
    else rows_phase(F, V, MT, V.out, H, V.out, H, (const bf16_t*)(V.big + B_FX), ng + 3072, modl, 5, true, ng + 4096, modl + 5 * 6144, 0, 1, U, F.bid, F.G, 1, 2);
}
__device__ __forceinline__ void ph_gemm_store(Frame F0, int which, int l) { const Frame F = uniform_frame(F0); const PView V = pview(F); which = RFL(which); l = RFL(l);
    unsigned char* ws = V.ws; unsigned char* big = V.big; const char* U = (const char*)(ws + WS_U); const int nMr = (l < DEPTH - 1 ? MT : ML) / 256;
    pg8::Sched S; pg8::EpiStore E; int K = 1024;
    S.A0 = U; S.A1 = U; S.A2 = U; S.A3 = U; S.lda = 1024; S.ldb = 1024; S.G = F.G; S.c = F.bid;
    if (which == 0) { S.B = (const char*)(ws + W_LSTM); S.nM = MT / 256; S.nN = NLSTM / 256; S.grp = S.nN; E.O = (bf16_t*)(big + B_PLSTM); E.ldc = NLSTM; }
    else if (which == 1) { S.B = (const char*)(ws + W_REST); S.nM = MT / 256; S.nN = NREST / 256; S.grp = S.nN; E.O = (bf16_t*)(big + B_PREST); E.ldc = NREST; }
    else if (which == 2) { const char* ys = (const char*)(big + B_YSB); S.A0 = (const char*)(big + B_YSA); S.A1 = ys; S.A2 = ys + YS_STRIDE; S.A3 = ys + 2 * YS_STRIDE; S.B = (const char*)(ws + W_B); S.lda = 512; S.ldb = 512;
        S.nM = nMr; S.nN = 16; S.grp = 4; E.O = (bf16_t*)(big + B_PROJ); E.ldc = PROJ_LD; K = 512; }
    else if (which == 3 || which == 8) { const size_t p0 = which == 8 ? (size_t)ML : 0;
        const char* a = (const char*)(big + B_MERGED) + p0 * 1024 * 2; S.A0 = a; S.A1 = a; S.A2 = a; S.A3 = a; S.B = (const char*)(ws + W_O); S.nM = which == 8 ? (MT - ML) / 256 : ML / 256; S.nN = 4; S.grp = 4; E.O = (bf16_t*)(big + B_MX) + p0 * 1024; E.ldc = 1024; }
    else { const size_t p0 = which == 7 ? (size_t)ML : 0;
        const char* a = (const char*)(big + B_ACT) + p0 * DFF * 2; S.A0 = a; S.A1 = a; S.A2 = a; S.A3 = a; S.B = (const char*)(ws + W_DN); S.lda = DFF; S.ldb = DFF; S.nM = which == 7 ? (MT - ML) / 256 : ML / 256; S.nN = 4; S.grp = 4;
        E.O = (bf16_t*)(big + B_FX) + p0 * 1024; E.ldc = 1024; K = DFF; }
    pg8::gemm_phase(F.lds, F.tid, K, S, E);
    if (l > 0 && which == 2) tail_prep(uniform_frame(F0), V, l, S.nM * S.nN, PREP_T4, PREP_T5, 0, 0, false);
}
__device__ __forceinline__ void ph_gemm_ffn(Frame F0, int l) { const Frame F = uniform_frame(F0); const PView V = pview(F); l = RFL(l);
    const char* U = (const char*)(V.ws + WS_U); const int nMr = (l < DEPTH - 1 ? MT : ML) / 256;
    pg8::Sched S{U, U, U, U, (const char*)(V.ws + W_UP), 1024, 1024, nMr, 22, 22, F.G, F.bid};
    pg8::EpiFfn E{(bf16_t*)(V.big + B_ACT), (float*)(V.big + B_HB), V.in(17) + (size_t)l * 3 * 5632, (LAS float*)(F.lds + 132096)};
    pg8::gemm_phase(F.lds, F.tid, 1024, S, E);
    if (l > 0) tail_prep(uniform_frame(F0), V, l, S.nM * S.nN, PREP_T5, PREP_NT, 0, 0, false);
    if (l < DEPTH - 1) tail_prep(uniform_frame(F0), V, l + 1, S.nM * S.nN, PREP_T1, PREP_T2, PREP_T3, PREP_T4, false);
}
__device__ __forceinline__ void ph_ffn_fix(Frame F0, int l) { const Frame F = uniform_frame(F0); const PView V = pview(F); l = RFL(l);
    const int nMr = (l < DEPTH - 1 ? MT : ML) / 256; const float* HB = (const float*)(V.big + B_HB); bf16_t* act = (bf16_t*)(V.big + B_ACT); const float* cw = V.in(17) + (size_t)l * 3 * 5632;
    const int ntask = nMr * 2 * 352;
#pragma unroll 1
    for (int t = F.bid * 512 + F.tid; t < ntask; t += F.G * 512) { const int chunk = t % 352, q = t / 352, which = q & 1, pm = q >> 1, c0 = chunk * 8;
        const bool first = pm >= 128 || (pm & 31) == 0, last = pm >= 128 || (pm & 31) == 31;
        const float* hp = HB + (size_t)pm * 4 * 5632;
        const float* rp = which == 0 ? (first ? nullptr : hp - 5632) : hp + 2 * 5632;
        const float* rc = which == 0 ? hp : hp + 3 * 5632;
        const float* rn = which == 0 ? hp + 5632 : (last ? nullptr : hp + 4 * 5632);
        float o[8];
#pragma unroll
        for (int half = 0; half < 2; ++half) { float res[2][4];
#pragma unroll
            for (int bj = 0; bj < 2; ++bj) { const int col = bj * 2816 + c0 + 4 * half; const f32x4 z = {0.f, 0.f, 0.f, 0.f};
                const f32x4 p = rp ? *(const f32x4*)(rp + col) : z, c = *(const f32x4*)(rc + col), n = rn ? *(const f32x4*)(rn + col) : z;
                const f32x4 w0 = *(const f32x4*)(cw + col), w1 = *(const f32x4*)(cw + 5632 + col), w2 = *(const f32x4*)(cw + 2 * 5632 + col);
#pragma unroll
                for (int j = 0; j < 4; ++j) res[bj][j] = w0[j] * p[j] + w1[j] * c[j] + w2[j] * n[j]; }
#pragma unroll
            for (int j = 0; j < 4; ++j) o[4 * half + j] = siluf_(res[0][j]) * res[1][j]; }
        *(u32x4*)(act + (size_t)(pm * 256 + (which ? 255 : 0)) * DFF + c0) = pack8(o); }
}
__device__ __forceinline__ void ph_gemm_merge(Frame F0, int l) { const Frame F = uniform_frame(F0); const PView V = pview(F); l = RFL(l);
    const char* U = (const char*)(V.ws + WS_U); const int nMr = (l < DEPTH - 1 ? MT : ML) / 256;
    pg8::Sched S{U, U, U, U, (const char*)(V.ws + W_GATE), 1024, 1024, nMr, 16, 16, F.G, F.bid};
    pg8::EpiMerge E{(const bf16_t*)(V.big + B_PROJ), (bf16_t*)(V.big + B_MERGED)}; pg8::gemm_phase(F.lds, F.tid, 1024, S, E);
    if (l < DEPTH - 1) tail_prep(uniform_frame(F0), V, l + 1, S.nM * S.nN, 0, PREP_T1, PREP_T2, PREP_T3, true);
}
__device__ __forceinline__ void ph_pass1(Frame F0, int l) { const Frame F = uniform_frame(F0); const PView V = pview(F); l = RFL(l);
    for (int u = F.G - 1 - F.bid; u < NCHAIN_UNITS / 2; u += F.G) lstm_pass1_unit(unit_frame(F), V, l, u); }
__device__ __forceinline__ void ph_scan(Frame F0) { const Frame F = uniform_frame(F0); const PView V = pview(F); lstm_scan(F, V); }
__device__ __forceinline__ void ph_pass2(Frame F0, int l) { const Frame F = uniform_frame(F0); const PView V = pview(F); l = RFL(l);
    const int nlat = NB * 4 * 32 * 2, nu = nlat + ((l < DEPTH - 1) ? NB * 4 * 2 : 0);
    for (int u = F.bid; u < nu; u += F.G) { const int qh = u & 1; int blk, bh;
        if (u < nlat) { const int r = u >> 1; blk = 1 + (r & 31); bh = r >> 5; } else { blk = 0; bh = (u - nlat) >> 1; }
        lstm_pass2_unit(unit_frame(F), V, l, bh >> 2, bh & 3, blk, qh); } }
__device__ __forceinline__ void ph_attn(Frame F0, int l) { const Frame F = uniform_frame(F0); const PView V = pview(F); l = RFL(l);
    { const f32x4* rt = (const f32x4*)(V.ws + WS_ROPE); LAS f32x4* rl = (LAS f32x4*)(F.lds + 36864); __syncthreads(); rl[F.tid] = rt[F.tid]; rl[512 + F.tid] = rt[512 + F.tid]; __syncthreads(); }
    const int nlat = NB * 2 * 128, nctx = (l < DEPTH - 1) ? NB * 2 * 4 : 0;
    for (int u = F.bid; u < nlat; u += F.G) attn_unit(unit_frame(F), V, l, false, u >> 8, (u >> 7) & 1, u & 127);
    for (int q = F.G - 1 - F.bid; q < nctx; q += F.G) attn_unit(unit_frame(F), V, l, true, q >> 3, (q >> 2) & 1, q & 3); }
__device__ __forceinline__ void ph_poolconv(Frame F0, int l) { const Frame F = uniform_frame(F0); const PView V = pview(F); l = RFL(l);
    const int Mrows = (l < DEPTH - 1) ? MT : ML; pool_tasks(F, V, Mrows); sconv_tasks(F, V, l, Mrows); }

__global__ void __launch_bounds__(512, 2) fwd(Params P) {
    extern __shared__ __attribute__((aligned(16))) unsigned char lds_raw[];
    Frame F; F.lds = (LAS unsigned char*)lds_raw; F.wave = __builtin_amdgcn_readfirstlane((int)threadIdx.x >> 6); F.tid = 0; F.lane = 0; F.G = gridDim.x; F.bid = blockIdx.x; F.P = &P;
    volatile LAS unsigned* ctlw = (volatile LAS unsigned*)(F.lds + LDS_WORK);
    { const int t0 = F.wave * 64 + hw_lane(); if (t0 < 16) ctlw[t0] = 0u; }
    __syncthreads();
    const size_t bar_off = WS_CTL + (size_t)P.bar_region * 16384;
    XcdBarrier bar; bar.bar = (unsigned*)(P.ws + bar_off); bar.x = 0; bar.st = ctlw;
    const int lo = P.ph_lo, hi = P.ph_hi;
    if (hi - lo > 1) bar = xcd_barrier_post((unsigned*)(P.ws + bar_off), ctlw, F.wave == 0 && hw_lane() == 0);
#define IN(k) (lo <= (k) && (k) < hi)
#pragma unroll 1
    for (int step = lo; step < hi; ++step) {
        const int l = step < 2 ? 0 : (step - 2) / PH_PER_LAYER, k = step < 2 ? step - 2 : (step - 2) % PH_PER_LAYER;
        if (l == DEPTH - 1 && k == 9) continue;
        switch (k) {
            case -2: if (KON(0)) ph_prologue(F); break;
            case -1: if (KON(1)) ph_rows(F, 0, 0); break;
            case 0: case 1: case 5: case 7: case 8: case 12: case 13:
                if (k == 1 && KON(3)) ph_pass1(F, l);
                if (KON(2) && !((k == 8 || k == 13) && l == DEPTH - 1)) ph_gemm_store(F, k == 0 ? 0 : (k == 1 ? 1 : (k == 5 ? 2 : (k == 7 ? 3 : (k == 8 ? 8 : (k == 12 ? 6 : 7))))), l);
                if ((k == 8 || k == 13) && KON(1)) ph_rows(F, k == 8 ? 1 : 2, l);
                break;
            case 10: if (KON(8)) ph_gemm_ffn(F, l); break;
            case 11: if (KON(8)) ph_ffn_fix(F, l); break;
            case 2: if (KON(4)) ph_scan(F); break;
            case 3: if (KON(5)) ph_pass2(F, l); break;
            case 4: if (KON(6)) ph_attn(F, l); if (KON(9)) ph_poolconv(F, l); break;
            case 6: if (KON(7)) ph_gemm_merge(F, l); break;
            default: if (KON(1)) ph_rows(F, k == 9 ? 4 : 3, l); break;
        }
        if (step + 1 < hi) { unsigned long long bp = (unsigned long long)(P.ws + bar_off); asm volatile("" : "+v"(bp)); bar.bar = (unsigned*)bp; xcd_barrier(bar, F.wave == 0 && hw_lane() == 0); }
    }
#undef IN
}

extern "C" void kernel_launch(void* const* d_in, const int* in_sizes, int n_in, void* d_out, int out_size, void* d_ws, size_t ws_size, hipStream_t stream) {
    static int grid = 0;
    if (grid == 0) {
        if (n_in != 19 || out_size != ML * D || ws_size < WS_END) { fprintf(stderr, "kernel_launch: need 19 inputs, out %d, ws >= %zu; got %d, %d, %zu\n", ML * D, (size_t)WS_END, n_in, out_size, ws_size); grid = -1; return; }
        int dev = 0, cus = 0, per_cu = 0;
        if (hipGetDevice(&dev) != hipSuccess || hipDeviceGetAttribute(&cus, hipDeviceAttributeMultiprocessorCount, dev) != hipSuccess) { grid = -1; return; }
        if (hipFuncSetAttribute((const void*)fwd, hipFuncAttributeMaxDynamicSharedMemorySize, LDS_BYTES) != hipSuccess) { fprintf(stderr, "kernel_launch: hipFuncSetAttribute failed\n"); grid = -1; return; }
        if (hipOccupancyMaxActiveBlocksPerMultiprocessor(&per_cu, (const void*)fwd, 512, LDS_BYTES) != hipSuccess || per_cu < 1) { fprintf(stderr, "kernel_launch: occupancy query says %d\n", per_cu); (void)hipGetLastError(); }
        grid = cus;
    }
    if (grid < 0) return;
    (void)hipMemsetAsync((char*)d_ws + WS_CTL, 0, 131072, stream);
    Params p{};
    for (int i = 0; i < 19; ++i) p.in[i] = (const float*)d_in[i];
    p.out = (float*)d_out; p.ws = (unsigned char*)d_ws;
#if MK_PER_PHASE
    for (int k = 0; k < N_PHASES; ++k) { p.ph_lo = k; p.ph_hi = k + 1; hipLaunchKernelGGL(fwd, dim3(grid), dim3(512), LDS_BYTES, stream, p); }
#elif defined(PROBE_K)
    { int lo = 0, reg = 0;
      for (int l = 0; l < DEPTH; ++l) { const int st = (PROBE_K < 0) ? PROBE_K + 2 : 2 + l * PH_PER_LAYER + PROBE_K; if (PROBE_K < 0 && l > 0) break;
          p.ph_lo = lo; p.ph_hi = st + 1; p.bar_region = reg++; hipLaunchKernelGGL(fwd, dim3(grid), dim3(512), LDS_BYTES, stream, p);
          for (int r = 0; r < PROBE_R; ++r) { p.ph_lo = st; p.ph_hi = st + 1; p.bar_region = 7; hipLaunchKernelGGL(fwd, dim3(grid), dim3(512), LDS_BYTES, stream, p); }
          lo = st + 1; }
      if (lo < N_PHASES) { p.ph_lo = lo; p.ph_hi = N_PHASES; p.bar_region = reg++; hipLaunchKernelGGL(fwd, dim3(grid), dim3(512), LDS_BYTES, stream, p); } }
#else
    p.ph_lo = 0; p.ph_hi = N_PHASES; p.bar_region = 0;
    hipLaunchKernelGGL(fwd, dim3(grid), dim3(512), LDS_BYTES, stream, p);
#endif
}
```

```cpp
#include <hip/hip_runtime.h>
#include <cstdio>
#include <cstdint>

#ifndef MK_PER_PHASE
#define MK_PER_PHASE 0
#endif

#ifndef MK_ONLY
#define MK_ONLY -1
#endif
#define KON(k) (MK_ONLY < 0 || MK_ONLY == (k))
#define LAS __attribute__((address_space(3)))
typedef unsigned short bf16_t;
typedef short bf16x8 __attribute__((ext_vector_type(8)));
typedef short s16x4 __attribute__((ext_vector_type(4)));
typedef float f32x4 __attribute__((ext_vector_type(4)));
typedef float f32x2 __attribute__((ext_vector_type(2)));
typedef unsigned u32x4 __attribute__((ext_vector_type(4)));
typedef unsigned u32x2 __attribute__((ext_vector_type(2)));
typedef __bf16 bf16v2 __attribute__((ext_vector_type(2)));

constexpr int D = 1024, NB = 4, SEQ = 8192, CTX = 256, DEPTH = 4;
constexpr int ML = NB * SEQ, MC = NB * CTX, MT = ML + MC;
constexpr int INW = 8976;
constexpr int NLSTM = 2304, NREST = 2816, NGATE = 4096, DFF = 2816, NUPH = 2816;
constexpr int PROJ_LD = 4160;
constexpr int NBLK = 33;
constexpr int NCHAIN_UNITS = NB * 4 * 2 * NBLK;
constexpr int ST_ELEMS = 129 * 128;
constexpr float EPS = 1e-6f;
constexpr int PR_POOL = 0, PR_AQ = 512, PR_AK = 1024, PR_AV = 1152, PR_SB = 1280, PR_SC = 1792, PR_SX = 2304;

constexpr size_t WS_CTL = 0;
constexpr size_t WS_MOD = 131072;
constexpr size_t WS_ROPE = WS_MOD + (size_t)DEPTH * 5 * 6144 * 4;
constexpr size_t WS_DEC = WS_ROPE + 128 * 16 * 2 * 4;
constexpr size_t WS_W = 1048576;
constexpr size_t W_LSTM = WS_W;
constexpr size_t W_REST = W_LSTM + (size_t)NLSTM * 1024 * 2;
constexpr size_t W_GATE = W_REST + (size_t)NREST * 1024 * 2;
constexpr size_t W_B = W_GATE + (size_t)NGATE * 1024 * 2;
constexpr size_t W_O = W_B + (size_t)4 * 1024 * 512 * 2;
constexpr size_t W_UP = W_O + (size_t)1024 * 1024 * 2;
constexpr size_t W_DN = W_UP + (size_t)2 * NUPH * 1024 * 2;
constexpr size_t WS_H = W_DN + (size_t)1024 * DFF * 2;
constexpr size_t WS_X = WS_H + (size_t)MC * 1024 * 4, WS_U = WS_X;
constexpr size_t WS_BIG = WS_U + (size_t)MT * 1024 * 2;
constexpr size_t YS_STRIDE = (size_t)MT * 512 * 2;
constexpr size_t B_PLSTM = 0;
constexpr size_t B_ST = (size_t)MT * NLSTM * 2;
constexpr size_t B_PREST = B_ST + (size_t)NCHAIN_UNITS * ST_ELEMS * 2;
constexpr size_t B_YSB = 0;
constexpr size_t B_PROJ = 3 * YS_STRIDE;
constexpr size_t B_YSA = B_PROJ + (size_t)MT * PROJ_LD * 2;
constexpr size_t B_MERGED = 0, B_MX = B_PROJ, B_ACT = (size_t)MT * NUPH * 2, B_FX = 0;
constexpr size_t B_HB = B_ACT + (size_t)MT * DFF * 2;
constexpr size_t B_GT = B_HB + 1048576;
constexpr size_t BIG_BYTES = B_YSA + YS_STRIDE;
constexpr size_t WS_END = WS_BIG + BIG_BYTES;
static_assert(B_PREST + (size_t)MT * NREST * 2 <= B_YSA && B_PREST % 256 == 0 && B_PROJ % 256 == 0 && B_YSA % 256 == 0, "layout");
static_assert(B_HB + (size_t)(MT / 256) * 4 * 5632 * 4 <= BIG_BYTES && B_GT >= B_PREST + (size_t)MT * NREST * 2 && B_GT + (size_t)NCHAIN_UNITS * 512 * 4 <= B_YSA, "act + halo rows overflow / gate table placement");
static_assert(W_LSTM % 256 == 0 && WS_U % 256 == 0 && WS_BIG % 256 == 0, "alignment");

constexpr int LDS_WORK = 155648;
constexpr int LDS_BYTES = LDS_WORK + 256;

struct Params { const float* in[19]; float* out; unsigned char* ws; int ph_lo, ph_hi, bar_region, pad; };

__device__ __forceinline__ float bf2f(bf16_t b) { return __uint_as_float(((unsigned)b) << 16); }
__device__ __forceinline__ unsigned pk2(float lo, float hi) { f32x2 v = {lo, hi}; bf16v2 r = __builtin_convertvector(v, bf16v2); return __builtin_bit_cast(unsigned, r); }
__device__ __forceinline__ bf16_t f2bf(float f) { return (bf16_t)(pk2(f, 0.f) & 0xffffu); }
__device__ __forceinline__ float lo16(unsigned w) { return __uint_as_float(w << 16); }
__device__ __forceinline__ float hi16(unsigned w) { return __uint_as_float(w & 0xffff0000u); }
__device__ __forceinline__ void unpack8(const u32x4 v, float (&f)[8]) { f[0] = lo16(v.x); f[1] = hi16(v.x); f[2] = lo16(v.y); f[3] = hi16(v.y); f[4] = lo16(v.z); f[5] = hi16(v.z); f[6] = lo16(v.w); f[7] = hi16(v.w); }
__device__ __forceinline__ u32x4 pack8(const float (&f)[8]) { u32x4 r; r.x = pk2(f[0], f[1]); r.y = pk2(f[2], f[3]); r.z = pk2(f[4], f[5]); r.w = pk2(f[6], f[7]); return r; }
__device__ __forceinline__ float sigmoidf_(float x) { return 1.0f / (1.0f + __expf(-x)); }
__device__ __forceinline__ float siluf_(float x) { return x / (1.0f + __expf(-x)); }
__device__ __forceinline__ float logsigmoidf_(float x) { return fminf(x, 0.f) - __logf(1.0f + __expf(-fabsf(x))); }
__device__ __forceinline__ float lshfl(float v, int src) { return __int_as_float(__builtin_amdgcn_ds_bpermute(src << 2, __float_as_int(v))); }
__device__ __forceinline__ float wave_sum(float v, int lane) {
#pragma unroll
    for (int o = 32; o >= 1; o >>= 1) v += lshfl(v, lane ^ o);
    return v; }
__device__ __forceinline__ u32x4 ldg16(const bf16_t* p) { return *(const u32x4*)p; }
#define MFMA16(a, b, c) __builtin_amdgcn_mfma_f32_16x16x32_bf16((a), (b), (c), 0, 0, 0)

__device__ __forceinline__ int hw_lane() { int l; asm volatile("v_mbcnt_lo_u32_b32 %0, -1, 0\n\tv_mbcnt_hi_u32_b32 %0, -1, %0" : "=v"(l)); return l; }
#define XB_TMO      128
#define XB_XCNT(j)  (256  + 64 * (j))
#define XB_XSUB(j)  (1280 + 64 * (j))
#define XB_XGEN(j)  (2304 + 64 * (j))
#define XB_TOP      3328
#define XB_TOPGEN   3392
#define XCD_BAR_WORDS 3456
#define XB_SPIN_CAP (1u << 22)
__device__ __forceinline__ unsigned xb_ld(unsigned* p)              { return __hip_atomic_load(p, __ATOMIC_RELAXED, __HIP_MEMORY_SCOPE_AGENT); }
__device__ __forceinline__ unsigned xb_add(unsigned* p, unsigned v) { return __hip_atomic_fetch_add(p, v, __ATOMIC_RELAXED, __HIP_MEMORY_SCOPE_AGENT); }
__device__ __forceinline__ unsigned xb_xcc_id() { return (unsigned)__builtin_amdgcn_s_getreg((3 << 11) | 20) & 0xFu; }
#define XB_SPIN(cond, bar) do { unsigned _sp = 0; while (cond) { __builtin_amdgcn_s_sleep(1); \
    if ((++_sp & 255u) == 0u) { if (xb_ld(&(bar)[XB_TMO])) break; if (_sp > XB_SPIN_CAP) { atomicAdd(&(bar)[XB_TMO], 1u); break; } } } } while (0)
struct XcdBarrier { unsigned* bar; unsigned x; volatile LAS unsigned* st; };
__device__ __forceinline__ XcdBarrier xcd_barrier_post(unsigned* bar, volatile LAS unsigned* st, bool leader) {
    XcdBarrier b; b.bar = bar; b.x = xb_xcc_id(); b.st = st;
    if (leader) (void)xb_add(&bar[XB_XCNT(b.x)], 1u);
    return b;
}
__device__ __forceinline__ void xcd_barrier_complete(unsigned* bar, unsigned x, unsigned& nloc, unsigned& nx) {
    const unsigned G = gridDim.x * gridDim.y * gridDim.z;
    unsigned sum, cnt, mine, sp = 0u;
    for (;;) {
        sum = 0u; cnt = 0u; mine = 0u;
#pragma unroll
        for (unsigned j = 0; j < 16; ++j) { const unsigned c = xb_ld(&bar[XB_XCNT(j)]); sum += c; cnt += (c > 0u) ? 1u : 0u; }
        mine = xb_ld(&bar[XB_XCNT(x)]);
        if (sum == G) break;
        __builtin_amdgcn_s_sleep(1);
        if ((++sp & 255u) == 0u) { if (xb_ld(&bar[XB_TMO])) break; if (sp > XB_SPIN_CAP) { atomicAdd(&bar[XB_TMO], 1u); break; } }
    }
    nloc = mine > 0u ? mine : 1u; nx = cnt > 0u ? cnt : 1u;
}
__device__ __forceinline__ void xcd_barrier(const XcdBarrier& b, bool leader) {
    asm volatile("s_waitcnt vmcnt(0)" ::: "memory");
    __syncthreads();
    if (leader) {
        unsigned* bar = b.bar;
        __builtin_amdgcn_s_waitcnt(0);
        unsigned nloc = b.st[0], nx = b.st[1];
        if (nloc == 0u) { xcd_barrier_complete(bar, b.x, nloc, nx); b.st[0] = nloc; b.st[1] = nx; }
        const unsigned old = xb_add(&bar[XB_XSUB(b.x)], 1u);
        const unsigned gen = old / nloc;
        if (old + 1u == (gen + 1u) * nloc) {
            __builtin_amdgcn_fence(__ATOMIC_RELEASE, "agent");
            asm volatile("s_waitcnt vmcnt(0)" ::: "memory");
            const unsigned og = xb_add(&bar[XB_TOP], 1u);
            const unsigned tg = og / nx;
            if (og + 1u == (tg + 1u) * nx) xb_add(&bar[XB_TOPGEN], 1u);
            else XB_SPIN(xb_ld(&bar[XB_TOPGEN]) == tg, bar);
            __builtin_amdgcn_fence(__ATOMIC_ACQUIRE, "agent");
            xb_add(&bar[XB_XGEN(b.x)], 1u);
            asm volatile("s_waitcnt vmcnt(0)" ::: "memory");
        } else {
            XB_SPIN(xb_ld(&bar[XB_XGEN(b.x)]) == gen, bar);
            __builtin_amdgcn_fence(__ATOMIC_ACQUIRE, "agent");
            asm volatile("s_waitcnt vmcnt(0)" ::: "memory");
        }
    }
    __syncthreads();
}

namespace pg8 {
constexpr int BM = 256, BK = 64, HALF = 128, HTB = HALF * BK * 2, STAGE_BYTES = 8 * HTB, NXCD = 8, WGM = 8;
__device__ __forceinline__ int lds_byte(int r, int c) { const int st = (r >> 4) * 2 + (c >> 5), rr = r & 15, cc = c & 31, ob = rr * 64 + cc * 2; return st * 1024 + (ob ^ (((ob >> 9) & 1) << 5)); }
__device__ __forceinline__ void stage_rc(int b, int& R, int& C) { const int st = b / 1024, sb = b % 1024, swz = sb ^ (((sb >> 9) & 1) << 5); R = (st >> 1) * 16 + swz / 64; C = (st & 1) * 32 + (swz % 64) / 2; }
__device__ __forceinline__ int perm32(int rho) { const int n = rho >> 4, i = rho & 15; return 8 * (i >> 2) + 4 * n + (i & 3); }
struct Unit { const char* a; const char* b; int orow, ocol; };
struct Sched {
    const char* A0; const char* A1; const char* A2; const char* A3; const char* B;
    int lda, ldb, nM, nN, grp, G, c;
    __device__ __forceinline__ bool next(int i, Unit& u) const {
        const int nwg = nM * nN; const int L = i * G + c; if (L >= nwg) return false;
        int wgid = L; { const int q = nwg / NXCD, r = nwg % NXCD, xcd = wgid % NXCD, off = wgid / NXCD; wgid = (xcd < r ? xcd * (q + 1) : r * (q + 1) + (xcd - r) * q) + off; }
        const int nig = WGM * nN, gid = wgid / nig, fm = gid * WGM, gsz = (nM - fm) < WGM ? (nM - fm) : WGM;
        const int pm = fm + ((wgid % nig) % gsz), pn = (wgid % nig) / gsz;
        const int ag = pn / grp; const char* ab = ag == 0 ? A0 : (ag == 1 ? A1 : (ag == 2 ? A2 : A3));
        u.a = ab + (size_t)pm * BM * lda * 2; u.b = B + (size_t)pn * BM * ldb * 2; u.orow = pm * BM; u.ocol = pn * BM; return true;
    }
};
struct EpiStore {
    static constexpr bool PERM = true, QUAD = true;
    template <int AI, int BJ> __device__ __forceinline__ void quad(const f32x4 (&acc)[2][2][4][2], const Unit& u, int wr, int wc, int fr, int fq) const {
        const int row0 = u.orow + wr * 64 + fr + AI * HALF, col0 = u.ocol + wc * 32 + 8 * fq + BJ * HALF;
#pragma unroll
        for (int m = 0; m < 4; ++m) { const f32x4 v0 = acc[AI][BJ][m][0], v1 = acc[AI][BJ][m][1];
            u32x4 w; w.x = pk2(v0[0], v0[1]); w.y = pk2(v0[2], v0[3]); w.z = pk2(v1[0], v1[1]); w.w = pk2(v1[2], v1[3]);
            *(u32x4*)(O + (size_t)(row0 + m * 16) * ldc + col0) = w; }
    }
    bf16_t* O; int ldc;
    __device__ __forceinline__ void operator()(const f32x4 (&acc)[2][2][4][2], const Unit& u, int wr, int wc, int fr, int fq) const {
        const int row0 = u.orow + wr * 64 + fr, col0 = u.ocol + wc * 32 + 8 * fq;
#pragma unroll
        for (int ai = 0; ai < 2; ++ai)
#pragma unroll
            for (int m = 0; m < 4; ++m) { bf16_t* rowp = O + (size_t)(row0 + ai * HALF + m * 16) * ldc + col0;
#pragma unroll
                for (int bj = 0; bj < 2; ++bj) { const f32x4 v0 = acc[ai][bj][m][0], v1 = acc[ai][bj][m][1];
                    u32x4 w; w.x = pk2(v0[0], v0[1]); w.y = pk2(v0[2], v0[3]); w.z = pk2(v1[0], v1[1]); w.w = pk2(v1[2], v1[3]);
                    *(u32x4*)(rowp + bj * HALF) = w; } }
    }
};
struct EpiMerge {
    static constexpr bool PERM = false, QUAD = false;
    const bf16_t* PROJ; bf16_t* O;
    __device__ __forceinline__ void operator()(f32x4 (&acc)[2][2][4][2], const Unit& u, int wr, int wc, int fr, int fq) const {
        const int row0 = u.orow + wr * 64 + fr, d0 = (u.ocol >> 8) * 64 + wc * 16 + 4 * fq;
        u32x2 pv[2][4][4];
#pragma unroll
        for (int ai = 0; ai < 2; ++ai)
#pragma unroll
            for (int m = 0; m < 4; ++m) { const bf16_t* pp = PROJ + (size_t)(row0 + ai * HALF + m * 16) * PROJ_LD + d0;
#pragma unroll
                for (int nb = 0; nb < 4; ++nb) pv[ai][m][nb] = *(const u32x2*)(pp + nb * 1024); }
        __builtin_amdgcn_sched_barrier(0);
#pragma unroll
        for (int ai = 0; ai < 2; ++ai)
#pragma unroll
            for (int bj = 0; bj < 2; ++bj)
#pragma unroll
                for (int m = 0; m < 4; ++m)
#pragma unroll
                    for (int n = 0; n < 2; ++n) { f32x4 a = acc[ai][bj][m][n]; a[0] = sigmoidf_(a[0]); a[1] = sigmoidf_(a[1]); a[2] = sigmoidf_(a[2]); a[3] = sigmoidf_(a[3]); acc[ai][bj][m][n] = a; }
        __builtin_amdgcn_sched_barrier(0);
#pragma unroll
        for (int ai = 0; ai < 2; ++ai)
#pragma unroll
            for (int m = 0; m < 4; ++m) { f32x4 s = {0.f, 0.f, 0.f, 0.f};
#pragma unroll
                for (int bj = 0; bj < 2; ++bj)
#pragma unroll
                    for (int n = 0; n < 2; ++n) { const u32x2 p2 = pv[ai][m][2 * bj + n]; const f32x4 a = acc[ai][bj][m][n];
                        s[0] += a[0] * lo16(p2.x); s[1] += a[1] * hi16(p2.x); s[2] += a[2] * lo16(p2.y); s[3] += a[3] * hi16(p2.y); }
                u32x2 w; w.x = pk2(s[0], s[1]); w.y = pk2(s[2], s[3]);
                *(u32x2*)(O + (size_t)(row0 + ai * HALF + m * 16) * 1024 + d0) = w; }
    }
};

__device__ __forceinline__ float dpp_prev_keep(float edge, float cur) { return __int_as_float(__builtin_amdgcn_update_dpp(__float_as_int(edge), __float_as_int(cur), 0x111, 0xf, 0xf, false)); }
__device__ __forceinline__ float dpp_next_keep(float edge, float cur) { return __int_as_float(__builtin_amdgcn_update_dpp(__float_as_int(edge), __float_as_int(cur), 0x101, 0xf, 0xf, false)); }
__device__ __forceinline__ float dpp_ror1(float v) { return __int_as_float(__builtin_amdgcn_update_dpp(0, __float_as_int(v), 0x121, 0xf, 0xf, true)); }
__device__ __forceinline__ float dpp_ror15(float v) { return __int_as_float(__builtin_amdgcn_update_dpp(0, __float_as_int(v), 0x12f, 0xf, 0xf, true)); }
struct EpiFfn {
    static constexpr bool PERM = true, QUAD = false;
    bf16_t* act; float* HB; const float* cw; LAS float* XB;
    __device__ __forceinline__ void operator()(f32x4 (&acc)[2][2][4][2], const Unit& u, int wr, int wc, int fr, int fq) const {
        asm volatile("" : "+v"(fr), "+v"(fq));
        const int pm = u.orow >> 8, pt = u.ocol >> 8, ch0 = pt * 128 + wc * 32 + 8 * fq, wv = wr * 4 + wc;
#pragma unroll
        for (int ai = 0; ai < 2; ++ai) {
            if (fr == 0) { LAS f32x4* d = (LAS f32x4*)(XB + (((wv * 4) + ai * 2 + 0) * 4 + fq) * 16); d[0] = acc[ai][0][0][0]; d[1] = acc[ai][0][0][1]; d[2] = acc[ai][1][0][0]; d[3] = acc[ai][1][0][1]; }
            if (fr == 15) { LAS f32x4* d = (LAS f32x4*)(XB + (((wv * 4) + ai * 2 + 1) * 4 + fq) * 16); d[0] = acc[ai][0][3][0]; d[1] = acc[ai][0][3][1]; d[2] = acc[ai][1][3][0]; d[3] = acc[ai][1][3][1]; } }
        if (wr == 0 && fr < 2) { float* h = HB + ((size_t)pm * 4 + fr) * 5632 + ch0;
            *(f32x4*)h = acc[0][0][0][0]; *(f32x4*)(h + 4) = acc[0][0][0][1]; *(f32x4*)(h + 2816) = acc[0][1][0][0]; *(f32x4*)(h + 2820) = acc[0][1][0][1]; }
        if (wr == 1 && fr >= 14) { float* h = HB + ((size_t)pm * 4 + (fr - 12)) * 5632 + ch0;
            *(f32x4*)h = acc[1][0][3][0]; *(f32x4*)(h + 4) = acc[1][0][3][1]; *(f32x4*)(h + 2816) = acc[1][1][3][0]; *(f32x4*)(h + 2820) = acc[1][1][3][1]; }
        asm volatile("s_waitcnt lgkmcnt(0)" ::: "memory"); __builtin_amdgcn_s_barrier(); asm volatile("" ::: "memory");
        __builtin_amdgcn_s_barrier(); asm volatile("" ::: "memory");
#pragma unroll
        for (int bj = 0; bj < 2; ++bj)
#pragma unroll
            for (int nn = 0; nn < 2; ++nn) {
                const f32x4 w0 = *(const f32x4*)(cw + bj * 2816 + ch0 + 4 * nn), w1 = *(const f32x4*)(cw + 5632 + bj * 2816 + ch0 + 4 * nn), w2 = *(const f32x4*)(cw + 2 * 5632 + bj * 2816 + ch0 + 4 * nn);
#pragma unroll
                for (int ai = 0; ai < 2; ++ai) {
                    f32x4 xp = {0.f, 0.f, 0.f, 0.f}, xn = xp;
                    if (wr == 1 || ai == 1) { const int swv = wr == 1 ? wc : 4 + wc, sslot = wr == 1 ? ai * 2 + 1 : 1; xp = *(const LAS f32x4*)(XB + (((swv * 4) + sslot) * 4 + fq) * 16 + bj * 8 + nn * 4); }
                    if (wr == 0 || ai == 0) { const int swv = wr == 0 ? 4 + wc : wc, sslot = wr == 0 ? ai * 2 : 2; xn = *(const LAS f32x4*)(XB + (((swv * 4) + sslot) * 4 + fq) * 16 + bj * 8 + nn * 4); }
                    f32x4 po = xp;
#pragma unroll
                    for (int m = 0; m < 4; ++m) { const f32x4 c = acc[ai][bj][m][nn]; f32x4 rr;
#pragma unroll
                        for (int j = 0; j < 4; ++j) {
                            const float pe = m > 0 ? dpp_ror1(po[j]) : xp[j];
                            const float ne = m < 3 ? dpp_ror15(acc[ai][bj][m < 3 ? m + 1 : 3][nn][j]) : xn[j];
                            const float pv = dpp_prev_keep(pe, c[j]), nv = dpp_next_keep(ne, c[j]);
                            rr[j] = w0[j] * pv + w1[j] * c[j] + w2[j] * nv; }
                        asm volatile("" : "+v"(rr[0]), "+v"(rr[1]), "+v"(rr[2]), "+v"(rr[3]));
                        po = c; acc[ai][bj][m][nn] = rr; }
                    __builtin_amdgcn_sched_barrier(0);
                }
            }
        const int row0 = u.orow + wr * 64 + fr;
#pragma unroll
        for (int ai = 0; ai < 2; ++ai)
#pragma unroll
            for (int m = 0; m < 4; ++m) { const f32x4 g0 = acc[ai][0][m][0], g1 = acc[ai][0][m][1], v0 = acc[ai][1][m][0], v1 = acc[ai][1][m][1];
                u32x4 o; o.x = pk2(siluf_(g0[0]) * v0[0], siluf_(g0[1]) * v0[1]); o.y = pk2(siluf_(g0[2]) * v0[2], siluf_(g0[3]) * v0[3]);
                o.z = pk2(siluf_(g1[0]) * v1[0], siluf_(g1[1]) * v1[1]); o.w = pk2(siluf_(g1[2]) * v1[2], siluf_(g1[3]) * v1[3]);
                *(u32x4*)(act + (size_t)(row0 + ai * HALF + m * 16) * DFF + ch0) = o; __builtin_amdgcn_sched_barrier(0); }
    }
};

template <class Epi>
__device__ __forceinline__ void gemm_phase(LAS unsigned char* lds, const int tid, const int K, const Sched& S, const Epi& E) {
    const int wid = __builtin_amdgcn_readfirstlane(tid >> 6), lane = tid & 63, wr = wid >> 2, wc = wid & 3, fr = lane & 15, fq = lane >> 4;
    const int nt = K / BK; const int lda = S.lda, ldb = S.ldb;
    unsigned voffA, voffB; { int R, C; stage_rc(tid * 16, R, C); const int Rb = Epi::PERM ? ((R & ~31) + perm32(R & 31)) : R;
        voffA = (unsigned)(R * lda + C) * 2u; voffB = (unsigned)(Rb * ldb + C) * 2u; }
    const unsigned skipoffA = (unsigned)(64 * lda * 2), skipoffB = (unsigned)(64 * ldb * 2);
    constexpr unsigned kstep = BK * 2;
    const unsigned hstepA = (unsigned)(HALF * lda * 2), hstepB = (unsigned)(HALF * ldb * 2);
    const unsigned ldsw = (unsigned)wid * 1024u;
    const int aoff = lds_byte(wr * 64 + fr, fq * 8), boff = lds_byte(wc * 32 + fr, fq * 8);
#define PG8_SA(b, h) (((b) * 2 + (h)) * HTB)
#define PG8_SB(b, h) ((4 + (b) * 2 + (h)) * HTB)
#define PG8_STAGE(bufoff, gbase, voff) do { _Pragma("unroll") for (int _i = 0; _i < 2; ++_i) \
        __builtin_amdgcn_global_load_lds((const unsigned*)((const char*)(gbase) + (_i ? skip##voff : 0u) + (v##voff)), (LAS unsigned*)(lds + (bufoff) + ldsw + _i * 8192), 16, 0, 0); } while (0)
#define PG8_LDA(dst, b, h) do { _Pragma("unroll") for (int m = 0; m < 4; ++m) _Pragma("unroll") for (int k = 0; k < 2; ++k) dst[m][k] = *(const LAS bf16x8*)(lds + PG8_SA(b, h) + aoff + m * 2048 + k * 1024); } while (0)
#define PG8_LDB(dst, b, h) do { _Pragma("unroll") for (int n = 0; n < 2; ++n) _Pragma("unroll") for (int k = 0; k < 2; ++k) dst[n][k] = *(const LAS bf16x8*)(lds + PG8_SB(b, h) + boff + n * 2048 + k * 1024); } while (0)
#define PG8_MMA(ai, bj, At, Bt) do { __builtin_amdgcn_s_setprio(1); _Pragma("unroll") for (int m = 0; m < 4; ++m) _Pragma("unroll") for (int n = 0; n < 2; ++n) _Pragma("unroll") for (int k = 0; k < 2; ++k) \
        acc[ai][bj][m][n] = __builtin_amdgcn_mfma_f32_16x16x32_bf16(Bt[n][k], At[m][k], acc[ai][bj][m][n], 0, 0, 0); __builtin_amdgcn_s_setprio(0); } while (0)
#define PG8_WAIT_V(n) asm volatile("s_waitcnt vmcnt(" #n ")" ::: "memory")
#define PG8_WAIT_L(n) asm volatile("s_waitcnt lgkmcnt(" #n ")" ::: "memory")
#define PG8_BAR __builtin_amdgcn_s_barrier()
#define PG8_SCHED __builtin_amdgcn_sched_barrier(0)
#define PG8_MMAZ(Z, ai, bj, At, Bt) do { __builtin_amdgcn_s_setprio(1); _Pragma("unroll") for (int m = 0; m < 4; ++m) _Pragma("unroll") for (int n = 0; n < 2; ++n) _Pragma("unroll") for (int k = 0; k < 2; ++k) \
        acc[ai][bj][m][n] = __builtin_amdgcn_mfma_f32_16x16x32_bf16(Bt[n][k], At[m][k], ((Z) && k == 0) ? (f32x4){0.f, 0.f, 0.f, 0.f} : acc[ai][bj][m][n], 0, 0, 0); __builtin_amdgcn_s_setprio(0); } while (0)
#define PG8_TRIP(FIRST, LAST) do { PG8_SCHED; asm volatile("" : "+v"(voffA), "+v"(voffB));     \
        const char* a1 = cur.a + (unsigned)(t + 1) * kstep; \
        const char* a2 = (LAST) ? nA : cur.a + (unsigned)(t + 2) * kstep; const char* b2 = (LAST) ? nB : cur.b + (unsigned)(t + 2) * kstep; \
        const char* a3 = a2 + kstep; const char* b3 = b2 + kstep; \
        PG8_LDB(B0, 0, 0); PG8_SCHED; PG8_LDA(At, 0, 0); PG8_STAGE(PG8_SA(1, 1), a1 + hstepA, offA); \
        PG8_WAIT_L(8); PG8_BAR; PG8_WAIT_L(0); PG8_MMAZ(FIRST, 0, 0, At, B0); PG8_BAR; PG8_SCHED; \
        PG8_LDB(B1, 0, 1); PG8_STAGE(PG8_SB(0, 0), b2, offB); \
        PG8_BAR; PG8_WAIT_L(0); PG8_MMAZ(FIRST, 0, 1, At, B1); PG8_BAR; \
        PG8_LDA(At, 0, 1); PG8_STAGE(PG8_SA(0, 0), a2, offA); \
        PG8_BAR; PG8_WAIT_L(0); PG8_MMAZ(FIRST, 1, 0, At, B0); PG8_BAR; PG8_SCHED; \
        PG8_STAGE(PG8_SB(0, 1), b2 + hstepB, offB); \
        PG8_WAIT_V(6); PG8_BAR; PG8_MMAZ(FIRST, 1, 1, At, B1); PG8_BAR; \
        PG8_LDB(B0, 1, 0); PG8_SCHED; PG8_LDA(At, 1, 0); PG8_STAGE(PG8_SA(0, 1), a2 + hstepA, offA); \
        PG8_WAIT_L(8); PG8_BAR; PG8_WAIT_L(0); PG8_MMA(0, 0, At, B0); PG8_BAR; PG8_SCHED; \
        PG8_LDB(B1, 1, 1); PG8_STAGE(PG8_SB(1, 0), b3, offB); \
        PG8_BAR; PG8_WAIT_L(0); PG8_MMA(0, 1, At, B1); if constexpr ((LAST) && Epi::QUAD) { const int l_ = hw_lane(); E.template quad<0, 0>(acc, cur, wr, wc, l_ & 15, l_ >> 4); }; PG8_BAR; \
        PG8_LDA(At, 1, 1); PG8_STAGE(PG8_SA(1, 0), a3, offA); \
        PG8_BAR; PG8_WAIT_L(0); PG8_MMA(1, 0, At, B0); if constexpr ((LAST) && Epi::QUAD) { const int l_ = hw_lane(); E.template quad<0, 1>(acc, cur, wr, wc, l_ & 15, l_ >> 4); }; PG8_BAR; PG8_SCHED; \
        PG8_STAGE(PG8_SB(1, 1), b3 + hstepB, offB); \
        if constexpr ((LAST) && Epi::QUAD) PG8_WAIT_V(14); else PG8_WAIT_V(6); \
        PG8_BAR; PG8_MMA(1, 1, At, B1); if constexpr ((LAST) && Epi::QUAD) { const int l_ = hw_lane(); E.template quad<1, 0>(acc, cur, wr, wc, l_ & 15, l_ >> 4); }; PG8_BAR; PG8_SCHED; \
    } while (0)
    Unit cur, nxt; int ui = 0;
    if (!S.next(0, cur)) return;
    f32x4 acc[2][2][4][2];
    bf16x8 At[4][2], B0[2][2], B1[2][2];
    PG8_STAGE(PG8_SB(0, 0), cur.b, offB); PG8_STAGE(PG8_SA(0, 0), cur.a, offA); PG8_STAGE(PG8_SB(0, 1), cur.b + hstepB, offB); PG8_STAGE(PG8_SA(0, 1), cur.a + hstepA, offA);
    if (wr == 1) PG8_BAR;
    PG8_WAIT_V(4); PG8_BAR;
    PG8_STAGE(PG8_SB(1, 0), cur.b + kstep, offB); PG8_STAGE(PG8_SA(1, 0), cur.a + kstep, offA); PG8_STAGE(PG8_SB(1, 1), cur.b + hstepB + kstep, offB);
    PG8_WAIT_V(6); PG8_BAR;
    for (;;) {
        const bool has_next = S.next(ui + 1, nxt);
        const char* nA = has_next ? nxt.a : cur.a; const char* nB = has_next ? nxt.b : cur.b;
        { const int t = 0; PG8_TRIP(true, false); }
        for (int t = 2; t < nt - 2; t += 2) PG8_TRIP(false, false);
        { const int t = nt - 2; PG8_TRIP(false, true); }
        { const int l_ = hw_lane(); if constexpr (Epi::QUAD) E.template quad<1, 1>(acc, cur, wr, wc, l_ & 15, l_ >> 4); else E(acc, cur, wr, wc, l_ & 15, l_ >> 4); }
        if (!has_next) break;
        cur = nxt; ++ui;
    }
    PG8_WAIT_V(0);
    if (wr == 0) PG8_BAR;
    PG8_BAR;
#undef PG8_SA
#undef PG8_SB
#undef PG8_STAGE
#undef PG8_LDA
#undef PG8_LDB
#undef PG8_MMA
#undef PG8_MMAZ
#undef PG8_TRIP
#undef PG8_WAIT_V
#undef PG8_WAIT_L
#undef PG8_BAR
#undef PG8_SCHED
}
}

struct Frame { LAS unsigned char* lds; int tid, lane, wave, G, bid; const Params* P; };
struct PView {
    const Params* p; unsigned char* ws; unsigned char* big; float* out;
    __device__ __forceinline__ const float* in(int k) const { return p->in[k]; }
};
__device__ __forceinline__ PView pview(const Frame& F) { PView v; v.p = F.P; v.out = F.P->out; v.ws = F.P->ws; v.big = v.ws + WS_BIG; return v; }
__device__ __forceinline__ Frame uniform_frame(Frame F) {
    int wv = F.wave, g = F.G, b = F.bid; unsigned lb = (unsigned)(size_t)F.lds;
    asm volatile("" : "+s"(wv), "+s"(g), "+s"(b), "+s"(lb));
    int t = wv * 64 + hw_lane(); asm volatile("" : "+v"(t));
    F.tid = t; F.lane = t & 63; F.wave = wv; F.G = g; F.bid = b; F.lds = (LAS unsigned char*)(size_t)lb; return F; }
#define RFL(x) __builtin_amdgcn_readfirstlane(x)
__device__ __forceinline__ Frame unit_frame(Frame F) { int t = F.tid; asm volatile("" : "+v"(t)); F.tid = t; F.lane = t & 63; return F; }

__device__ __forceinline__ void mod_unit(const Frame& F, const PView& V, int l, int nt) {
    LAS float* sc = (LAS float*)F.lds; LAS float* red = sc + 5 * 1024;
    const float* c = V.in(1); const float* cc = V.in(3);
    __syncthreads();
    for (int i = F.tid; i < 5 * 1024; i += 512) { const float v = i < 4096 ? c[i] : cc[i - 4096]; sc[i] = siluf_(v); }
    __syncthreads();
    const int nl = F.tid & 63, kg = F.tid >> 6, n = nt * 64 + nl;
    const float* w = V.in(4) + (size_t)l * 1024 * 6144 + n;
    float a0 = 0.f, a1 = 0.f, a2 = 0.f, a3 = 0.f, a4 = 0.f;
    for (int k = kg * 128; k < kg * 128 + 128; ++k) { const float wv = w[(size_t)k * 6144];
        a0 += sc[k] * wv; a1 += sc[1024 + k] * wv; a2 += sc[2048 + k] * wv; a3 += sc[3072 + k] * wv; a4 += sc[4096 + k] * wv; }
    red[(kg * 5 + 0) * 64 + nl] = a0; red[(kg * 5 + 1) * 64 + nl] = a1; red[(kg * 5 + 2) * 64 + nl] = a2; red[(kg * 5 + 3) * 64 + nl] = a3; red[(kg * 5 + 4) * 64 + nl] = a4;
    __syncthreads();
    if (F.tid < 320) { const int bi = F.tid >> 6; float s = 0.f;
#pragma unroll
        for (int g = 0; g < 8; ++g) s += red[(g * 5 + bi) * 64 + nl];
        float* mod = (float*)(V.ws + WS_MOD);
        mod[((size_t)l * 5 + bi) * 6144 + n] = s + V.in(5)[(size_t)l * 6144 + n]; }
}
__device__ __forceinline__ void rope_table(const Frame& F, const PView& V) {
    float* rt = (float*)(V.ws + WS_ROPE);
    for (int i = F.tid; i < 128 * 16; i += 512) { const int pos = i >> 4, f = i & 15;
        const float inv = powf(10000.0f, -(float)f / 16.0f); const float ang = (float)pos * inv;
        rt[2 * i] = cosf(ang); rt[2 * i + 1] = sinf(ang); }
}
__device__ __forceinline__ int srcmap(int kind, int n) {
    switch (kind) {
        case 0: return n < 2048 ? n : (n < 2064 ? n : -1);
        case 1: return 2064 + n;
        case 2: { const int dt = n >> 8, c = n & 255, bj = c >> 7, wc = (c >> 5) & 3, nn = (c >> 4) & 1, fq = (c >> 2) & 3, j = c & 3;
                  return 4880 + (2 * bj + nn) * 1024 + dt * 64 + wc * 16 + fq * 4 + j; }
        case 3: return n;
        default: { const int pt = n >> 8, c = n & 255; return (c >> 7) * 2816 + pt * 128 + (c & 127); }
    }
}
struct TileDesc { const float* src; bf16_t* dst; int ldsrc, K, n0, k0, kind; };
__device__ __forceinline__ void convert_tiles4(const Frame& F, const TileDesc (&td)[4], int ntiles) {
    LAS float* tile = (LAS float*)F.lds;
    const int nn = F.tid & 63, kq = F.tid >> 6; float v[4][8];
#pragma unroll
    for (int q = 0; q < 4; ++q) { const int sc = q < ntiles ? srcmap(td[q].kind, td[q].n0 + nn) : -1;
#pragma unroll
        for (int i = 0; i < 8; ++i) { const int kk = kq * 8 + i; v[q][i] = sc >= 0 ? td[q].src[(size_t)(td[q].k0 + kk) * td[q].ldsrc + sc] : 0.f; } }
    __syncthreads();
#pragma unroll
    for (int q = 0; q < 4; ++q)
#pragma unroll
        for (int i = 0; i < 8; ++i) tile[q * 4160 + (kq * 8 + i) * 65 + nn] = v[q][i];
    __syncthreads();
    const int n2 = F.tid >> 3, k8 = (F.tid & 7) * 8;
#pragma unroll
    for (int q = 0; q < 4; ++q) if (q < ntiles) { float f[8];
#pragma unroll
        for (int i = 0; i < 8; ++i) f[i] = tile[q * 4160 + (k8 + i) * 65 + n2];
        *(u32x4*)(td[q].dst + (size_t)(td[q].n0 + n2) * td[q].K + td[q].k0 + k8) = pack8(f); }
}
__device__ __forceinline__ void weff_unit(const Frame& F, const PView& V, int l, int g, int et) {
    LAS float* pw = (LAS float*)F.lds; LAS float* sw = pw + 128 * 129;
    const float* poolw = V.in(10) + ((size_t)l * 4 + g) * 128 * 128; const float* scale = V.in(11) + (size_t)l * 512 + g * 128;
    const float* wb1 = V.in(14) + (((size_t)l * 4 + 1) * 512 + g * 128) * 1024 + et * 64;
    __syncthreads();
    for (int i = F.tid; i < 128 * 128; i += 512) pw[(i >> 7) * 129 + (i & 127)] = poolw[i];
    for (int i = F.tid; i < 128 * 64; i += 512) { const int d = i >> 6, e = i & 63; sw[d * 65 + e] = scale[d] * wb1[(size_t)d * 1024 + e]; }
    __syncthreads();
    const int el = F.tid & 63, cg = F.tid >> 6; float acc[16];
#pragma unroll
    for (int i = 0; i < 16; ++i) acc[i] = 0.f;
    for (int d = 0; d < 128; ++d) { const float s = sw[d * 65 + el];
#pragma unroll
        for (int i = 0; i < 16; ++i) acc[i] += pw[(cg * 16 + i) * 129 + d] * s; }
    bf16_t* dst = (bf16_t*)(V.ws + W_B) + ((size_t)1024 + et * 64 + el) * 512 + g * 128 + cg * 16;
    float f0[8], f1[8];
#pragma unroll
    for (int i = 0; i < 8; ++i) { f0[i] = acc[i]; f1[i] = acc[8 + i]; }
    *(u32x4*)dst = pack8(f0); *(u32x4*)(dst + 8) = pack8(f1);
}
__device__ __forceinline__ TileDesc tile_desc(const PView& V, int l, int t) {
    unsigned char* ws = V.ws; const float* w_in = V.in(7) + (size_t)l * 1024 * INW; TileDesc d;
    const int T0 = 36 * 16, T1 = T0 + 44 * 16, T2 = T1 + 64 * 16, T3 = T2 + 3 * 16 * 8, T4 = T3 + 16 * 16, T5 = T4 + 88 * 16;
    if (t < T0) { d.src = w_in; d.ldsrc = INW; d.K = 1024; d.dst = (bf16_t*)(ws + W_LSTM); d.n0 = (t / 16) * 64; d.k0 = (t % 16) * 64; d.kind = 0; }
    else if (t < T1) { const int q = t - T0; d.src = w_in; d.ldsrc = INW; d.K = 1024; d.dst = (bf16_t*)(ws + W_REST); d.n0 = (q / 16) * 64; d.k0 = (q % 16) * 64; d.kind = 1; }
    else if (t < T2) { const int q = t - T1; d.src = w_in; d.ldsrc = INW; d.K = 1024; d.dst = (bf16_t*)(ws + W_GATE); d.n0 = (q / 16) * 64; d.k0 = (q % 16) * 64; d.kind = 2; }
    else if (t < T3) { const int q = t - T2, bi = q / 128, r = q % 128; const int nb = bi == 0 ? 0 : bi + 1;
        d.src = V.in(14) + ((size_t)l * 4 + nb) * 512 * 1024; d.ldsrc = 1024; d.K = 512; d.dst = (bf16_t*)(ws + W_B) + (size_t)nb * 1024 * 512; d.n0 = (r / 8) * 64; d.k0 = (r % 8) * 64; d.kind = 3; }
    else if (t < T4) { const int q = t - T3; d.src = V.in(15) + (size_t)l * 1024 * 1024; d.ldsrc = 1024; d.K = 1024; d.dst = (bf16_t*)(ws + W_O); d.n0 = (q / 16) * 64; d.k0 = (q % 16) * 64; d.kind = 3; }
    else if (t < T5) { const int q = t - T4; d.src = V.in(16) + (size_t)l * 1024 * 5632; d.ldsrc = 5632; d.K = 1024; d.dst = (bf16_t*)(ws + W_UP); d.n0 = (q / 16) * 64; d.k0 = (q % 16) * 64; d.kind = 4; }
    else { const int q = t - T5; d.src = V.in(18) + (size_t)l * DFF * 1024; d.ldsrc = 1024; d.K = DFF; d.dst = (bf16_t*)(ws + W_DN); d.n0 = (q / 44) * 64; d.k0 = (q % 44) * 64; d.kind = 3; }
    return d;
}
__device__ __forceinline__ void prep_weights(const Frame& F, const PView& V, int l, int t0, int t1, int wid, int nw, bool with_weff) {
#pragma unroll 1
    for (int t = t0 + wid; t < t1; t += 4 * nw) { TileDesc td[4]; int nt = 0;
#pragma unroll
        for (int q = 0; q < 4; ++q) { const int tq = t + q * nw; td[q] = tile_desc(V, l, tq < t1 ? tq : t); nt += tq < t1 ? 1 : 0; }
        convert_tiles4(F, td, nt); }
    if (with_weff) for (int q = wid; q < 64; q += nw) weff_unit(F, V, l, q >> 4, q & 15);
}
constexpr int PREP_T0 = 36 * 16, PREP_T1 = PREP_T0 + 44 * 16, PREP_T2 = PREP_T1 + 64 * 16, PREP_T3 = PREP_T2 + 3 * 16 * 8, PREP_T4 = PREP_T3 + 16 * 16, PREP_T5 = PREP_T4 + 88 * 16, PREP_NT = PREP_T5 + 16 * 44;
__device__ __forceinline__ void tail_prep(const Frame& F, const PView& V, int l, int units, int t0, int t1, int u0, int u1, bool with_weff) {
    const int nbusy = units % F.G;
    int wid = F.bid, nw = F.G;
    if (nbusy > 0) { if (F.bid < nbusy) return; wid = F.bid - nbusy; nw = F.G - nbusy; }
    prep_weights(F, V, l, t0, t1, wid, nw, with_weff);
    if (u1 > u0) prep_weights(F, V, l, u0, u1, wid, nw, false);
}

__device__ __forceinline__ void rows_phase(const Frame& F, const PView& V, int Mrows, const void* xsl, bool src_f32, const float* xsc, void* xdl, bool dst_f32, float* xdc, const bf16_t* y, const float* gpost, const float* modcur, int kgate,
                           bool has_next, const float* gpre, const float* modnext, int kshift, int kscale, bf16_t* U, int wg, int nwg, int pass_lo, int pass_hi) {
    const int lane = F.lane; const int wv = wg * 8 + F.wave, nwv = nwg * 8;
#pragma unroll 1
    for (int pass = pass_lo; pass < pass_hi; ++pass) {
        const int per = nwv >> 2; const int bi = pass == 0 ? wv / per : 4;
        int r = pass == 0 ? bi * SEQ + (wv % per) : ML + wv; const int rstep = pass == 0 ? per : nwv; const int rend = pass == 0 ? (bi + 1) * SEQ : Mrows;
        if (pass == 0 && bi > 3) continue;
        if (r >= rend) continue;
        float cA[16], cB[16], cC[16];
#pragma unroll
        for (int i = 0; i < 2; ++i)
#pragma unroll
            for (int j = 0; j < 8; ++j) { const int c = 512 * i + 8 * lane + j; cA[8 * i + j] = 0.f; cB[8 * i + j] = 0.f; cC[8 * i + j] = 0.f;
                if (y) cA[8 * i + j] = modcur[(size_t)bi * 6144 + kgate * 1024 + c] * gpost[c];
                if (has_next) { cB[8 * i + j] = gpre[c] * (1.0f + modnext[(size_t)bi * 6144 + kscale * 1024 + c]); cC[8 * i + j] = modnext[(size_t)bi * 6144 + kshift * 1024 + c]; } }
#pragma unroll 1
        for (; r < rend; r += rstep) {
            const bool lat = r < ML, sf = !lat || src_f32, df = !lat || dst_f32;
            float xv[16];
            if (sf) { const float* xs = lat ? (const float*)xsl + (size_t)r * 1024 : xsc + (size_t)(r - ML) * 1024;
#pragma unroll
                for (int i = 0; i < 2; ++i) { const int c0 = 512 * i + 8 * lane; const f32x4 a = *(const f32x4*)(xs + c0), b = *(const f32x4*)(xs + c0 + 4);
                    xv[8 * i + 0] = a[0]; xv[8 * i + 1] = a[1]; xv[8 * i + 2] = a[2]; xv[8 * i + 3] = a[3]; xv[8 * i + 4] = b[0]; xv[8 * i + 5] = b[1]; xv[8 * i + 6] = b[2]; xv[8 * i + 7] = b[3]; } }
            else { const bf16_t* xs = (const bf16_t*)xsl + (size_t)r * 1024;
#pragma unroll
                for (int i = 0; i < 2; ++i) { float f[8]; unpack8(ldg16(xs + 512 * i + 8 * lane), f);
#pragma unroll
                    for (int j = 0; j < 8; ++j) xv[8 * i + j] = f[j]; } }
            if (y) {
                float yv[16]; float ss = 0.f;
#pragma unroll
                for (int i = 0; i < 2; ++i) { float f[8]; unpack8(ldg16(y + (size_t)r * 1024 + 512 * i + 8 * lane), f);
#pragma unroll
                    for (int j = 0; j < 8; ++j) { yv[8 * i + j] = f[j]; ss += f[j] * f[j]; } }
                ss = wave_sum(ss, lane); const float rs = rsqrtf(ss * (1.0f / 1024.0f) + EPS);
#pragma unroll
                for (int i = 0; i < 16; ++i) xv[i] += cA[i] * (yv[i] * rs);
            }
            if (df) { float* xd = lat ? (float*)xdl + (size_t)r * 1024 : xdc + (size_t)(r - ML) * 1024;
#pragma unroll
                for (int i = 0; i < 2; ++i) { const int c0 = 512 * i + 8 * lane;
                    *(f32x4*)(xd + c0) = (f32x4){xv[8 * i], xv[8 * i + 1], xv[8 * i + 2], xv[8 * i + 3]}; *(f32x4*)(xd + c0 + 4) = (f32x4){xv[8 * i + 4], xv[8 * i + 5], xv[8 * i + 6], xv[8 * i + 7]}; } }
            else { bf16_t* xd = (bf16_t*)xdl + (size_t)r * 1024;
#pragma unroll
                for (int i = 0; i < 2; ++i) { float f[8];
#pragma unroll
                    for (int j = 0; j < 8; ++j) f[j] = xv[8 * i + j];
                    *(u32x4*)(xd + 512 * i + 8 * lane) = pack8(f); } }
            if (has_next) {
                float ss = 0.f;
#pragma unroll
                for (int i = 0; i < 16; ++i) ss += xv[i] * xv[i];
                ss = wave_sum(ss, lane); const float rs = rsqrtf(ss * (1.0f / 1024.0f) + EPS);
#pragma unroll
                for (int i = 0; i < 2; ++i) { float f[8];
#pragma unroll
                    for (int j = 0; j < 8; ++j) f[j] = (xv[8 * i + j] * rs) * cB[8 * i + j] + cC[8 * i + j];
                    *(u32x4*)(U + (size_t)r * 1024 + 512 * i + 8 * lane) = pack8(f); }
            }
        }
    }
}

__device__ __forceinline__ int blk_rowbase(int b, int blk) { return blk == 0 ? ML + b * 256 : b * SEQ + (blk - 1) * 256; }
__device__ __forceinline__ float scan256(LAS float* ws, float v, int tid, bool suffix) {
    const int lane = tid & 63, w = tid >> 6; float x = v;
    if (!suffix) {
#pragma unroll
        for (int o = 1; o < 64; o <<= 1) { const float yv = lshfl(x, (lane - o) & 63); if (lane >= o) x += yv; }
    } else {
#pragma unroll
        for (int o = 1; o < 64; o <<= 1) { const float yv = lshfl(x, (lane + o) & 63); if (lane + o < 64) x += yv; }
    }
    __syncthreads();
    if (w < 4 && lane == (suffix ? 0 : 63)) ws[w] = x;
    __syncthreads();
    if (w < 4) {
        if (!suffix) { for (int j = 0; j < w; ++j) x += ws[j]; }
        else { for (int j = w + 1; j < 4; ++j) x += ws[j]; }
    }
    return x;
}
__device__ __forceinline__ void conv_silu8(const u32x4 pv, const u32x4 cv, const u32x4 nv, const LAS float* w0, const LAS float* w1, const LAS float* w2, float scale, float (&o)[8]) {
    float p[8], c[8], n[8]; unpack8(pv, p); unpack8(cv, c); unpack8(nv, n);
#pragma unroll
    for (int i = 0; i < 8; ++i) { const float yv = p[i] * w0[i] + c[i] * w1[i] + n[i] * w2[i]; o[i] = siluf_(yv) * scale; }
}

__device__ __forceinline__ void lstm_pass1_unit(const Frame& F, const PView& V, int l, int ub) {
    const int tid = F.tid, lane = F.lane, w = F.wave, r = lane & 15, quad = lane >> 4;
    const int blk = ub % NBLK, h = (ub / NBLK) & 3, b = ub / (4 * NBLK);
    const int uf = ((b * 4 + h) * 2 + 0) * NBLK + blk, ubk = uf + NBLK;
    const int rowbase = blk_rowbase(b, blk); const bool seq_first = blk <= 1, seq_last = (blk == 0 || blk == 32);
    const bf16_t* PL = (const bf16_t*)(V.big + B_PLSTM);
    LAS float* wgt = (LAS float*)F.lds;
    LAS float* sws = wgt + 512;
    LAS float* cw = wgt + 528;
    LAS bf16_t* Kt = (LAS bf16_t*)(F.lds + 4096);
    LAS bf16_t* Vt = (LAS bf16_t*)(F.lds + 4096 + 128 * 264 * 2);
    __syncthreads();
    if (tid < 384) cw[tid] = V.in(8)[(size_t)l * 3072 + (tid >> 7) * 1024 + 512 + h * 128 + (tid & 127)];
    float gif = 0.f, gib = 0.f, lff = 0.f, lfb = 0.f;
    if (tid < 256) { const bf16_t* gp = PL + (size_t)(rowbase + tid) * NLSTM + 2048; const float* gb = V.in(9) + (size_t)l * 16;
        gif = bf2f(gp[h]) + gb[h]; gib = bf2f(gp[4 + h]) + gb[4 + h]; lff = logsigmoidf_(bf2f(gp[8 + h]) + gb[8 + h]); lfb = logsigmoidf_(bf2f(gp[12 + h]) + gb[12 + h]); }
    const float cif = scan256(sws, lff, tid, false);
    const float cib = scan256(sws + 4, lfb, tid, false);
    __syncthreads();
    if (tid == 255) { sws[8] = cif; sws[9] = cib; }
    __syncthreads();
    const float totf = sws[8], totb = sws[9];
    if (tid < 256) { wgt[tid] = __expf(totf - cif + gif); wgt[256 + tid] = __expf(cib - lfb + gib);
        float* gt = (float*)(V.big + B_GT); gt[(size_t)uf * 512 + tid] = cif; gt[(size_t)uf * 512 + 256 + tid] = gif;
        gt[(size_t)ubk * 512 + tid] = totb - cib + lfb; gt[(size_t)ubk * 512 + 256 + tid] = gib; }
    if (tid == 0) { float* dec = (float*)(V.ws + WS_DEC); dec[uf] = __expf(totf); dec[ubk] = __expf(totb); }
    __syncthreads();
#pragma unroll 1
    for (int hb = 0; hb < 2; ++hb) {
        u32x4 cv[2][2], pv[2][2], nv[2][2], vv[2][2];
#pragma unroll
        for (int it = 0; it < 2; ++it) { const int pt = (hb * 2 + it) * 512 + tid, chunk = pt >> 7, tp = pt & 127;
#pragma unroll
            for (int e = 0; e < 2; ++e) { const int tau = 2 * tp + e; const int row = rowbase + tau;
                const bf16_t* kp = PL + (size_t)row * NLSTM + 512 + h * 128 + chunk * 8;
                cv[it][e] = ldg16(kp); pv[it][e] = (u32x4){0u, 0u, 0u, 0u}; nv[it][e] = pv[it][e];
                if (!(seq_first && tau == 0)) pv[it][e] = ldg16(kp - NLSTM);
                if (!(seq_last && tau == 255)) nv[it][e] = ldg16(kp + NLSTM);
                vv[it][e] = ldg16(PL + (size_t)row * NLSTM + 1024 + h * 128 + chunk * 8); } }
#pragma unroll
        for (int it = 0; it < 2; ++it) { const int pt = (hb * 2 + it) * 512 + tid, CH = pt >> 7, tp = pt & 127, kc2 = 2 * tp;
            float o0[8], o1[8];
            conv_silu8(pv[it][0], cv[it][0], nv[it][0], cw + CH * 8, cw + 128 + CH * 8, cw + 256 + CH * 8, 0.08838834764831845f, o0);
            conv_silu8(pv[it][1], cv[it][1], nv[it][1], cw + CH * 8, cw + 128 + CH * 8, cw + 256 + CH * 8, 0.08838834764831845f, o1);
#pragma unroll
            for (int i = 0; i < 8; ++i) *(LAS unsigned*)(Kt + (CH * 8 + i) * 264 + kc2) = pk2(o0[i], o1[i]);
            const u32x4 va = vv[it][0], vb = vv[it][1];
            *(LAS unsigned*)(Vt + ((CH) * 8 + 0) * 264 + kc2) = (va.x & 0xffffu) | (vb.x << 16); *(LAS unsigned*)(Vt + ((CH) * 8 + 1) * 264 + kc2) = (va.x >> 16) | (vb.x & 0xffff0000u); *(LAS unsigned*)(Vt + ((CH) * 8 + 2) * 264 + kc2) = (va.y & 0xffffu) | (vb.y << 16); *(LAS unsigned*)(Vt + ((CH) * 8 + 3) * 264 + kc2) = (va.y >> 16) | (vb.y & 0xffff0000u); *(LAS unsigned*)(Vt + ((CH) * 8 + 4) * 264 + kc2) = (va.z & 0xffffu) | (vb.z << 16); *(LAS unsigned*)(Vt + ((CH) * 8 + 5) * 264 + kc2) = (va.z >> 16) | (vb.z & 0xffff0000u); *(LAS unsigned*)(Vt + ((CH) * 8 + 6) * 264 + kc2) = (va.w & 0xffffu) | (vb.w << 16); *(LAS unsigned*)(Vt + ((CH) * 8 + 7) * 264 + kc2) = (va.w >> 16) | (vb.w & 0xffff0000u); }
    }
    __syncthreads();
    bf16x8 af[8];
#pragma unroll
    for (int ks = 0; ks < 8; ++ks) af[ks] = *(const LAS bf16x8*)(Kt + (16 * w + r) * 264 + 32 * ks + 8 * quad);
    const bf16x8 ones = {(short)0x3f80, (short)0x3f80, (short)0x3f80, (short)0x3f80, (short)0x3f80, (short)0x3f80, (short)0x3f80, (short)0x3f80};
    const bf16x8 zeros = {0, 0, 0, 0, 0, 0, 0, 0};
#pragma unroll 1
    for (int dir = 0; dir < 2; ++dir) {
        asm volatile("" ::: "memory");
        bf16x8 ad[8];
#pragma unroll
        for (int ks = 0; ks < 8; ++ks) { const f32x4 w0 = *(const LAS f32x4*)(wgt + dir * 256 + 32 * ks + 8 * quad), w1 = *(const LAS f32x4*)(wgt + dir * 256 + 32 * ks + 8 * quad + 4);
            float f[8]; unpack8(__builtin_bit_cast(u32x4, af[ks]), f);
            f[0] *= w0[0]; f[1] *= w0[1]; f[2] *= w0[2]; f[3] *= w0[3]; f[4] *= w1[0]; f[5] *= w1[1]; f[6] *= w1[2]; f[7] *= w1[3];
            ad[ks] = __builtin_bit_cast(bf16x8, pack8(f)); }
        bf16_t* st = (bf16_t*)(V.big + B_ST) + (size_t)(dir == 0 ? uf : ubk) * ST_ELEMS;
#pragma unroll
        for (int db = 0; db < 9; ++db) { f32x4 acc = {0.f, 0.f, 0.f, 0.f};
#pragma unroll
            for (int ks = 0; ks < 8; ++ks) { bf16x8 bfr;
                if (db < 8) bfr = *(const LAS bf16x8*)(Vt + (16 * db + r) * 264 + 32 * ks + 8 * quad); else bfr = (r == 0) ? ones : zeros;
                acc = MFMA16(ad[ks], bfr, acc); }
            u32x2 pw; pw.x = pk2(acc[0], acc[1]); pw.y = pk2(acc[2], acc[3]);
            if (db < 8) *(u32x2*)(st + (size_t)(16 * db + r) * 128 + 16 * w + 4 * quad) = pw;
            else if (r == 0) *(u32x2*)(st + (size_t)128 * 128 + 16 * w + 4 * quad) = pw; }
    }
}
__device__ __forceinline__ void lstm_scan(const Frame& F, const PView& V) {
    bf16_t* ST = (bf16_t*)(V.big + B_ST); const float* DEC = (const float*)(V.ws + WS_DEC);
    const int per = ST_ELEMS / 8;
    for (int gid = F.bid * 512 + F.tid; gid < 32 * per; gid += F.G * 512) {
        const int chain = gid / per, e8 = gid % per, dir = chain & 1; const int ub = chain * NBLK;
        float sv[8];
#pragma unroll
        for (int q = 0; q < 8; ++q) sv[q] = 0.f;
#pragma unroll 1
        for (int g = 0; g < 3; ++g) { u32x4 tmp[11]; float dc[11];
#pragma unroll
            for (int j = 0; j < 11; ++j) { const int i = g * 11 + j; const int blk = (dir == 0 || i == 0) ? i : 33 - i;
                tmp[j] = *(const u32x4*)(ST + (size_t)(ub + blk) * ST_ELEMS + e8 * 8); dc[j] = DEC[ub + blk]; }
#pragma unroll
            for (int j = 0; j < 11; ++j) { const int i = g * 11 + j; const int blk = (dir == 0 || i == 0) ? i : 33 - i;
                *(u32x4*)(ST + (size_t)(ub + blk) * ST_ELEMS + e8 * 8) = pack8(sv); float f[8]; unpack8(tmp[j], f);
#pragma unroll
                for (int q = 0; q < 8; ++q) sv[q] = sv[q] * dc[j] + f[q]; } }
    }
}
__device__ __forceinline__ void lstm_pass2_unit(const Frame& F, const PView& V, int l, int b, int h, int blk, int qh) {
    const int tid = F.tid, lane = F.lane, w = F.wave, r = lane & 15, quad = lane >> 4;
    const int rowbase = blk_rowbase(b, blk); const bool seq_first = blk <= 1, seq_last = (blk == 0 || blk == 32);
    const bf16_t* PL = (const bf16_t*)(V.big + B_PLSTM);
    LAS float* cf = (LAS float*)F.lds; LAS float* cb = cf + 256; LAS float* igf = cf + 512; LAS float* igb = cf + 768;
    LAS float* sws = cf + 1024;
    LAS float* cwq = cf + 1056;
    LAS float* cwk = cwq + 384;
    LAS bf16_t* CTf = (LAS bf16_t*)(F.lds + 7424);
    LAS bf16_t* CTb = (LAS bf16_t*)(F.lds + 42512);
    LAS bf16_t* Kh = (LAS bf16_t*)(F.lds + 77600);
    LAS bf16_t* Vt = (LAS bf16_t*)(F.lds + 112416);
    const int qi = 8 * qh + w, t = 16 * qi + r; const int qrow = rowbase + t;
    __syncthreads();
    float cwq_v = 0.f, cwk_v = 0.f;
    if (tid < 384) { cwq_v = V.in(8)[(size_t)l * 3072 + (tid >> 7) * 1024 + h * 128 + (tid & 127)]; cwk_v = V.in(8)[(size_t)l * 3072 + (tid >> 7) * 1024 + 512 + h * 128 + (tid & 127)]; }
    float cfv = 0.f, cbv = 0.f, gif = 0.f, gib = 0.f;
    if (tid < 256) { const float* gtf = (const float*)(V.big + B_GT) + (size_t)(((b * 4 + h) * 2 + 0) * NBLK + blk) * 512; const float* gtb = gtf + (size_t)NBLK * 512;
        cfv = gtf[tid]; gif = gtf[256 + tid]; cbv = gtb[tid]; gib = gtb[256 + tid]; }
    u32x4 qc[4], qp_[4], qn[4];
#pragma unroll
    for (int ks = 0; ks < 4; ++ks) { const bf16_t* qp = PL + (size_t)qrow * NLSTM + h * 128 + 32 * ks + 8 * quad;
        qc[ks] = ldg16(qp); qp_[ks] = (u32x4){0u, 0u, 0u, 0u}; qn[ks] = qp_[ks];
        if (!(seq_first && t == 0)) qp_[ks] = ldg16(qp - NLSTM);
        if (!(seq_last && t == 255)) qn[ks] = ldg16(qp + NLSTM); }
    u32x2 og[8];
    const bf16_t* sf = (const bf16_t*)(V.big + B_ST) + (size_t)(((b * 4 + h) * 2 + 0) * NBLK + blk) * ST_ELEMS; const bf16_t* sb = sf + (size_t)NBLK * ST_ELEMS;
    const bool carried = blk != 0;
    if (tid < 384) { cwq[tid] = cwq_v; cwk[tid] = cwk_v; }
    if (tid < 256) { cf[tid] = cfv; cb[tid] = cbv; igf[tid] = gif; igb[tid] = gib; }
    __builtin_amdgcn_sched_barrier(0);
    if (carried) { u32x4 fa[5], fc[5];
#pragma unroll
        for (int it = 0; it < 5; ++it) { const int i = tid + 512 * it; fa[it] = (u32x4){0u, 0u, 0u, 0u}; fc[it] = fa[it];
            if (i < ST_ELEMS / 8) { fa[it] = *(const u32x4*)(sf + (size_t)i * 8); fc[it] = *(const u32x4*)(sb + (size_t)i * 8); } }
#pragma unroll
        for (int it = 0; it < 5; ++it) { const int i = tid + 512 * it; if (i < ST_ELEMS / 8) { const int row = i >> 4, c8 = (i & 15) * 8;
            *(LAS u32x4*)(CTf + row * 136 + c8) = fa[it]; *(LAS u32x4*)(CTb + row * 136 + c8) = fc[it]; } } }
    __builtin_amdgcn_sched_barrier(0);
    u32x4 kc[4], kp_[4], kn[4], vv[4];
#define P2_KV_LOAD(kh_) do { _Pragma("unroll") for (int it = 0; it < 4; ++it) { const int task = it * 512 + tid, chunk = task & 15, key = task >> 4, tau = 128 * (kh_) + key; \
        const bf16_t* kp = PL + (size_t)(rowbase + tau) * NLSTM + 512 + h * 128 + chunk * 8; \
        kc[it] = ldg16(kp); kp_[it] = (u32x4){0u, 0u, 0u, 0u}; kn[it] = kp_[it]; \
        if (!(seq_first && tau == 0)) kp_[it] = ldg16(kp - NLSTM); \
        if (!(seq_last && tau == 255)) kn[it] = ldg16(kp + NLSTM); \
        } } while (0)
#define P2_V_LOAD(kh_) do { _Pragma("unroll") for (int it = 0; it < 2; ++it) { const int pt = it * 512 + tid; \
        const bf16_t* vp = PL + (size_t)(rowbase + 128 * (kh_) + 2 * (pt & 63)) * NLSTM + 1024 + h * 128 + (pt >> 6) * 8; vv[2 * it] = ldg16(vp); vv[2 * it + 1] = ldg16(vp + NLSTM); } } while (0)
#define P2_KV_STORE(KD, VD) do { _Pragma("unroll") for (int it = 0; it < 4; ++it) { const int task = it * 512 + tid, chunk = task & 15, key = task >> 4; \
        float o[8]; conv_silu8(kp_[it], kc[it], kn[it], cwk + chunk * 8, cwk + 128 + chunk * 8, cwk + 256 + chunk * 8, 0.08838834764831845f, o); \
        *(LAS u32x4*)((KD) + key * 136 + chunk * 8) = pack8(o); } \
        _Pragma("unroll") for (int it = 0; it < 2; ++it) { const int pt = it * 512 + tid; const int CH = pt >> 6, kc2 = 2 * (pt & 63); LAS bf16_t* vd_ = (VD); const u32x4 va = vv[2 * it], vb = vv[2 * it + 1]; \
        *(LAS unsigned*)(vd_ + ((CH) * 8 + 0) * 136 + kc2) = (va.x & 0xffffu) | (vb.x << 16); \
         *(LAS unsigned*)(vd_ + ((CH) * 8 + 1) * 136 + kc2) = (va.x >> 16) | (vb.x & 0xffff0000u); \
         *(LAS unsigned*)(vd_ + ((CH) * 8 + 2) * 136 + kc2) = (va.y & 0xffffu) | (vb.y << 16); \
         *(LAS unsigned*)(vd_ + ((CH) * 8 + 3) * 136 + kc2) = (va.y >> 16) | (vb.y & 0xffff0000u); \
         *(LAS unsigned*)(vd_ + ((CH) * 8 + 4) * 136 + kc2) = (va.z & 0xffffu) | (vb.z << 16); \
         *(LAS unsigned*)(vd_ + ((CH) * 8 + 5) * 136 + kc2) = (va.z >> 16) | (vb.z & 0xffff0000u); \
         *(LAS unsigned*)(vd_ + ((CH) * 8 + 6) * 136 + kc2) = (va.w & 0xffffu) | (vb.w << 16); \
         *(LAS unsigned*)(vd_ + ((CH) * 8 + 7) * 136 + kc2) = (va.w >> 16) | (vb.w & 0xffff0000u); } } while (0)
    __syncthreads();
    bf16x8 qf[4];
#pragma unroll
    for (int ks = 0; ks < 4; ++ks) { const int c0 = 32 * ks + 8 * quad; float o[8]; conv_silu8(qp_[ks], qc[ks], qn[ks], cwq + c0, cwq + 128 + c0, cwq + 256 + c0, 1.0f, o);
        qf[ks] = __builtin_bit_cast(bf16x8, pack8(o)); }
    __builtin_amdgcn_sched_barrier(0);
    P2_KV_LOAD(0);
    __builtin_amdgcn_sched_barrier(0);
    const bf16x8 ones = {(short)0x3f80, (short)0x3f80, (short)0x3f80, (short)0x3f80, (short)0x3f80, (short)0x3f80, (short)0x3f80, (short)0x3f80};
    const bf16x8 zeros = {0, 0, 0, 0, 0, 0, 0, 0};
    f32x4 accf[9], accb[9];
#pragma unroll
    for (int db = 0; db < 9; ++db) { accf[db] = (f32x4){0.f, 0.f, 0.f, 0.f}; accb[db] = accf[db]; }
    if (carried) { const float ef = __expf(cf[t]), eb = __expf(cb[t]);
#pragma unroll
        for (int db = 0; db < 9; ++db) { f32x4 a = {0.f, 0.f, 0.f, 0.f}, c = {0.f, 0.f, 0.f, 0.f};
#pragma unroll
            for (int ks = 0; ks < 4; ++ks) { bf16x8 xf, xb;
                if (db < 8) { xf = *(const LAS bf16x8*)(CTf + (16 * db + r) * 136 + 32 * ks + 8 * quad); xb = *(const LAS bf16x8*)(CTb + (16 * db + r) * 136 + 32 * ks + 8 * quad); }
                else { xf = zeros; xb = zeros; if (r == 0) { xf = *(const LAS bf16x8*)(CTf + 128 * 136 + 32 * ks + 8 * quad); xb = *(const LAS bf16x8*)(CTb + 128 * 136 + 32 * ks + 8 * quad); } }
                a = MFMA16(xf, qf[ks], a); c = MFMA16(xb, qf[ks], c); }
            accf[db] = a * ef; accb[db] = c * eb; } }
    const float cft = cf[t], cbt = cb[t];
    P2_V_LOAD(0);
    P2_KV_STORE(Kh, Vt);
    __syncthreads();
    P2_KV_LOAD(1); P2_V_LOAD(1);
    P2_KV_STORE(CTf, CTf + 128 * 136);
    __syncthreads();
#pragma unroll 1
    for (int kh = 0; kh < 2; ++kh) {
        const LAS bf16_t* Kc = kh == 0 ? Kh : CTf; const LAS bf16_t* Vc = kh == 0 ? Vt : CTf + 128 * 136;
#pragma unroll
        for (int dir = 0; dir < 2; ++dir) {
            int s0, s1;
            if (dir == 0) { if (kh > qh) continue; s0 = 0; s1 = (kh < qh) ? 4 : (w >> 1) + 1; }
            else { if (kh < qh) continue; s1 = 4; s0 = (kh > qh) ? 0 : (w >> 1); }
            const LAS float* cs = dir == 0 ? cf : cb; const LAS float* gs = dir == 0 ? igf : igb; const float ct = dir == 0 ? cft : cbt;
#pragma unroll 1
            for (int st = s0; st < s1; ++st) {
                f32x4 T0 = {0.f, 0.f, 0.f, 0.f}, T1 = {0.f, 0.f, 0.f, 0.f};
#pragma unroll
                for (int ks = 0; ks < 4; ++ks) { const bf16x8 k0 = *(const LAS bf16x8*)(Kc + (32 * st + r) * 136 + 32 * ks + 8 * quad), k1 = *(const LAS bf16x8*)(Kc + (32 * st + 16 + r) * 136 + 32 * ks + 8 * quad);
                    T0 = MFMA16(k0, qf[ks], T0); T1 = MFMA16(k1, qf[ks], T1); }
                const int sg0 = 128 * kh + 32 * st + 4 * quad;
                const f32x4 c0 = *(const LAS f32x4*)(cs + sg0), c1 = *(const LAS f32x4*)(cs + sg0 + 16), e0 = *(const LAS f32x4*)(gs + sg0), e1 = *(const LAS f32x4*)(gs + sg0 + 16);
                float p[8];
#pragma unroll
                for (int j = 0; j < 4; ++j) { const int sa = sg0 + j, sb = sg0 + 16 + j;
                    const bool va = dir == 0 ? (sa <= t) : (sa >= t), vb = dir == 0 ? (sb <= t) : (sb >= t);
                    const float da = __expf(ct - c0[j] + e0[j]), dbb = __expf(ct - c1[j] + e1[j]);
                    p[j] = va ? T0[j] * da : 0.f; p[4 + j] = vb ? T1[j] * dbb : 0.f; }
                const bf16x8 pf = __builtin_bit_cast(bf16x8, pack8(p));
#pragma unroll
                for (int db = 0; db < 9; ++db) { bf16x8 vf;
                    if (db < 8) { const s16x4 lo = *(const LAS s16x4*)(Vc + (16 * db + r) * 136 + 32 * st + 4 * quad), hi = *(const LAS s16x4*)(Vc + (16 * db + r) * 136 + 32 * st + 16 + 4 * quad);
                        vf = __builtin_shufflevector(lo, hi, 0, 1, 2, 3, 4, 5, 6, 7); }
                    else vf = (r == 0) ? ones : zeros;
                    if (dir == 0) accf[db] = MFMA16(vf, pf, accf[db]); else accb[db] = MFMA16(vf, pf, accb[db]); }
            }
        }
    }
#undef P2_KV_LOAD
#undef P2_V_LOAD
#undef P2_KV_STORE
#pragma unroll
    for (int db = 0; db < 8; ++db) og[db] = *(const u32x2*)(PL + (size_t)qrow * NLSTM + 1536 + h * 128 + 16 * db + 4 * quad);
    const float denf = lshfl(accf[8][0], r), denb = lshfl(accb[8][0], r);
    const float invf = 1.0f / fmaxf(fabsf(denf), 1.0f), invb = 1.0f / fmaxf(fabsf(denb), 1.0f);
    bf16_t* ya = (bf16_t*)(V.big + B_YSA);
#pragma unroll
    for (int db = 0; db < 8; ++db) { const int dv = 16 * db + 4 * quad; const u32x2 ov = og[db];
        const float o0 = lo16(ov.x), o1 = hi16(ov.x), o2 = lo16(ov.y), o3 = hi16(ov.y);
        const f32x4 hv = accf[db] * invf + accb[db] * invb;
        u32x2 wv; wv.x = pk2(sigmoidf_(o0) * hv[0], sigmoidf_(o1) * hv[1]); wv.y = pk2(sigmoidf_(o2) * hv[2], sigmoidf_(o3) * hv[3]);
        *(u32x2*)(ya + (size_t)qrow * 512 + h * 128 + dv) = wv; }
}

__device__ __forceinline__ void attn_unit(const Frame& F, const PView& V, int l, bool isctx, int b, int g, int qs) {
    const int tid = F.tid, lane = F.lane, w = F.wave, r = lane & 15, quad = lane >> 4;
    const bf16_t* PR = (const bf16_t*)(V.big + B_PREST); const LAS float* ropel = (const LAS float*)(F.lds + 36864);
    LAS bf16_t* Ks = (LAS bf16_t*)F.lds;
    LAS bf16_t* Vt = (LAS bf16_t*)(F.lds + 18432);
    const int head = g * 4 + (w >> 1), qhalf = w & 1;
    const int qrow0 = isctx ? ML + b * 256 + qs * 64 : b * SEQ + qs * 64;
    const float sink = V.in(12)[l * 8 + head];
    bf16x8 qf[2][2];
#pragma unroll
    for (int qk = 0; qk < 2; ++qk) { const int qi = qhalf * 32 + qk * 16 + r, tpos = qs * 64 + qi; const bf16_t* qp = PR + (size_t)(qrow0 + qi) * NREST + PR_AQ + head * 64;
#pragma unroll
        for (int ks = 0; ks < 2; ++ks) { const int d0 = 32 * ks + 8 * quad; float own[8], par[8], o[8]; unpack8(ldg16(qp + d0), own); unpack8(ldg16(qp + (d0 ^ 16)), par);
            if (!isctx) { const int pos = ks == 0 ? (tpos >> 6) : (tpos & 63); const LAS float* rp = ropel + (pos * 16 + 8 * (quad & 1)) * 2;
#pragma unroll
                for (int j = 0; j < 8; ++j) { const float c = rp[2 * j], sn = rp[2 * j + 1]; o[j] = (quad < 2) ? own[j] * c - par[j] * sn : par[j] * sn + own[j] * c; } }
            else {
#pragma unroll
                for (int j = 0; j < 8; ++j) o[j] = own[j]; }
#pragma unroll
            for (int j = 0; j < 8; ++j) o[j] *= 0.18033688011112042f;
            qf[qk][ks] = __builtin_bit_cast(bf16x8, pack8(o)); } }
    float mrun[2], lsum[2]; f32x4 acc[2][4];
    const float sinkl = sink * 1.4426950408889634f;
#pragma unroll
    for (int qk = 0; qk < 2; ++qk) { mrun[qk] = sinkl; lsum[qk] = 0.f;
#pragma unroll
        for (int db = 0; db < 4; ++db) acc[qk][db] = (f32x4){0.f, 0.f, 0.f, 0.f}; }
    const int ntile = isctx ? 2 : 5; const int ltm = 4 * quad - r - 32 * qhalf; const int qb = qs >> 1;
    const unsigned vmask = isctx ? 3u : (3u | (qb >= 1 ? 4u : 0u) | 8u | (qb <= 62 ? 16u : 0u));
    const int skey = tid >> 2, sa = (tid >> 1) & 1, sfh = tid & 1;
    u32x4 pk1, pk2v, pv0, pv1;
#define ATT_LOAD(tl) do { const int _kr = (tl) < 2 ? ML + b * 256 + (tl) * 128 : b * SEQ + (qb + (tl) - 3) * 128; \
        const bf16_t* _kp = PR + (size_t)(_kr + skey) * NREST + PR_AK + g * 64 + sa * 32 + sfh * 8; pk1 = ldg16(_kp); pk2v = ldg16(_kp + 16); \
        const bf16_t* _vp = PR + (size_t)(_kr + 2 * (tid & 63)) * NREST + PR_AV + g * 64 + (tid >> 6) * 8; pv0 = ldg16(_vp); pv1 = ldg16(_vp + NREST); } while (0)
    ATT_LOAD(0);
#pragma unroll 1
    for (int tile = 0; tile < ntile; ++tile) {
        if (!((vmask >> tile) & 1u)) continue;
        int kb = 0, base = 0; bool band = false;
        if (tile >= 2) { kb = qb + tile - 3; band = true; base = 128 * kb - 64 * qs; }
        __syncthreads();
        { float x1[8], x2[8], o1[8], o2[8]; unpack8(pk1, x1); unpack8(pk2v, x2);
            if (band) { const int kpos = kb * 128 + skey, pos = sa == 0 ? (kpos >> 6) : (kpos & 63); const LAS float* rp = ropel + (pos * 16 + sfh * 8) * 2;
#pragma unroll
                for (int j = 0; j < 8; ++j) { const float c = rp[2 * j], sn = rp[2 * j + 1]; o1[j] = x1[j] * c - x2[j] * sn; o2[j] = x1[j] * sn + x2[j] * c; } }
            else {
#pragma unroll
                for (int j = 0; j < 8; ++j) { o1[j] = x1[j]; o2[j] = x2[j]; } }
            *(LAS u32x4*)(Ks + skey * 72 + sa * 32 + sfh * 8) = pack8(o1); *(LAS u32x4*)(Ks + skey * 72 + sa * 32 + 16 + sfh * 8) = pack8(o2); }
        { const int CH = tid >> 6, kc2 = 2 * (tid & 63); *(LAS unsigned*)(Vt + ((CH) * 8 + 0) * 136 + kc2) = (pv0.x & 0xffffu) | (pv1.x << 16); *(LAS unsigned*)(Vt + ((CH) * 8 + 1) * 136 + kc2) = (pv0.x >> 16) | (pv1.x & 0xffff0000u); *(LAS unsigned*)(Vt + ((CH) * 8 + 2) * 136 + kc2) = (pv0.y & 0xffffu) | (pv1.y << 16); *(LAS unsigned*)(Vt + ((CH) * 8 + 3) * 136 + kc2) = (pv0.y >> 16) | (pv1.y & 0xffff0000u); *(LAS unsigned*)(Vt + ((CH) * 8 + 4) * 136 + kc2) = (pv0.z & 0xffffu) | (pv1.z << 16); *(LAS unsigned*)(Vt + ((CH) * 8 + 5) * 136 + kc2) = (pv0.z >> 16) | (pv1.z & 0xffff0000u); *(LAS unsigned*)(Vt + ((CH) * 8 + 6) * 136 + kc2) = (pv0.w & 0xffffu) | (pv1.w << 16); *(LAS unsigned*)(Vt + ((CH) * 8 + 7) * 136 + kc2) = (pv0.w >> 16) | (pv1.w & 0xffff0000u); }
        __syncthreads();
        { int nx = tile + 1; while (nx < ntile && !((vmask >> nx) & 1u)) ++nx; if (nx < ntile) ATT_LOAD(nx); }
        const bool domask = band && base != 0 && base != -64;
        f32x4 T[2][8];
#pragma unroll
        for (int kt = 0; kt < 8; ++kt) { f32x4 a0 = {0.f, 0.f, 0.f, 0.f}, a1 = {0.f, 0.f, 0.f, 0.f};
#pragma unroll
            for (int ks = 0; ks < 2; ++ks) { const bf16x8 kf = *(const LAS bf16x8*)(Ks + (16 * kt + r) * 72 + 32 * ks + 8 * quad); a0 = MFMA16(kf, qf[0][ks], a0); a1 = MFMA16(kf, qf[1][ks], a1); }
            T[0][kt] = a0; T[1][kt] = a1; }
        bf16x8 pf[2][4];
#pragma unroll
        for (int qk = 0; qk < 2; ++qk) {
            if (domask) {
#pragma unroll
                for (int kt = 0; kt < 8; ++kt)
#pragma unroll
                    for (int j = 0; j < 4; ++j) { const int dlt = base + (16 * kt + j - 16 * qk) + ltm; if (dlt > 128 || dlt < -128) T[qk][kt][j] = -8e30f; }
            }
            float tmax = -1e30f;
#pragma unroll
            for (int kt = 0; kt < 8; ++kt)
#pragma unroll
                for (int j = 0; j < 4; ++j) tmax = fmaxf(tmax, T[qk][kt][j]);
            tmax = fmaxf(tmax, lshfl(tmax, lane ^ 16)); tmax = fmaxf(tmax, lshfl(tmax, lane ^ 32));
            const float mnew = fmaxf(mrun[qk], tmax), alpha = __builtin_amdgcn_exp2f(mrun[qk] - mnew); mrun[qk] = mnew;
            float psum = 0.f;
#pragma unroll
            for (int kt = 0; kt < 8; ++kt)
#pragma unroll
                for (int j = 0; j < 4; ++j) { const float pv = __builtin_amdgcn_exp2f(T[qk][kt][j] - mnew); T[qk][kt][j] = pv; psum += pv; }
            lsum[qk] = lsum[qk] * alpha + psum;
#pragma unroll
            for (int db = 0; db < 4; ++db) acc[qk][db] = acc[qk][db] * alpha;
#pragma unroll
            for (int st = 0; st < 4; ++st) { float p[8];
#pragma unroll
                for (int j = 0; j < 4; ++j) { p[j] = T[qk][2 * st][j]; p[4 + j] = T[qk][2 * st + 1][j]; }
                pf[qk][st] = __builtin_bit_cast(bf16x8, pack8(p)); }
        }
#pragma unroll
        for (int st = 0; st < 4; ++st)
#pragma unroll
            for (int db = 0; db < 4; ++db) { const s16x4 lo = *(const LAS s16x4*)(Vt + (16 * db + r) * 136 + 32 * st + 4 * quad), hi = *(const LAS s16x4*)(Vt + (16 * db + r) * 136 + 32 * st + 16 + 4 * quad);
                const bf16x8 vf = __builtin_shufflevector(lo, hi, 0, 1, 2, 3, 4, 5, 6, 7);
                acc[0][db] = MFMA16(vf, pf[0][st], acc[0][db]); acc[1][db] = MFMA16(vf, pf[1][st], acc[1][db]); }
    }
    bf16_t* yc = (bf16_t*)(V.big + B_YSB + 1 * YS_STRIDE);
#pragma unroll
    for (int qk = 0; qk < 2; ++qk) { const int qi = qhalf * 32 + qk * 16 + r; float lt = lsum[qk]; lt += lshfl(lt, lane ^ 16); lt += lshfl(lt, lane ^ 32); lt += __builtin_amdgcn_exp2f(sinkl - mrun[qk]);
        const float inv = 1.0f / lt;
#pragma unroll
        for (int db = 0; db < 4; ++db) { const f32x4 o = acc[qk][db] * inv; u32x2 wv; wv.x = pk2(o[0], o[1]); wv.y = pk2(o[2], o[3]);
            *(u32x2*)(yc + (size_t)(qrow0 + qi) * 512 + head * 64 + 16 * db + 4 * quad) = wv; } }
#undef ATT_LOAD
}
__device__ __forceinline__ void seq_of_row(int row0, int& seqbase, int& T) { seqbase = row0 < ML ? (row0 & ~(SEQ - 1)) : ML + ((row0 - ML) & ~(CTX - 1)); T = row0 < ML ? SEQ : CTX; }
__device__ __forceinline__ void pool_tasks(const Frame& F, const PView& V, int Mrows) {
    const bf16_t* PR = (const bf16_t*)(V.big + B_PREST); bf16_t* yb = (bf16_t*)(V.big + B_YSB + 0 * YS_STRIDE);
    const int ntask = (Mrows / 8) * 64;
#pragma unroll 1
    for (int t = F.bid * 512 + F.tid; t < ntask; t += F.G * 512) {
        const int cg = t & 15, rbl = (t >> 4) & 3, g = (t >> 6) & 3, rb = ((t >> 8) << 2) + rbl, half = 1 << g;
        const int row0 = rb * 8; int seqbase, T; seq_of_row(row0, seqbase, T); const int t0 = row0 - seqbase;
        const bf16_t* base = PR + (size_t)row0 * NREST + PR_POOL + (g * 16 + cg) * 8;
        u32x4 rw[24];
#pragma unroll
        for (int i = 0; i < 24; ++i) { const int tt = t0 - half + i; rw[i] = (u32x4){0u, 0u, 0u, 0u};
            if (i < 8 + 2 * half && tt >= 0 && tt < T) rw[i] = ldg16(base + (ptrdiff_t)(i - half) * NREST); }
        float sum[8];
#pragma unroll
        for (int j = 0; j < 8; ++j) sum[j] = 0.f;
#pragma unroll
        for (int i = 0; i < 16; ++i) if (i < 2 * half) { float f[8]; unpack8(rw[i], f);
#pragma unroll
            for (int j = 0; j < 8; ++j) sum[j] += f[j]; }
#pragma unroll
        for (int i = 0; i < 8; ++i) {
            const int tc = t0 + i, lo = tc - half < 0 ? 0 : tc - half, hi = tc + half > T ? T : tc + half; const float inv = 1.0f / (float)(hi - lo);
            float c[8], o[8];
            if (g == 0) unpack8(rw[i + 1], c); else if (g == 1) unpack8(rw[i + 2], c); else if (g == 2) unpack8(rw[i + 4], c); else unpack8(rw[i + 8], c);
#pragma unroll
            for (int j = 0; j < 8; ++j) o[j] = sum[j] * inv - c[j];
            *(u32x4*)(yb + (size_t)(row0 + i) * 512 + (g * 16 + cg) * 8) = pack8(o);
            if (i < 7) { float fa[8], fs[8]; unpack8(rw[i], fs);
                if (g == 0) unpack8(rw[i + 2], fa); else if (g == 1) unpack8(rw[i + 4], fa); else if (g == 2) unpack8(rw[i + 8], fa); else unpack8(rw[i + 16], fa);
#pragma unroll
                for (int j = 0; j < 8; ++j) sum[j] += fa[j] - fs[j]; }
        }
    }
}
__device__ __forceinline__ void sconv_tasks(const Frame& F, const PView& V, int l, int Mrows) {
    const bf16_t* PR = (const bf16_t*)(V.big + B_PREST); bf16_t* yd = (bf16_t*)(V.big + B_YSB + 2 * YS_STRIDE);
    const int ntask = (Mrows / 8) * 64;
#pragma unroll 1
    for (int t = F.bid * 512 + F.tid; t < ntask; t += F.G * 512) {
        const int chunk = t & 63, rb = t >> 6; const int row0 = rb * 8; int seqbase, T; seq_of_row(row0, seqbase, T); const int t0 = row0 - seqbase;
        const float* cw = V.in(13) + (size_t)l * 1536 + chunk * 8;
        const bf16_t* base = PR + (size_t)row0 * NREST + chunk * 8;
        u32x4 cr[10], xr[10], br[8];
#pragma unroll
        for (int i = 0; i < 10; ++i) { const int tt = t0 - 1 + i; cr[i] = (u32x4){0u, 0u, 0u, 0u}; xr[i] = cr[i];
            if (tt >= 0 && tt < T) { cr[i] = ldg16(base + (ptrdiff_t)(i - 1) * NREST + PR_SC); xr[i] = ldg16(base + (ptrdiff_t)(i - 1) * NREST + PR_SX); } }
#pragma unroll
        for (int i = 0; i < 8; ++i) br[i] = ldg16(base + (size_t)i * NREST + PR_SB);
        float w0[8], w1[8], w2[8];
#pragma unroll
        for (int j = 0; j < 8; ++j) { w0[j] = cw[j]; w1[j] = cw[512 + j]; w2[j] = cw[1024 + j]; }
        float pa[8], pb[8], pc[8], c[8], x[8];
        unpack8(cr[0], c); unpack8(xr[0], x);
#pragma unroll
        for (int j = 0; j < 8; ++j) pa[j] = c[j] * x[j];
        unpack8(cr[1], c); unpack8(xr[1], x);
#pragma unroll
        for (int j = 0; j < 8; ++j) pb[j] = c[j] * x[j];
#pragma unroll
        for (int i = 0; i < 8; ++i) { unpack8(cr[i + 2], c); unpack8(xr[i + 2], x); float bv[8], o[8]; unpack8(br[i], bv);
#pragma unroll
            for (int j = 0; j < 8; ++j) { pc[j] = c[j] * x[j]; o[j] = bv[j] * (w0[j] * pa[j] + w1[j] * pb[j] + w2[j] * pc[j]); pa[j] = pb[j]; pb[j] = pc[j]; }
            *(u32x4*)(yd + (size_t)(row0 + i) * 512 + chunk * 8) = pack8(o); }
    }
}
constexpr int PH_PER_LAYER = 15, N_PHASES = 2 + DEPTH * PH_PER_LAYER - 1;
constexpr int F3C_WGS = ((MT - ML) / 256) * 4;
__device__ __forceinline__ void ph_prologue(Frame F0) { const Frame F = uniform_frame(F0); const PView V = pview(F);
    for (int u = F.bid; u < DEPTH * 96; u += F.G) mod_unit(F, V, u / 96, u % 96);
    if (F.bid == F.G - 1) rope_table(F, V);
    prep_weights(F, V, 0, 0, PREP_NT, F.bid, F.G, true);
}
__device__ __forceinline__ void ph_rows(Frame F0, int kind, int l) { const Frame F = uniform_frame(F0); const PView V = pview(F); kind = RFL(kind); l = RFL(l);
    const float* modall = (const float*)(V.ws + WS_MOD); const float* modl = modall + (size_t)l * 5 * 6144; const float* ng = V.in(6) + (size_t)l * 4 * 1024;
    bf16_t* U = (bf16_t*)V.out; bf16_t* X = (bf16_t*)(V.ws + WS_X); float* H = (float*)(V.ws + WS_H); const bool ctx_out = l < DEPTH - 1;
    if (kind == 0) rows_phase(F, V, MT, V.in(0), true, V.in(2), X, false, H, nullptr, nullptr, nullptr, 0, true, ng, modl, 0, 1, U, F.bid, F.G, 0, 2);
    else if (kind == 1) { const int skip = ctx_out ? F3C_WGS : 0;
        if (F.bid >= skip) rows_phase(F, V, ML, X, false, H, X, false, H, (const bf16_t*)(V.big + B_MX), ng + 1024, modl, 2, true, ng + 2048, modl, 3, 4, U, F.bid - skip, F.G - skip, 0, 1); }
    else if (kind == 4) rows_phase(F, V, MT, X, false, H, X, false, H, (const bf16_t*)(V.big + B_MX), ng + 1024, modl, 2, true, ng + 2048, modl, 3, 4, U, F.bid, F.G, 1, 2);
    else if (kind == 2) { const int skip = ctx_out ? F3C_WGS : 0;
        if (F.bid >= skip) rows_phase(F, V, ML, X, false, H, ctx_out ? (void*)X : (void*)V.out, !ctx_out, H, (const bf16_t*)(V.big + B_FX), ng + 3072, modl, 5, ctx_out, ng + 4096, modl + 5 * 6144, 0, 1, U, F.bid - skip, F.G - skip, 0, 1); }
    else rows_phase(F, V, MT, X, false, H, X, false, H, (const bf16_t*)(V.big + B_FX), ng + 3072, modl, 5, true, ng + 4096, modl + 5 * 6144, 0, 1, U, F.bid, F.G, 1, 2);
}
__device__ __forceinline__ void ph_gemm_store(Frame F0, int which, int l) { const Frame F = uniform_frame(F0); const PView V = pview(F); which = RFL(which); l = RFL(l);
    unsigned char* ws = V.ws; unsigned char* big = V.big; const char* U = (const char*)V.out; const int nMr = (l < DEPTH - 1 ? MT : ML) / 256;
    pg8::Sched S; pg8::EpiStore E; int K = 1024;
    S.A0 = U; S.A1 = U; S.A2 = U; S.A3 = U; S.lda = 1024; S.ldb = 1024; S.G = F.G; S.c = F.bid;
    if (which == 0) { S.B = (const char*)(ws + W_LSTM); S.nM = MT / 256; S.nN = NLSTM / 256; S.grp = S.nN; E.O = (bf16_t*)(big + B_PLSTM); E.ldc = NLSTM; }
    else if (which == 1) { S.B = (const char*)(ws + W_REST); S.nM = MT / 256; S.nN = NREST / 256; S.grp = S.nN; E.O = (bf16_t*)(big + B_PREST); E.ldc = NREST; }
    else if (which == 2) { const char* ys = (const char*)(big + B_YSB); S.A0 = (const char*)(big + B_YSA); S.A1 = ys; S.A2 = ys + YS_STRIDE; S.A3 = ys + 2 * YS_STRIDE; S.B = (const char*)(ws + W_B); S.lda = 512; S.ldb = 512;
        S.nM = nMr; S.nN = 16; S.grp = 4; E.O = (bf16_t*)(big + B_PROJ); E.ldc = PROJ_LD; K = 512; }
    else if (which == 3 || which == 8) { const size_t p0 = which == 8 ? (size_t)ML : 0;
        const char* a = (const char*)(big + B_MERGED) + p0 * 1024 * 2; S.A0 = a; S.A1 = a; S.A2 = a; S.A3 = a; S.B = (const char*)(ws + W_O); S.nM = which == 8 ? (MT - ML) / 256 : ML / 256; S.nN = 4; S.grp = 4; E.O = (bf16_t*)(big + B_MX) + p0 * 1024; E.ldc = 1024; }
    else { const size_t p0 = which == 7 ? (size_t)ML : 0;
        const char* a = (const char*)(big + B_ACT) + p0 * DFF * 2; S.A0 = a; S.A1 = a; S.A2 = a; S.A3 = a; S.B = (const char*)(ws + W_DN); S.lda = DFF; S.ldb = DFF; S.nM = which == 7 ? (MT - ML) / 256 : ML / 256; S.nN = 4; S.grp = 4;
        E.O = (bf16_t*)(big + B_FX) + p0 * 1024; E.ldc = 1024; K = DFF; }
    pg8::gemm_phase(F.lds, F.tid, K, S, E);
    if (l > 0 && which == 2) tail_prep(uniform_frame(F0), V, l, S.nM * S.nN, PREP_T4, PREP_T5, 0, 0, false);
}
__device__ __forceinline__ void ph_gemm_ffn(Frame F0, int l) { const Frame F = uniform_frame(F0); const PView V = pview(F); l = RFL(l);
    const char* U = (const char*)V.out; const int nMr = (l < DEPTH - 1 ? MT : ML) / 256;
    pg8::Sched S{U, U, U, U, (const char*)(V.ws + W_UP), 1024, 1024, nMr, 22, 22, F.G, F.bid};
    pg8::EpiFfn E{(bf16_t*)(V.big + B_ACT), (float*)(V.big + B_HB), V.in(17) + (size_t)l * 3 * 5632, (LAS float*)(F.lds + 132096)};
    pg8::gemm_phase(F.lds, F.tid, 1024, S, E);
    if (l > 0) tail_prep(uniform_frame(F0), V, l, S.nM * S.nN, PREP_T5, PREP_NT, 0, 0, false);
    if (l < DEPTH - 1) tail_prep(uniform_frame(F0), V, l + 1, S.nM * S.nN, PREP_T1, PREP_T2, PREP_T3, PREP_T4, false);
}
__device__ __forceinline__ void ph_ffn_fix(Frame F0, int l) { const Frame F = uniform_frame(F0); const PView V = pview(F); l = RFL(l);
    const int nMr = (l < DEPTH - 1 ? MT : ML) / 256; const float* HB = (const float*)(V.big + B_HB); bf16_t* act = (bf16_t*)(V.big + B_ACT); const float* cw = V.in(17) + (size_t)l * 3 * 5632;
    const int ntask = nMr * 2 * 352;
#pragma unroll 1
    for (int t = F.bid * 512 + F.tid; t < ntask; t += F.G * 512) { const int chunk = t % 352, q = t / 352, which = q & 1, pm = q >> 1, c0 = chunk * 8;
        const bool first = pm >= 128 || (pm & 31) == 0, last = pm >= 128 || (pm & 31) == 31;
        const float* hp = HB + (size_t)pm * 4 * 5632;
        const float* rp = which == 0 ? (first ? nullptr : hp - 5632) : hp + 2 * 5632;
        const float* rc = which == 0 ? hp : hp + 3 * 5632;
        const float* rn = which == 0 ? hp + 5632 : (last ? nullptr : hp + 4 * 5632);
        float o[8];
#pragma unroll
        for (int half = 0; half < 2; ++half) { float res[2][4];
#pragma unroll
            for (int bj = 0; bj < 2; ++bj) { const int col = bj * 2816 + c0 + 4 * half; const f32x4 z = {0.f, 0.f, 0.f, 0.f};
                const f32x4 p = rp ? *(const f32x4*)(rp + col) : z, c = *(const f32x4*)(rc + col), n = rn ? *(const f32x4*)(rn + col) : z;
                const f32x4 w0 = *(const f32x4*)(cw + col), w1 = *(const f32x4*)(cw + 5632 + col), w2 = *(const f32x4*)(cw + 2 * 5632 + col);
#pragma unroll
                for (int j = 0; j < 4; ++j) res[bj][j] = w0[j] * p[j] + w1[j] * c[j] + w2[j] * n[j]; }
#pragma unroll
            for (int j = 0; j < 4; ++j) o[4 * half + j] = siluf_(res[0][j]) * res[1][j]; }
        *(u32x4*)(act + (size_t)(pm * 256 + (which ? 255 : 0)) * DFF + c0) = pack8(o); }
}
__device__ __forceinline__ void ph_gemm_merge(Frame F0, int l) { const Frame F = uniform_frame(F0); const PView V = pview(F); l = RFL(l);
    const char* U = (const char*)V.out; const int nMr = (l < DEPTH - 1 ? MT : ML) / 256;
    pg8::Sched S{U, U, U, U, (const char*)(V.ws + W_GATE), 1024, 1024, nMr, 16, 16, F.G, F.bid};
    pg8::EpiMerge E{(const bf16_t*)(V.big + B_PROJ), (bf16_t*)(V.big + B_MERGED)}; pg8::gemm_phase(F.lds, F.tid, 1024, S, E);
    if (l < DEPTH - 1) tail_prep(uniform_frame(F0), V, l + 1, S.nM * S.nN, 0, PREP_T1, PREP_T2, PREP_T3, true);
}
__device__ __forceinline__ void ph_pass1(Frame F0, int l) { const Frame F = uniform_frame(F0); const PView V = pview(F); l = RFL(l);
    for (int u = F.G - 1 - F.bid; u < NCHAIN_UNITS / 2; u += F.G) lstm_pass1_unit(unit_frame(F), V, l, u); }
__device__ __forceinline__ void ph_scan(Frame F0) { const Frame F = uniform_frame(F0); const PView V = pview(F); lstm_scan(F, V); }
__device__ __forceinline__ void ph_pass2(Frame F0, int l) { const Frame F = uniform_frame(F0); const PView V = pview(F); l = RFL(l);
    const int nlat = NB * 4 * 32 * 2, nu = nlat + ((l < DEPTH - 1) ? NB * 4 * 2 : 0);
    for (int u = F.bid; u < nu; u += F.G) { const int qh = u & 1; int blk, bh;
        if (u < nlat) { const int r = u >> 1; blk = 1 + (r & 31); bh = r >> 5; } else { blk = 0; bh = (u - nlat) >> 1; }
        lstm_pass2_unit(unit_frame(F), V, l, bh >> 2, bh & 3, blk, qh); } }
__device__ __forceinline__ void ph_attn(Frame F0, int l) { const Frame F = uniform_frame(F0); const PView V = pview(F); l = RFL(l);
    { const f32x4* rt = (const f32x4*)(V.ws + WS_ROPE); LAS f32x4* rl = (LAS f32x4*)(F.lds + 36864); __syncthreads(); rl[F.tid] = rt[F.tid]; rl[512 + F.tid] = rt[512 + F.tid]; __syncthreads(); }
    const int nlat = NB * 2 * 128, nctx = (l < DEPTH - 1) ? NB * 2 * 4 : 0;
    for (int u = F.bid; u < nlat; u += F.G) attn_unit(unit_frame(F), V, l, false, u >> 8, (u >> 7) & 1, u & 127);
    for (int q = F.G - 1 - F.bid; q < nctx; q += F.G) attn_unit(unit_frame(F), V, l, true, q >> 3, (q >> 2) & 1, q & 3); }
__device__ __forceinline__ void ph_poolconv(Frame F0, int l) { const Frame F = uniform_frame(F0); const PView V = pview(F); l = RFL(l);
    const int Mrows = (l < DEPTH - 1) ? MT : ML; pool_tasks(F, V, Mrows); sconv_tasks(F, V, l, Mrows); }

__global__ void __launch_bounds__(512, 2) fwd(Params P) {
    extern __shared__ __attribute__((aligned(16))) unsigned char lds_raw[];
    Frame F; F.lds = (LAS unsigned char*)lds_raw; F.wave = __builtin_amdgcn_readfirstlane((int)threadIdx.x >> 6); F.tid = 0; F.lane = 0; F.G = gridDim.x; F.bid = blockIdx.x; F.P = &P;
    volatile LAS unsigned* ctlw = (volatile LAS unsigned*)(F.lds + LDS_WORK);
    { const int t0 = F.wave * 64 + hw_lane(); if (t0 < 16) ctlw[t0] = 0u; }
    __syncthreads();
    const size_t bar_off = WS_CTL + (size_t)P.bar_region * 16384;
    XcdBarrier bar; bar.bar = (unsigned*)(P.ws + bar_off); bar.x = 0; bar.st = ctlw;
    const int lo = P.ph_lo, hi = P.ph_hi;
    if (hi - lo > 1) bar = xcd_barrier_post((unsigned*)(P.ws + bar_off), ctlw, F.wave == 0 && hw_lane() == 0);
#define IN(k) (lo <= (k) && (k) < hi)
#pragma unroll 1
    for (int step = lo; step < hi; ++step) {
        const int l = step < 2 ? 0 : (step - 2) / PH_PER_LAYER, k = step < 2 ? step - 2 : (step - 2) % PH_PER_LAYER;
        if (l == DEPTH - 1 && k == 9) continue;
        switch (k) {
            case -2: if (KON(0)) ph_prologue(F); break;
            case -1: if (KON(1)) ph_rows(F, 0, 0); break;
            case 0: case 1: case 5: case 7: case 8: case 12: case 13:
                if (k == 1 && KON(3)) ph_pass1(F, l);
                if (KON(2) && !((k == 8 || k == 13) && l == DEPTH - 1)) ph_gemm_store(F, k == 0 ? 0 : (k == 1 ? 1 : (k == 5 ? 2 : (k == 7 ? 3 : (k == 8 ? 8 : (k == 12 ? 6 : 7))))), l);
                if ((k == 8 || k == 13) && KON(1)) ph_rows(F, k == 8 ? 1 : 2, l);
                break;
            case 10: if (KON(8)) ph_gemm_ffn(F, l); break;
            case 11: if (KON(8)) ph_ffn_fix(F, l); break;
            case 2: if (KON(4)) ph_scan(F); break;
            case 3: if (KON(5)) ph_pass2(F, l); break;
            case 4: if (KON(6)) ph_attn(F, l); if (KON(9)) ph_poolconv(F, l); break;
            case 6: if (KON(7)) ph_gemm_merge(F, l); break;
            default: if (KON(1)) ph_rows(F, k == 9 ? 4 : 3, l); break;
        }
        if (step + 1 < hi) { unsigned long long bp = (unsigned long long)(P.ws + bar_off); asm volatile("" : "+v"(bp)); bar.bar = (unsigned*)bp; xcd_barrier(bar, F.wave == 0 && hw_lane() == 0); }
    }
#undef IN
}

extern "C" void kernel_launch(void* const* d_in, const int* in_sizes, int n_in, void* d_out, int out_size, void* d_ws, size_t ws_size, hipStream_t stream) {
    static int grid = 0;
    if (grid == 0) {
        if (n_in != 19 || out_size != ML * D || ws_size < WS_END) { fprintf(stderr, "kernel_launch: need 19 inputs, out %d, ws >= %zu; got %d, %d, %zu\n", ML * D, (size_t)WS_END, n_in, out_size, ws_size); grid = -1; return; }
        int dev = 0, cus = 0, per_cu = 0;
        if (hipGetDevice(&dev) != hipSuccess || hipDeviceGetAttribute(&cus, hipDeviceAttributeMultiprocessorCount, dev) != hipSuccess) { grid = -1; return; }
        if (hipFuncSetAttribute((const void*)fwd, hipFuncAttributeMaxDynamicSharedMemorySize, LDS_BYTES) != hipSuccess) { fprintf(stderr, "kernel_launch: hipFuncSetAttribute failed\n"); grid = -1; return; }
        if (hipOccupancyMaxActiveBlocksPerMultiprocessor(&per_cu, (const void*)fwd, 512, LDS_BYTES) != hipSuccess || per_cu < 1) { fprintf(stderr, "kernel_launch: occupancy query says %d\n", per_cu); (void)hipGetLastError(); }
        grid = cus;
    }
    if (grid < 0) return;
    (void)hipMemsetAsync((char*)d_ws + WS_CTL, 0, 131072, stream);
    Params p{};
    for (int i = 0; i < 19; ++i) p.in[i] = (const float*)d_in[i];
    p.out = (float*)d_out; p.ws = (unsigned char*)d_ws;
#if MK_PER_PHASE
    for (int k = 0; k < N_PHASES; ++k) { p.ph_lo = k; p.ph_hi = k + 1; hipLaunchKernelGGL(fwd, dim3(grid), dim3(512), LDS_BYTES, stream, p); }
#elif defined(PROBE_K)
    { int lo = 0, reg = 0;
      for (int l = 0; l < DEPTH; ++l) { const int st = (PROBE_K < 0) ? PROBE_K + 2 : 2 + l * PH_PER_LAYER + PROBE_K; if (PROBE_K < 0 && l > 0) break;
          p.ph_lo = lo; p.ph_hi = st + 1; p.bar_region = reg++; hipLaunchKernelGGL(fwd, dim3(grid), dim3(512), LDS_BYTES, stream, p);
          for (int r = 0; r < PROBE_R; ++r) { p.ph_lo = st; p.ph_hi = st + 1; p.bar_region = 7; hipLaunchKernelGGL(fwd, dim3(grid), dim3(512), LDS_BYTES, stream, p); }
          lo = st + 1; }
      if (lo < N_PHASES) { p.ph_lo = lo; p.ph_hi = N_PHASES; p.bar_region = reg++; hipLaunchKernelGGL(fwd, dim3(grid), dim3(512), LDS_BYTES, stream, p); } }
#else
    p.ph_lo = 0; p.ph_hi = N_PHASES; p.bar_region = 0;
    hipLaunchKernelGGL(fwd, dim3(grid), dim3(512), LDS_BYTES, stream, p);
#endif
}
```

```cpp
#include <hip/hip_runtime.h>
#include <cstdio>
#include <cstdint>

#ifndef MK_PER_PHASE
#define MK_PER_PHASE 0
#endif

#ifndef MK_ONLY
#define MK_ONLY -1
#endif
#define KON(k) (MK_ONLY < 0 || MK_ONLY == (k))
#define LAS __attribute__((address_space(3)))
typedef unsigned short bf16_t;
typedef short bf16x8 __attribute__((ext_vector_type(8)));
typedef short s16x4 __attribute__((ext_vector_type(4)));
typedef float f32x4 __attribute__((ext_vector_type(4)));
typedef float f32x2 __attribute__((ext_vector_type(2)));
typedef unsigned u32x4 __attribute__((ext_vector_type(4)));
typedef unsigned u32x2 __attribute__((ext_vector_type(2)));
typedef __bf16 bf16v2 __attribute__((ext_vector_type(2)));

constexpr int D = 1024, NB = 4, SEQ = 8192, CTX = 256, DEPTH = 4;
constexpr int ML = NB * SEQ, MC = NB * CTX, MT = ML + MC;
constexpr int INW = 8976;
constexpr int NLSTM = 2304, NREST = 2816, NGATE = 4096, DFF = 2816, NUPH = 2816;
constexpr int PROJ_LD = 4160;
constexpr int NBLK = 33;
constexpr int NCHAIN_UNITS = NB * 4 * 2 * NBLK;
constexpr int ST_ELEMS = 129 * 128;
constexpr float EPS = 1e-6f;
constexpr int PR_POOL = 0, PR_AQ = 512, PR_AK = 1024, PR_AV = 1152, PR_SB = 1280, PR_SC = 1792, PR_SX = 2304;

constexpr size_t WS_CTL = 0;
constexpr size_t WS_MOD = 131072;
constexpr size_t WS_ROPE = WS_MOD + (size_t)DEPTH * 5 * 6144 * 4;
constexpr size_t WS_DEC = WS_ROPE + 128 * 16 * 2 * 4;
constexpr size_t WS_W = 1048576;
constexpr size_t W_LSTM = WS_W;
constexpr size_t W_REST = W_LSTM + (size_t)NLSTM * 1024 * 2;
constexpr size_t W_GATE = W_REST + (size_t)NREST * 1024 * 2;
constexpr size_t W_B = W_GATE + (size_t)NGATE * 1024 * 2;
constexpr size_t W_O = W_B + (size_t)4 * 1024 * 512 * 2;
constexpr size_t W_UP = W_O + (size_t)1024 * 1024 * 2;
constexpr size_t W_DN = W_UP + (size_t)2 * NUPH * 1024 * 2;
constexpr size_t WS_H = W_DN + (size_t)1024 * DFF * 2;
constexpr size_t WS_X = WS_H + (size_t)MC * 1024 * 4, WS_U = WS_X;
constexpr size_t WS_BIG = WS_U + (size_t)MT * 1024 * 2;
constexpr size_t YS_STRIDE = (size_t)MT * 512 * 2;
constexpr size_t B_PLSTM = 0;
constexpr size_t B_ST = (size_t)MT * NLSTM * 2;
constexpr size_t B_PREST = B_ST + (size_t)NCHAIN_UNITS * ST_ELEMS * 2;
constexpr size_t B_YSB = 0;
constexpr size_t B_PROJ = 3 * YS_STRIDE;
constexpr size_t B_YSA = B_PROJ + (size_t)MT * PROJ_LD * 2;
constexpr size_t B_MERGED = 0, B_MX = B_PROJ, B_ACT = (size_t)MT * NUPH * 2, B_FX = 0;
constexpr size_t B_HB = B_ACT + (size_t)MT * DFF * 2;
constexpr size_t B_GT = B_HB + 1048576;
constexpr size_t BIG_BYTES = B_YSA + YS_STRIDE;
constexpr size_t WS_END = WS_BIG + BIG_BYTES;
static_assert(B_PREST + (size_t)MT * NREST * 2 <= B_YSA && B_PREST % 256 == 0 && B_PROJ % 256 == 0 && B_YSA % 256 == 0, "layout");
static_assert(B_HB + (size_t)(MT / 256) * 4 * 5632 * 4 <= BIG_BYTES && B_GT >= B_PREST + (size_t)MT * NREST * 2 && B_GT + (size_t)NCHAIN_UNITS * 512 * 4 <= B_YSA, "act + halo rows overflow / gate table placement");
static_assert(W_LSTM % 256 == 0 && WS_U % 256 == 0 && WS_BIG % 256 == 0, "alignment");

constexpr int LDS_WORK = 155648;
constexpr int LDS_BYTES = LDS_WORK + 256;

struct Params { const float* in[19]; float* out; unsigned char* ws; int ph_lo, ph_hi, bar_region, pad; };

__device__ __forceinline__ float bf2f(bf16_t b) { return __uint_as_float(((unsigned)b) << 16); }
__device__ __forceinline__ unsigned pk2(float lo, float hi) { f32x2 v = {lo, hi}; bf16v2 r = __builtin_convertvector(v, bf16v2); return __builtin_bit_cast(unsigned, r); }
__device__ __forceinline__ bf16_t f2bf(float f) { return (bf16_t)(pk2(f, 0.f) & 0xffffu); }
__device__ __forceinline__ float lo16(unsigned w) { return __uint_as_float(w << 16); }
__device__ __forceinline__ float hi16(unsigned w) { return __uint_as_float(w & 0xffff0000u); }
__device__ __forceinline__ void unpack8(const u32x4 v, float (&f)[8]) { f[0] = lo16(v.x); f[1] = hi16(v.x); f[2] = lo16(v.y); f[3] = hi16(v.y); f[4] = lo16(v.z); f[5] = hi16(v.z); f[6] = lo16(v.w); f[7] = hi16(v.w); }
__device__ __forceinline__ u32x4 pack8(const float (&f)[8]) { u32x4 r; r.x = pk2(f[0], f[1]); r.y = pk2(f[2], f[3]); r.z = pk2(f[4], f[5]); r.w = pk2(f[6], f[7]); return r; }
__device__ __forceinline__ float sigmoidf_(float x) { return 1.0f / (1.0f + __expf(-x)); }
__device__ __forceinline__ float siluf_(float x) { return x / (1.0f + __expf(-x)); }
__device__ __forceinline__ float logsigmoidf_(float x) { return fminf(x, 0.f) - __logf(1.0f + __expf(-fabsf(x))); }
__device__ __forceinline__ float lshfl(float v, int src) { return __int_as_float(__builtin_amdgcn_ds_bpermute(src << 2, __float_as_int(v))); }
__device__ __forceinline__ float wave_sum(float v, int lane) {
#pragma unroll
    for (int o = 32; o >= 1; o >>= 1) v += lshfl(v, lane ^ o);
    return v; }
__device__ __forceinline__ u32x4 ldg16(const bf16_t* p) { return *(const u32x4*)p; }
#define MFMA16(a, b, c) __builtin_amdgcn_mfma_f32_16x16x32_bf16((a), (b), (c), 0, 0, 0)

__device__ __forceinline__ int hw_lane() { int l; asm volatile("v_mbcnt_lo_u32_b32 %0, -1, 0\n\tv_mbcnt_hi_u32_b32 %0, -1, %0" : "=v"(l)); return l; }
#define XB_TMO      128
#define XB_XCNT(j)  (256  + 64 * (j))
#define XB_XSUB(j)  (1280 + 64 * (j))
#define XB_XGEN(j)  (2304 + 64 * (j))
#define XB_TOP      3328
#define XB_TOPGEN   3392
#define XCD_BAR_WORDS 3456
#define XB_SPIN_CAP (1u << 22)
__device__ __forceinline__ unsigned xb_ld(unsigned* p)              { return __hip_atomic_load(p, __ATOMIC_RELAXED, __HIP_MEMORY_SCOPE_AGENT); }
__device__ __forceinline__ unsigned xb_add(unsigned* p, unsigned v) { return __hip_atomic_fetch_add(p, v, __ATOMIC_RELAXED, __HIP_MEMORY_SCOPE_AGENT); }
__device__ __forceinline__ unsigned xb_xcc_id() { return (unsigned)__builtin_amdgcn_s_getreg((3 << 11) | 20) & 0xFu; }
#define XB_SPIN(cond, bar) do { unsigned _sp = 0; while (cond) { __builtin_amdgcn_s_sleep(1); \
    if ((++_sp & 255u) == 0u) { if (xb_ld(&(bar)[XB_TMO])) break; if (_sp > XB_SPIN_CAP) { atomicAdd(&(bar)[XB_TMO], 1u); break; } } } } while (0)
struct XcdBarrier { unsigned* bar; unsigned x; volatile LAS unsigned* st; };
__device__ __forceinline__ XcdBarrier xcd_barrier_post(unsigned* bar, volatile LAS unsigned* st, bool leader) {
    XcdBarrier b; b.bar = bar; b.x = xb_xcc_id(); b.st = st;
    if (leader) (void)xb_add(&bar[XB_XCNT(b.x)], 1u);
    return b;
}
__device__ __forceinline__ void xcd_barrier_complete(unsigned* bar, unsigned x, unsigned& nloc, unsigned& nx) {
    const unsigned G = gridDim.x * gridDim.y * gridDim.z;
    unsigned sum, cnt, mine, sp = 0u;
    for (;;) {
        sum = 0u; cnt = 0u; mine = 0u;
#pragma unroll
        for (unsigned j = 0; j < 16; ++j) { const unsigned c = xb_ld(&bar[XB_XCNT(j)]); sum += c; cnt += (c > 0u) ? 1u : 0u; }
        mine = xb_ld(&bar[XB_XCNT(x)]);
        if (sum == G) break;
        __builtin_amdgcn_s_sleep(1);
        if ((++sp & 255u) == 0u) { if (xb_ld(&bar[XB_TMO])) break; if (sp > XB_SPIN_CAP) { atomicAdd(&bar[XB_TMO], 1u); break; } }
    }
    nloc = mine > 0u ? mine : 1u; nx = cnt > 0u ? cnt : 1u;
}
__device__ __forceinline__ void xcd_barrier(const XcdBarrier& b, bool leader) {
    asm volatile("s_waitcnt vmcnt(0)" ::: "memory");
    __syncthreads();
    if (leader) {
        unsigned* bar = b.bar;
        __builtin_amdgcn_s_waitcnt(0);
        unsigned nloc = b.st[0], nx = b.st[1];
        if (nloc == 0u) { xcd_barrier_complete(bar, b.x, nloc, nx); b.st[0] = nloc; b.st[1] = nx; }
        const unsigned old = xb_add(&bar[XB_XSUB(b.x)], 1u);
        const unsigned gen = old / nloc;
        if (old + 1u == (gen + 1u) * nloc) {
            __builtin_amdgcn_fence(__ATOMIC_RELEASE, "agent");
            asm volatile("s_waitcnt vmcnt(0)" ::: "memory");
            const unsigned og = xb_add(&bar[XB_TOP], 1u);
            const unsigned tg = og / nx;
            if (og + 1u == (tg + 1u) * nx) xb_add(&bar[XB_TOPGEN], 1u);
            else XB_SPIN(xb_ld(&bar[XB_TOPGEN]) == tg, bar);
            __builtin_amdgcn_fence(__ATOMIC_ACQUIRE, "agent");
            xb_add(&bar[XB_XGEN(b.x)], 1u);
            asm volatile("s_waitcnt vmcnt(0)" ::: "memory");
        } else {
            XB_SPIN(xb_ld(&bar[XB_XGEN(b.x)]) == gen, bar);
            __builtin_amdgcn_fence(__ATOMIC_ACQUIRE, "agent");
            asm volatile("s_waitcnt vmcnt(0)" ::: "memory");
        }
    }
    __syncthreads();
}

namespace pg8 {
constexpr int BM = 256, BK = 64, HALF = 128, HTB = HALF * BK * 2, STAGE_BYTES = 8 * HTB, NXCD = 8, WGM = 8;
__device__ __forceinline__ int lds_byte(int r, int c) { const int st = (r >> 4) * 2 + (c >> 5), rr = r & 15, cc = c & 31, ob = rr * 64 + cc * 2; return st * 1024 + (ob ^ (((ob >> 9) & 1) << 5)); }
__device__ __forceinline__ void stage_rc(int b, int& R, int& C) { const int st = b / 1024, sb = b % 1024, swz = sb ^ (((sb >> 9) & 1) << 5); R = (st >> 1) * 16 + swz / 64; C = (st & 1) * 32 + (swz % 64) / 2; }
__device__ __forceinline__ int perm32(int rho) { const int n = rho >> 4, i = rho & 15; return 8 * (i >> 2) + 4 * n + (i & 3); }
struct Unit { const char* a; const char* b; int orow, ocol; };
struct Sched {
    const char* A0; const char* A1; const char* A2; const char* A3; const char* B;
    int lda, ldb, nM, nN, grp, G, c;
    __device__ __forceinline__ bool next(int i, Unit& u) const {
        const int nwg = nM * nN; const int L = i * G + c; if (L >= nwg) return false;
        int wgid = L; { const int q = nwg / NXCD, r = nwg % NXCD, xcd = wgid % NXCD, off = wgid / NXCD; wgid = (xcd < r ? xcd * (q + 1) : r * (q + 1) + (xcd - r) * q) + off; }
        const int nig = WGM * nN, gid = wgid / nig, fm = gid * WGM, gsz = (nM - fm) < WGM ? (nM - fm) : WGM;
        const int pm = fm + ((wgid % nig) % gsz), pn = (wgid % nig) / gsz;
        const int ag = pn / grp; const char* ab = ag == 0 ? A0 : (ag == 1 ? A1 : (ag == 2 ? A2 : A3));
        u.a = ab + (size_t)pm * BM * lda * 2; u.b = B + (size_t)pn * BM * ldb * 2; u.orow = pm * BM; u.ocol = pn * BM; return true;
    }
};
struct EpiStore {
    static constexpr bool PERM = true, QUAD = true;
    template <int AI, int BJ> __device__ __forceinline__ void quad(const f32x4 (&acc)[2][2][4][2], const Unit& u, int wr, int wc, int fr, int fq) const {
        const int row0 = u.orow + wr * 64 + fr + AI * HALF, col0 = u.ocol + wc * 32 + 8 * fq + BJ * HALF;
#pragma unroll
        for (int m = 0; m < 4; ++m) { const f32x4 v0 = acc[AI][BJ][m][0], v1 = acc[AI][BJ][m][1];
            u32x4 w; w.x = pk2(v0[0], v0[1]); w.y = pk2(v0[2], v0[3]); w.z = pk2(v1[0], v1[1]); w.w = pk2(v1[2], v1[3]);
            *(u32x4*)(O + (size_t)(row0 + m * 16) * ldc + col0) = w; }
    }
    bf16_t* O; int ldc;
    __device__ __forceinline__ void operator()(const f32x4 (&acc)[2][2][4][2], const Unit& u, int wr, int wc, int fr, int fq) const {
        const int row0 = u.orow + wr * 64 + fr, col0 = u.ocol + wc * 32 + 8 * fq;
#pragma unroll
        for (int ai = 0; ai < 2; ++ai)
#pragma unroll
            for (int m = 0; m < 4; ++m) { bf16_t* rowp = O + (size_t)(row0 + ai * HALF + m * 16) * ldc + col0;
#pragma unroll
                for (int bj = 0; bj < 2; ++bj) { const f32x4 v0 = acc[ai][bj][m][0], v1 = acc[ai][bj][m][1];
                    u32x4 w; w.x = pk2(v0[0], v0[1]); w.y = pk2(v0[2], v0[3]); w.z = pk2(v1[0], v1[1]); w.w = pk2(v1[2], v1[3]);
                    *(u32x4*)(rowp + bj * HALF) = w; } }
    }
};
struct EpiMerge {
    static constexpr bool PERM = false, QUAD = false;
    const bf16_t* PROJ; bf16_t* O;
    __device__ __forceinline__ void operator()(f32x4 (&acc)[2][2][4][2], const Unit& u, int wr, int wc, int fr, int fq) const {
        const int row0 = u.orow + wr * 64 + fr, d0 = (u.ocol >> 8) * 64 + wc * 16 + 4 * fq;
        u32x2 pv[2][4][4];
#pragma unroll
        for (int ai = 0; ai < 2; ++ai)
#pragma unroll
            for (int m = 0; m < 4; ++m) { const bf16_t* pp = PROJ + (size_t)(row0 + ai * HALF + m * 16) * PROJ_LD + d0;
#pragma unroll
                for (int nb = 0; nb < 4; ++nb) pv[ai][m][nb] = *(const u32x2*)(pp + nb * 1024); }
        __builtin_amdgcn_sched_barrier(0);
#pragma unroll
        for (int ai = 0; ai < 2; ++ai)
#pragma unroll
            for (int bj = 0; bj < 2; ++bj)
#pragma unroll
                for (int m = 0; m < 4; ++m)
#pragma unroll
                    for (int n = 0; n < 2; ++n) { f32x4 a = acc[ai][bj][m][n]; a[0] = sigmoidf_(a[0]); a[1] = sigmoidf_(a[1]); a[2] = sigmoidf_(a[2]); a[3] = sigmoidf_(a[3]); acc[ai][bj][m][n] = a; }
        __builtin_amdgcn_sched_barrier(0);
#pragma unroll
        for (int ai = 0; ai < 2; ++ai)
#pragma unroll
            for (int m = 0; m < 4; ++m) { f32x4 s = {0.f, 0.f, 0.f, 0.f};
#pragma unroll
                for (int bj = 0; bj < 2; ++bj)
#pragma unroll
                    for (int n = 0; n < 2; ++n) { const u32x2 p2 = pv[ai][m][2 * bj + n]; const f32x4 a = acc[ai][bj][m][n];
                        s[0] += a[0] * lo16(p2.x); s[1] += a[1] * hi16(p2.x); s[2] += a[2] * lo16(p2.y); s[3] += a[3] * hi16(p2.y); }
                u32x2 w; w.x = pk2(s[0], s[1]); w.y = pk2(s[2], s[3]);
                *(u32x2*)(O + (size_t)(row0 + ai * HALF + m * 16) * 1024 + d0) = w; }
    }
};

__device__ __forceinline__ float dpp_prev_keep(float edge, float cur) { return __int_as_float(__builtin_amdgcn_update_dpp(__float_as_int(edge), __float_as_int(cur), 0x111, 0xf, 0xf, false)); }
__device__ __forceinline__ float dpp_next_keep(float edge, float cur) { return __int_as_float(__builtin_amdgcn_update_dpp(__float_as_int(edge), __float_as_int(cur), 0x101, 0xf, 0xf, false)); }
__device__ __forceinline__ float dpp_ror1(float v) { return __int_as_float(__builtin_amdgcn_update_dpp(0, __float_as_int(v), 0x121, 0xf, 0xf, true)); }
__device__ __forceinline__ float dpp_ror15(float v) { return __int_as_float(__builtin_amdgcn_update_dpp(0, __float_as_int(v), 0x12f, 0xf, 0xf, true)); }
struct EpiFfn {
    static constexpr bool PERM = true, QUAD = false;
    bf16_t* act; float* HB; const float* cw; LAS float* XB;
    __device__ __forceinline__ void operator()(f32x4 (&acc)[2][2][4][2], const Unit& u, int wr, int wc, int fr, int fq) const {
        asm volatile("" : "+v"(fr), "+v"(fq));
        const int pm = u.orow >> 8, pt = u.ocol >> 8, ch0 = pt * 128 + wc * 32 + 8 * fq, wv = wr * 4 + wc;
#pragma unroll
        for (int ai = 0; ai < 2; ++ai) {
            if (fr == 0) { LAS f32x4* d = (LAS f32x4*)(XB + (((wv * 4) + ai * 2 + 0) * 4 + fq) * 16); d[0] = acc[ai][0][0][0]; d[1] = acc[ai][0][0][1]; d[2] = acc[ai][1][0][0]; d[3] = acc[ai][1][0][1]; }
            if (fr == 15) { LAS f32x4* d = (LAS f32x4*)(XB + (((wv * 4) + ai * 2 + 1) * 4 + fq) * 16); d[0] = acc[ai][0][3][0]; d[1] = acc[ai][0][3][1]; d[2] = acc[ai][1][3][0]; d[3] = acc[ai][1][3][1]; } }
        if (wr == 0 && fr < 2) { float* h = HB + ((size_t)pm * 4 + fr) * 5632 + ch0;
            *(f32x4*)h = acc[0][0][0][0]; *(f32x4*)(h + 4) = acc[0][0][0][1]; *(f32x4*)(h + 2816) = acc[0][1][0][0]; *(f32x4*)(h + 2820) = acc[0][1][0][1]; }
        if (wr == 1 && fr >= 14) { float* h = HB + ((size_t)pm * 4 + (fr - 12)) * 5632 + ch0;
            *(f32x4*)h = acc[1][0][3][0]; *(f32x4*)(h + 4) = acc[1][0][3][1]; *(f32x4*)(h + 2816) = acc[1][1][3][0]; *(f32x4*)(h + 2820) = acc[1][1][3][1]; }
        asm volatile("s_waitcnt lgkmcnt(0)" ::: "memory"); __builtin_amdgcn_s_barrier(); asm volatile("" ::: "memory");
        __builtin_amdgcn_s_barrier(); asm volatile("" ::: "memory");
#pragma unroll
        for (int bj = 0; bj < 2; ++bj)
#pragma unroll
            for (int nn = 0; nn < 2; ++nn) {
                const f32x4 w0 = *(const f32x4*)(cw + bj * 2816 + ch0 + 4 * nn), w1 = *(const f32x4*)(cw + 5632 + bj * 2816 + ch0 + 4 * nn), w2 = *(const f32x4*)(cw + 2 * 5632 + bj * 2816 + ch0 + 4 * nn);
#pragma unroll
                for (int ai = 0; ai < 2; ++ai) {
                    f32x4 xp = {0.f, 0.f, 0.f, 0.f}, xn = xp;
                    if (wr == 1 || ai == 1) { const int swv = wr == 1 ? wc : 4 + wc, sslot = wr == 1 ? ai * 2 + 1 : 1; xp = *(const LAS f32x4*)(XB + (((swv * 4) + sslot) * 4 + fq) * 16 + bj * 8 + nn * 4); }
                    if (wr == 0 || ai == 0) { const int swv = wr == 0 ? 4 + wc : wc, sslot = wr == 0 ? ai * 2 : 2; xn = *(const LAS f32x4*)(XB + (((swv * 4) + sslot) * 4 + fq) * 16 + bj * 8 + nn * 4); }
                    f32x4 po = xp;
#pragma unroll
                    for (int m = 0; m < 4; ++m) { const f32x4 c = acc[ai][bj][m][nn]; f32x4 rr;
#pragma unroll
                        for (int j = 0; j < 4; ++j) {
                            const float pe = m > 0 ? dpp_ror1(po[j]) : xp[j];
                            const float ne = m < 3 ? dpp_ror15(acc[ai][bj][m < 3 ? m + 1 : 3][nn][j]) : xn[j];
                            const float pv = dpp_prev_keep(pe, c[j]), nv = dpp_next_keep(ne, c[j]);
                            rr[j] = w0[j] * pv + w1[j] * c[j] + w2[j] * nv; }
                        asm volatile("" : "+v"(rr[0]), "+v"(rr[1]), "+v"(rr[2]), "+v"(rr[3]));
                        po = c; acc[ai][bj][m][nn] = rr; }
                    __builtin_amdgcn_sched_barrier(0);
                }
            }
        const int row0 = u.orow + wr * 64 + fr;
#pragma unroll
        for (int ai = 0; ai < 2; ++ai)
#pragma unroll
            for (int m = 0; m < 4; ++m) { const f32x4 g0 = acc[ai][0][m][0], g1 = acc[ai][0][m][1], v0 = acc[ai][1][m][0], v1 = acc[ai][1][m][1];
                u32x4 o; o.x = pk2(siluf_(g0[0]) * v0[0], siluf_(g0[1]) * v0[1]); o.y = pk2(siluf_(g0[2]) * v0[2], siluf_(g0[3]) * v0[3]);
                o.z = pk2(siluf_(g1[0]) * v1[0], siluf_(g1[1]) * v1[1]); o.w = pk2(siluf_(g1[2]) * v1[2], siluf_(g1[3]) * v1[3]);
                *(u32x4*)(act + (size_t)(row0 + ai * HALF + m * 16) * DFF + ch0) = o; __builtin_amdgcn_sched_barrier(0); }
    }
};

template <class Epi>
__device__ __forceinline__ void gemm_phase(LAS unsigned char* lds, const int tid, const int K, const Sched& S, const Epi& E) {
    const int wid = __builtin_amdgcn_readfirstlane(tid >> 6), lane = tid & 63, wr = wid >> 2, wc = wid & 3, fr = lane & 15, fq = lane >> 4;
    const int nt = K / BK; const int lda = S.lda, ldb = S.ldb;
    unsigned voffA, voffB; { int R, C; stage_rc(tid * 16, R, C); const int Rb = Epi::PERM ? ((R & ~31) + perm32(R & 31)) : R;
        voffA = (unsigned)(R * lda + C) * 2u; voffB = (unsigned)(Rb * ldb + C) * 2u; }
    const unsigned skipoffA = (unsigned)(64 * lda * 2), skipoffB = (unsigned)(64 * ldb * 2);
    constexpr unsigned kstep = BK * 2;
    const unsigned hstepA = (unsigned)(HALF * lda * 2), hstepB = (unsigned)(HALF * ldb * 2);
    const unsigned ldsw = (unsigned)wid * 1024u;
    const int aoff = lds_byte(wr * 64 + fr, fq * 8), boff = lds_byte(wc * 32 + fr, fq * 8);
#define PG8_SA(b, h) (((b) * 2 + (h)) * HTB)
#define PG8_SB(b, h) ((4 + (b) * 2 + (h)) * HTB)
#define PG8_STAGE(bufoff, gbase, voff) do { _Pragma("unroll") for (int _i = 0; _i < 2; ++_i) \
        __builtin_amdgcn_global_load_lds((const unsigned*)((const char*)(gbase) + (_i ? skip##voff : 0u) + (v##voff)), (LAS unsigned*)(lds + (bufoff) + ldsw + _i * 8192), 16, 0, 0); } while (0)
#define PG8_LDA(dst, b, h) do { _Pragma("unroll") for (int m = 0; m < 4; ++m) _Pragma("unroll") for (int k = 0; k < 2; ++k) dst[m][k] = *(const LAS bf16x8*)(lds + PG8_SA(b, h) + aoff + m * 2048 + k * 1024); } while (0)
#define PG8_LDB(dst, b, h) do { _Pragma("unroll") for (int n = 0; n < 2; ++n) _Pragma("unroll") for (int k = 0; k < 2; ++k) dst[n][k] = *(const LAS bf16x8*)(lds + PG8_SB(b, h) + boff + n * 2048 + k * 1024); } while (0)
#define PG8_MMA(ai, bj, At, Bt) do { __builtin_amdgcn_s_setprio(1); _Pragma("unroll") for (int m = 0; m < 4; ++m) _Pragma("unroll") for (int n = 0; n < 2; ++n) _Pragma("unroll") for (int k = 0; k < 2; ++k) \
        acc[ai][bj][m][n] = __builtin_amdgcn_mfma_f32_16x16x32_bf16(Bt[n][k], At[m][k], acc[ai][bj][m][n], 0, 0, 0); __builtin_amdgcn_s_setprio(0); } while (0)
#define PG8_WAIT_V(n) asm volatile("s_waitcnt vmcnt(" #n ")" ::: "memory")
#define PG8_WAIT_L(n) asm volatile("s_waitcnt lgkmcnt(" #n ")" ::: "memory")
#define PG8_BAR __builtin_amdgcn_s_barrier()
#define PG8_SCHED __builtin_amdgcn_sched_barrier(0)
#define PG8_MMAZ(Z, ai, bj, At, Bt) do { __builtin_amdgcn_s_setprio(1); _Pragma("unroll") for (int m = 0; m < 4; ++m) _Pragma("unroll") for (int n = 0; n < 2; ++n) _Pragma("unroll") for (int k = 0; k < 2; ++k) \
        acc[ai][bj][m][n] = __builtin_amdgcn_mfma_f32_16x16x32_bf16(Bt[n][k], At[m][k], ((Z) && k == 0) ? (f32x4){0.f, 0.f, 0.f, 0.f} : acc[ai][bj][m][n], 0, 0, 0); __builtin_amdgcn_s_setprio(0); } while (0)
#define PG8_TRIP(FIRST, LAST) do { PG8_SCHED; asm volatile("" : "+v"(voffA), "+v"(voffB));     \
        const char* a1 = cur.a + (unsigned)(t + 1) * kstep; \
        const char* a2 = (LAST) ? nA : cur.a + (unsigned)(t + 2) * kstep; const char* b2 = (LAST) ? nB : cur.b + (unsigned)(t + 2) * kstep; \
        const char* a3 = a2 + kstep; const char* b3 = b2 + kstep; \
        PG8_LDB(B0, 0, 0); PG8_SCHED; PG8_LDA(At, 0, 0); PG8_STAGE(PG8_SA(1, 1), a1 + hstepA, offA); \
        PG8_WAIT_L(8); PG8_BAR; PG8_WAIT_L(0); PG8_MMAZ(FIRST, 0, 0, At, B0); PG8_BAR; PG8_SCHED; \
        PG8_LDB(B1, 0, 1); PG8_STAGE(PG8_SB(0, 0), b2, offB); \
        PG8_BAR; PG8_WAIT_L(0); PG8_MMAZ(FIRST, 0, 1, At, B1); PG8_BAR; \
        PG8_LDA(At, 0, 1); PG8_STAGE(PG8_SA(0, 0), a2, offA); \
        PG8_BAR; PG8_WAIT_L(0); PG8_MMAZ(FIRST, 1, 0, At, B0); PG8_BAR; PG8_SCHED; \
        PG8_STAGE(PG8_SB(0, 1), b2 + hstepB, offB); \
        PG8_WAIT_V(6); PG8_BAR; PG8_MMAZ(FIRST, 1, 1, At, B1); PG8_BAR; \
        PG8_LDB(B0, 1, 0); PG8_SCHED; PG8_LDA(At, 1, 0); PG8_STAGE(PG8_SA(0, 1), a2 + hstepA, offA); \
        PG8_WAIT_L(8); PG8_BAR; PG8_WAIT_L(0); PG8_MMA(0, 0, At, B0); PG8_BAR; PG8_SCHED; \
        PG8_LDB(B1, 1, 1); PG8_STAGE(PG8_SB(1, 0), b3, offB); \
        PG8_BAR; PG8_WAIT_L(0); PG8_MMA(0, 1, At, B1); if constexpr ((LAST) && Epi::QUAD) { const int l_ = hw_lane(); E.template quad<0, 0>(acc, cur, wr, wc, l_ & 15, l_ >> 4); }; PG8_BAR; \
        PG8_LDA(At, 1, 1); PG8_STAGE(PG8_SA(1, 0), a3, offA); \
        PG8_BAR; PG8_WAIT_L(0); PG8_MMA(1, 0, At, B0); if constexpr ((LAST) && Epi::QUAD) { const int l_ = hw_lane(); E.template quad<0, 1>(acc, cur, wr, wc, l_ & 15, l_ >> 4); }; PG8_BAR; PG8_SCHED; \
        PG8_STAGE(PG8_SB(1, 1), b3 + hstepB, offB); \
        if constexpr ((LAST) && Epi::QUAD) PG8_WAIT_V(14); else PG8_WAIT_V(6); \
        PG8_BAR; PG8_MMA(1, 1, At, B1); if constexpr ((LAST) && Epi::QUAD) { const int l_ = hw_lane(); E.template quad<1, 0>(acc, cur, wr, wc, l_ & 15, l_ >> 4); }; PG8_BAR; PG8_SCHED; \
    } while (0)
    Unit cur, nxt; int ui = 0;
    if (!S.next(0, cur)) return;
    f32x4 acc[2][2][4][2];
    bf16x8 At[4][2], B0[2][2], B1[2][2];
    PG8_STAGE(PG8_SB(0, 0), cur.b, offB); PG8_STAGE(PG8_SA(0, 0), cur.a, offA); PG8_STAGE(PG8_SB(0, 1), cur.b + hstepB, offB); PG8_STAGE(PG8_SA(0, 1), cur.a + hstepA, offA);
    if (wr == 1) PG8_BAR;
    PG8_WAIT_V(4); PG8_BAR;
    PG8_STAGE(PG8_SB(1, 0), cur.b + kstep, offB); PG8_STAGE(PG8_SA(1, 0), cur.a + kstep, offA); PG8_STAGE(PG8_SB(1, 1), cur.b + hstepB + kstep, offB);
    PG8_WAIT_V(6); PG8_BAR;
    for (;;) {
        const bool has_next = S.next(ui + 1, nxt);
        const char* nA = has_next ? nxt.a : cur.a; const char* nB = has_next ? nxt.b : cur.b;
        { const int t = 0; PG8_TRIP(true, false); }
        for (int t = 2; t < nt - 2; t += 2) PG8_TRIP(false, false);
        { const int t = nt - 2; PG8_TRIP(false, true); }
        { const int l_ = hw_lane(); if constexpr (Epi::QUAD) E.template quad<1, 1>(acc, cur, wr, wc, l_ & 15, l_ >> 4); else E(acc, cur, wr, wc, l_ & 15, l_ >> 4); }
        if (!has_next) break;
        cur = nxt; ++ui;
    }
    PG8_WAIT_V(0);
    if (wr == 0) PG8_BAR;
    PG8_BAR;
#undef PG8_SA
#undef PG8_SB
#undef PG8_STAGE
#undef PG8_LDA
#undef PG8_LDB
#undef PG8_MMA
#undef PG8_MMAZ
#undef PG8_TRIP
#undef PG8_WAIT_V
#undef PG8_WAIT_L
#undef PG8_BAR
#undef PG8_SCHED
}
}

struct Frame { LAS unsigned char* lds; int tid, lane, wave, G, bid; const Params* P; };
struct PView {
    const Params* p; unsigned char* ws; unsigned char* big; float* out;
    __device__ __forceinline__ const float* in(int k) const { return p->in[k]; }
};
__device__ __forceinline__ PView pview(const Frame& F) { PView v; v.p = F.P; v.out = F.P->out; v.ws = F.P->ws; v.big = v.ws + WS_BIG; return v; }
__device__ __forceinline__ Frame uniform_frame(Frame F) {
    int wv = F.wave, g = F.G, b = F.bid; unsigned lb = (unsigned)(size_t)F.lds;
    asm volatile("" : "+s"(wv), "+s"(g), "+s"(b), "+s"(lb));
    int t = wv * 64 + hw_lane(); asm volatile("" : "+v"(t));
    F.tid = t; F.lane = t & 63; F.wave = wv; F.G = g; F.bid = b; F.lds = (LAS unsigned char*)(size_t)lb; return F; }
#define RFL(x) __builtin_amdgcn_readfirstlane(x)
__device__ __forceinline__ Frame unit_frame(Frame F) { int t = F.tid; asm volatile("" : "+v"(t)); F.tid = t; F.lane = t & 63; return F; }

__device__ __forceinline__ void mod_unit(const Frame& F, const PView& V, int l, int nt) {
    LAS float* sc = (LAS float*)F.lds; LAS float* red = sc + 5 * 1024;
    const float* c = V.in(1); const float* cc = V.in(3);
    __syncthreads();
    for (int i = F.tid; i < 5 * 1024; i += 512) { const float v = i < 4096 ? c[i] : cc[i - 4096]; sc[i] = siluf_(v); }
    __syncthreads();
    const int nl = F.tid & 63, kg = F.tid >> 6, n = nt * 64 + nl;
    const float* w = V.in(4) + (size_t)l * 1024 * 6144 + n;
    float a0 = 0.f, a1 = 0.f, a2 = 0.f, a3 = 0.f, a4 = 0.f;
    for (int k = kg * 128; k < kg * 128 + 128; ++k) { const float wv = w[(size_t)k * 6144];
        a0 += sc[k] * wv; a1 += sc[1024 + k] * wv; a2 += sc[2048 + k] * wv; a3 += sc[3072 + k] * wv; a4 += sc[4096 + k] * wv; }
    red[(kg * 5 + 0) * 64 + nl] = a0; red[(kg * 5 + 1) * 64 + nl] = a1; red[(kg * 5 + 2) * 64 + nl] = a2; red[(kg * 5 + 3) * 64 + nl] = a3; red[(kg * 5 + 4) * 64 + nl] = a4;
    __syncthreads();
    if (F.tid < 320) { const int bi = F.tid >> 6; float s = 0.f;
#pragma unroll
        for (int g = 0; g < 8; ++g) s += red[(g * 5 + bi) * 64 + nl];
        float* mod = (float*)(V.ws + WS_MOD);
        mod[((size_t)l * 5 + bi) * 6144 + n] = s + V.in(5)[(size_t)l * 6144 + n]; }
}
__device__ __forceinline__ void rope_table(const Frame& F, const PView& V) {
    float* rt = (float*)(V.ws + WS_ROPE);
    for (int i = F.tid; i < 128 * 16; i += 512) { const int pos = i >> 4, f = i & 15;
        const float inv = powf(10000.0f, -(float)f / 16.0f); const float ang = (float)pos * inv;
        rt[2 * i] = cosf(ang); rt[2 * i + 1] = sinf(ang); }
}
__device__ __forceinline__ int srcmap(int kind, int n) {
    switch (kind) {
        case 0: return n < 2048 ? n : (n < 2064 ? n : -1);
        case 1: return 2064 + n;
        case 2: { const int dt = n >> 8, c = n & 255, bj = c >> 7, wc = (c >> 5) & 3, nn = (c >> 4) & 1, fq = (c >> 2) & 3, j = c & 3;
                  return 4880 + (2 * bj + nn) * 1024 + dt * 64 + wc * 16 + fq * 4 + j; }
        case 3: return n;
        default: { const int pt = n >> 8, c = n & 255; return (c >> 7) * 2816 + pt * 128 + (c & 127); }
    }
}
struct TileDesc { const float* src; bf16_t* dst; int ldsrc, K, n0, k0, kind; };
__device__ __forceinline__ void convert_tiles4(const Frame& F, const TileDesc (&td)[4], int ntiles) {
    LAS float* tile = (LAS float*)F.lds;
    const int nn = F.tid & 63, kq = F.tid >> 6; float v[4][8];
#pragma unroll
    for (int q = 0; q < 4; ++q) { const int sc = q < ntiles ? srcmap(td[q].kind, td[q].n0 + nn) : -1;
#pragma unroll
        for (int i = 0; i < 8; ++i) { const int kk = kq * 8 + i; v[q][i] = sc >= 0 ? td[q].src[(size_t)(td[q].k0 + kk) * td[q].ldsrc + sc] : 0.f; } }
    __syncthreads();
#pragma unroll
    for (int q = 0; q < 4; ++q)
#pragma unroll
        for (int i = 0; i < 8; ++i) tile[q * 4160 + (kq * 8 + i) * 65 + nn] = v[q][i];
    __syncthreads();
    const int n2 = F.tid >> 3, k8 = (F.tid & 7) * 8;
#pragma unroll
    for (int q = 0; q < 4; ++q) if (q < ntiles) { float f[8];
#pragma unroll
        for (int i = 0; i < 8; ++i) f[i] = tile[q * 4160 + (k8 + i) * 65 + n2];
        *(u32x4*)(td[q].dst + (size_t)(td[q].n0 + n2) * td[q].K + td[q].k0 + k8) = pack8(f); }
}
__device__ __forceinline__ void weff_unit(const Frame& F, const PView& V, int l, int g, int et) {
    LAS float* pw = (LAS float*)F.lds; LAS float* sw = pw + 128 * 129;
    const float* poolw = V.in(10) + ((size_t)l * 4 + g) * 128 * 128; const float* scale = V.in(11) + (size_t)l * 512 + g * 128;
    const float* wb1 = V.in(14) + (((size_t)l * 4 + 1) * 512 + g * 128) * 1024 + et * 64;
    __syncthreads();
    for (int i = F.tid; i < 128 * 128; i += 512) pw[(i >> 7) * 129 + (i & 127)] = poolw[i];
    for (int i = F.tid; i < 128 * 64; i += 512) { const int d = i >> 6, e = i & 63; sw[d * 65 + e] = scale[d] * wb1[(size_t)d * 1024 + e]; }
    __syncthreads();
    const int el = F.tid & 63, cg = F.tid >> 6; float acc[16];
#pragma unroll
    for (int i = 0; i < 16; ++i) acc[i] = 0.f;
    for (int d = 0; d < 128; ++d) { const float s = sw[d * 65 + el];
#pragma unroll
        for (int i = 0; i < 16; ++i) acc[i] += pw[(cg * 16 + i) * 129 + d] * s; }
    bf16_t* dst = (bf16_t*)(V.ws + W_B) + ((size_t)1024 + et * 64 + el) * 512 + g * 128 + cg * 16;
    float f0[8], f1[8];
#pragma unroll
    for (int i = 0; i < 8; ++i) { f0[i] = acc[i]; f1[i] = acc[8 + i]; }
    *(u32x4*)dst = pack8(f0); *(u32x4*)(dst + 8) = pack8(f1);
}
__device__ __forceinline__ TileDesc tile_desc(const PView& V, int l, int t) {
    unsigned char* ws = V.ws; const float* w_in = V.in(7) + (size_t)l * 1024 * INW; TileDesc d;
    const int T0 = 36 * 16, T1 = T0 + 44 * 16, T2 = T1 + 64 * 16, T3 = T2 + 3 * 16 * 8, T4 = T3 + 16 * 16, T5 = T4 + 88 * 16;
    if (t < T0) { d.src = w_in; d.ldsrc = INW; d.K = 1024; d.dst = (bf16_t*)(ws + W_LSTM); d.n0 = (t / 16) * 64; d.k0 = (t % 16) * 64; d.kind = 0; }
    else if (t < T1) { const int q = t - T0; d.src = w_in; d.ldsrc = INW; d.K = 1024; d.dst = (bf16_t*)(ws + W_REST); d.n0 = (q / 16) * 64; d.k0 = (q % 16) * 64; d.kind = 1; }
    else if (t < T2) { const int q = t - T1; d.src = w_in; d.ldsrc = INW; d.K = 1024; d.dst = (bf16_t*)(ws + W_GATE); d.n0 = (q / 16) * 64; d.k0 = (q % 16) * 64; d.kind = 2; }
    else if (t < T3) { const int q = t - T2, bi = q / 128, r = q % 128; const int nb = bi == 0 ? 0 : bi + 1;
        d.src = V.in(14) + ((size_t)l * 4 + nb) * 512 * 1024; d.ldsrc = 1024; d.K = 512; d.dst = (bf16_t*)(ws + W_B) + (size_t)nb * 1024 * 512; d.n0 = (r / 8) * 64; d.k0 = (r % 8) * 64; d.kind = 3; }
    else if (t < T4) { const int q = t - T3; d.src = V.in(15) + (size_t)l * 1024 * 1024; d.ldsrc = 1024; d.K = 1024; d.dst = (bf16_t*)(ws + W_O); d.n0 = (q / 16) * 64; d.k0 = (q % 16) * 64; d.kind = 3; }
    else if (t < T5) { const int q = t - T4; d.src = V.in(16) + (size_t)l * 1024 * 5632; d.ldsrc = 5632; d.K = 1024; d.dst = (bf16_t*)(ws + W_UP); d.n0 = (q / 16) * 64; d.k0 = (q % 16) * 64; d.kind = 4; }
    else { const int q = t - T5; d.src = V.in(18) + (size_t)l * DFF * 1024; d.ldsrc = 1024; d.K = DFF; d.dst = (bf16_t*)(ws + W_DN); d.n0 = (q / 44) * 64; d.k0 = (q % 44) * 64; d.kind = 3; }
    return d;
}
__device__ __forceinline__ void prep_weights(const Frame& F, const PView& V, int l, int t0, int t1, int wid, int nw, bool with_weff) {
#pragma unroll 1
    for (int t = t0 + wid; t < t1; t += 4 * nw) { TileDesc td[4]; int nt = 0;
#pragma unroll
        for (int q = 0; q < 4; ++q) { const int tq = t + q * nw; td[q] = tile_desc(V, l, tq < t1 ? tq : t); nt += tq < t1 ? 1 : 0; }
        convert_tiles4(F, td, nt); }
    if (with_weff) for (int q = wid; q < 64; q += nw) weff_unit(F, V, l, q >> 4, q & 15);
}
constexpr int PREP_T0 = 36 * 16, PREP_T1 = PREP_T0 + 44 * 16, PREP_T2 = PREP_T1 + 64 * 16, PREP_T3 = PREP_T2 + 3 * 16 * 8, PREP_T4 = PREP_T3 + 16 * 16, PREP_T5 = PREP_T4 + 88 * 16, PREP_NT = PREP_T5 + 16 * 44;
__device__ __forceinline__ void tail_prep(const Frame& F, const PView& V, int l, int units, int t0, int t1, int u0, int u1, bool with_weff) {
    const int nbusy = units % F.G;
    int wid = F.bid, nw = F.G;
    if (nbusy > 0) { if (F.bid < nbusy) return; wid = F.bid - nbusy; nw = F.G - nbusy; }
    prep_weights(F, V, l, t0, t1, wid, nw, with_weff);
    if (u1 > u0) prep_weights(F, V, l, u0, u1, wid, nw, false);
}

__device__ __forceinline__ void rows_phase(const Frame& F, const PView& V, int Mrows, const void* xsl, bool src_f32, const float* xsc, void* xdl, bool dst_f32, float* xdc, const bf16_t* y, const float* gpost, const float* modcur, int kgate,
                           bool has_next, const float* gpre, const float* modnext, int kshift, int kscale, bf16_t* U, int wg, int nwg, int pass_lo, int pass_hi) {
    const int lane = F.lane; const int wv = wg * 8 + F.wave, nwv = nwg * 8;
#pragma unroll 1
    for (int pass = pass_lo; pass < pass_hi; ++pass) {
        const int per = nwv >> 2; const int bi = pass == 0 ? wv / per : 4;
        int r = pass == 0 ? bi * SEQ + (wv % per) : ML + wv; const int rstep = pass == 0 ? per : nwv; const int rend = pass == 0 ? (bi + 1) * SEQ : Mrows;
        if (pass == 0 && bi > 3) continue;
        if (r >= rend) continue;
        float cA[16], cB[16], cC[16];
#pragma unroll
        for (int i = 0; i < 2; ++i)
#pragma unroll
            for (int j = 0; j < 8; ++j) { const int c = 512 * i + 8 * lane + j; cA[8 * i + j] = 0.f; cB[8 * i + j] = 0.f; cC[8 * i + j] = 0.f;
                if (y) cA[8 * i + j] = modcur[(size_t)bi * 6144 + kgate * 1024 + c] * gpost[c];
                if (has_next) { cB[8 * i + j] = gpre[c] * (1.0f + modnext[(size_t)bi * 6144 + kscale * 1024 + c]); cC[8 * i + j] = modnext[(size_t)bi * 6144 + kshift * 1024 + c]; } }
        const bool lat = pass == 0, sf = !lat || src_f32, df = !lat || dst_f32;
#define ROWS_LOAD(rr, XR, YR) do { \
            if (sf) { const float* _xs = lat ? (const float*)xsl + (size_t)(rr) * 1024 : xsc + (size_t)((rr) - ML) * 1024; \
                XR[0] = *(const u32x4*)(_xs + 8 * lane); XR[1] = *(const u32x4*)(_xs + 8 * lane + 4); XR[2] = *(const u32x4*)(_xs + 512 + 8 * lane); XR[3] = *(const u32x4*)(_xs + 512 + 8 * lane + 4); } \
            else { const bf16_t* _xs = (const bf16_t*)xsl + (size_t)(rr) * 1024; XR[0] = ldg16(_xs + 8 * lane); XR[1] = ldg16(_xs + 512 + 8 * lane); XR[2] = XR[0]; XR[3] = XR[0]; } \
            if (y) { YR[0] = ldg16(y + (size_t)(rr) * 1024 + 8 * lane); YR[1] = ldg16(y + (size_t)(rr) * 1024 + 512 + 8 * lane); } else { YR[0] = XR[0]; YR[1] = XR[0]; } } while (0)
        u32x4 xc[4], yc[2]; ROWS_LOAD(r, xc, yc);
#pragma unroll 1
        for (; r < rend; r += rstep) {
            u32x4 xn[4], yn[2]; { const int rn = r + rstep < rend ? r + rstep : r; ROWS_LOAD(rn, xn, yn); }
            float xv[16];
            if (sf) {
#pragma unroll
                for (int i = 0; i < 4; ++i) { xv[4 * i] = __uint_as_float(xc[i].x); xv[4 * i + 1] = __uint_as_float(xc[i].y); xv[4 * i + 2] = __uint_as_float(xc[i].z); xv[4 * i + 3] = __uint_as_float(xc[i].w); } }
            else {
#pragma unroll
                for (int i = 0; i < 2; ++i) { float f[8]; unpack8(xc[i], f);
#pragma unroll
                    for (int j = 0; j < 8; ++j) xv[8 * i + j] = f[j]; } }
            if (y) {
                float yv[16]; float ss = 0.f;
#pragma unroll
                for (int i = 0; i < 2; ++i) { float f[8]; unpack8(yc[i], f);
#pragma unroll
                    for (int j = 0; j < 8; ++j) { yv[8 * i + j] = f[j]; ss += f[j] * f[j]; } }
                ss = wave_sum(ss, lane); const float rs = rsqrtf(ss * (1.0f / 1024.0f) + EPS);
#pragma unroll
                for (int i = 0; i < 16; ++i) xv[i] += cA[i] * (yv[i] * rs);
            }
            if (df) { float* xd = lat ? (float*)xdl + (size_t)r * 1024 : xdc + (size_t)(r - ML) * 1024;
#pragma unroll
                for (int i = 0; i < 2; ++i) { const int c0 = 512 * i + 8 * lane;
                    *(f32x4*)(xd + c0) = (f32x4){xv[8 * i], xv[8 * i + 1], xv[8 * i + 2], xv[8 * i + 3]}; *(f32x4*)(xd + c0 + 4) = (f32x4){xv[8 * i + 4], xv[8 * i + 5], xv[8 * i + 6], xv[8 * i + 7]}; } }
            else { bf16_t* xd = (bf16_t*)xdl + (size_t)r * 1024;
#pragma unroll
                for (int i = 0; i < 2; ++i) { float f[8];
#pragma unroll
                    for (int j = 0; j < 8; ++j) f[j] = xv[8 * i + j];
                    *(u32x4*)(xd + 512 * i + 8 * lane) = pack8(f); } }
            if (has_next) {
                float ss = 0.f;
#pragma unroll
                for (int i = 0; i < 16; ++i) ss += xv[i] * xv[i];
                ss = wave_sum(ss, lane); const float rs = rsqrtf(ss * (1.0f / 1024.0f) + EPS);
#pragma unroll
                for (int i = 0; i < 2; ++i) { float f[8];
#pragma unroll
                    for (int j = 0; j < 8; ++j) f[j] = (xv[8 * i + j] * rs) * cB[8 * i + j] + cC[8 * i + j];
                    *(u32x4*)(U + (size_t)r * 1024 + 512 * i + 8 * lane) = pack8(f); }
            }
#pragma unroll
            for (int i = 0; i < 4; ++i) xc[i] = xn[i];
            yc[0] = yn[0]; yc[1] = yn[1];
        }
#undef ROWS_LOAD
    }
}

__device__ __forceinline__ int blk_rowbase(int b, int blk) { return blk == 0 ? ML + b * 256 : b * SEQ + (blk - 1) * 256; }
__device__ __forceinline__ float scan256(LAS float* ws, float v, int tid, bool suffix) {
    const int lane = tid & 63, w = tid >> 6; float x = v;
    if (!suffix) {
#pragma unroll
        for (int o = 1; o < 64; o <<= 1) { const float yv = lshfl(x, (lane - o) & 63); if (lane >= o) x += yv; }
    } else {
#pragma unroll
        for (int o = 1; o < 64; o <<= 1) { const float yv = lshfl(x, (lane + o) & 63); if (lane + o < 64) x += yv; }
    }
    __syncthreads();
    if (w < 4 && lane == (suffix ? 0 : 63)) ws[w] = x;
    __syncthreads();
    if (w < 4) {
        if (!suffix) { for (int j = 0; j < w; ++j) x += ws[j]; }
        else { for (int j = w + 1; j < 4; ++j) x += ws[j]; }
    }
    return x;
}
__device__ __forceinline__ void conv_silu8(const u32x4 pv, const u32x4 cv, const u32x4 nv, const LAS float* w0, const LAS float* w1, const LAS float* w2, float scale, float (&o)[8]) {
    float p[8], c[8], n[8]; unpack8(pv, p); unpack8(cv, c); unpack8(nv, n);
#pragma unroll
    for (int i = 0; i < 8; ++i) { const float yv = p[i] * w0[i] + c[i] * w1[i] + n[i] * w2[i]; o[i] = siluf_(yv) * scale; }
}

__device__ __forceinline__ void lstm_pass1_unit(const Frame& F, const PView& V, int l, int ub) {
    const int tid = F.tid, lane = F.lane, w = F.wave, r = lane & 15, quad = lane >> 4;
    const int blk = ub % NBLK, h = (ub / NBLK) & 3, b = ub / (4 * NBLK);
    const int uf = ((b * 4 + h) * 2 + 0) * NBLK + blk, ubk = uf + NBLK;
    const int rowbase = blk_rowbase(b, blk); const bool seq_first = blk <= 1, seq_last = (blk == 0 || blk == 32);
    const bf16_t* PL = (const bf16_t*)(V.big + B_PLSTM);
    LAS float* wgt = (LAS float*)F.lds;
    LAS float* sws = wgt + 512;
    LAS float* cw = wgt + 528;
    LAS bf16_t* Kt = (LAS bf16_t*)(F.lds + 4096);
    LAS bf16_t* Vt = (LAS bf16_t*)(F.lds + 4096 + 128 * 264 * 2);
    __syncthreads();
    if (tid < 384) cw[tid] = V.in(8)[(size_t)l * 3072 + (tid >> 7) * 1024 + 512 + h * 128 + (tid & 127)];
    float gif = 0.f, gib = 0.f, lff = 0.f, lfb = 0.f;
    if (tid < 256) { const bf16_t* gp = PL + (size_t)(rowbase + tid) * NLSTM + 2048; const float* gb = V.in(9) + (size_t)l * 16;
        gif = bf2f(gp[h]) + gb[h]; gib = bf2f(gp[4 + h]) + gb[4 + h]; lff = logsigmoidf_(bf2f(gp[8 + h]) + gb[8 + h]); lfb = logsigmoidf_(bf2f(gp[12 + h]) + gb[12 + h]); }
    const float cif = scan256(sws, lff, tid, false);
    const float cib = scan256(sws + 4, lfb, tid, false);
    __syncthreads();
    if (tid == 255) { sws[8] = cif; sws[9] = cib; }
    __syncthreads();
    const float totf = sws[8], totb = sws[9];
    if (tid < 256) { wgt[tid] = __expf(totf - cif + gif); wgt[256 + tid] = __expf(cib - lfb + gib);
        float* gt = (float*)(V.big + B_GT); gt[(size_t)uf * 512 + tid] = cif; gt[(size_t)uf * 512 + 256 + tid] = gif;
        gt[(size_t)ubk * 512 + tid] = totb - cib + lfb; gt[(size_t)ubk * 512 + 256 + tid] = gib; }
    if (tid == 0) { float* dec = (float*)(V.ws + WS_DEC); dec[uf] = __expf(totf); dec[ubk] = __expf(totb); }
    __syncthreads();
#pragma unroll 1
    for (int hb = 0; hb < 2; ++hb) {
        u32x4 cv[2][2], pv[2][2], nv[2][2], vv[2][2];
#pragma unroll
        for (int it = 0; it < 2; ++it) { const int pt = (hb * 2 + it) * 512 + tid, chunk = pt >> 7, tp = pt & 127;
#pragma unroll
            for (int e = 0; e < 2; ++e) { const int tau = 2 * tp + e; const int row = rowbase + tau;
                const bf16_t* kp = PL + (size_t)row * NLSTM + 512 + h * 128 + chunk * 8;
                cv[it][e] = ldg16(kp); pv[it][e] = (u32x4){0u, 0u, 0u, 0u}; nv[it][e] = pv[it][e];
                if (!(seq_first && tau == 0)) pv[it][e] = ldg16(kp - NLSTM);
                if (!(seq_last && tau == 255)) nv[it][e] = ldg16(kp + NLSTM);
                vv[it][e] = ldg16(PL + (size_t)row * NLSTM + 1024 + h * 128 + chunk * 8); } }
#pragma unroll
        for (int it = 0; it < 2; ++it) { const int pt = (hb * 2 + it) * 512 + tid, CH = pt >> 7, tp = pt & 127, kc2 = 2 * tp;
            float o0[8], o1[8];
            conv_silu8(pv[it][0], cv[it][0], nv[it][0], cw + CH * 8, cw + 128 + CH * 8, cw + 256 + CH * 8, 0.08838834764831845f, o0);
            conv_silu8(pv[it][1], cv[it][1], nv[it][1], cw + CH * 8, cw + 128 + CH * 8, cw + 256 + CH * 8, 0.08838834764831845f, o1);
#pragma unroll
            for (int i = 0; i < 8; ++i) *(LAS unsigned*)(Kt + (CH * 8 + i) * 264 + kc2) = pk2(o0[i], o1[i]);
            const u32x4 va = vv[it][0], vb = vv[it][1];
            *(LAS unsigned*)(Vt + ((CH) * 8 + 0) * 264 + kc2) = (va.x & 0xffffu) | (vb.x << 16); *(LAS unsigned*)(Vt + ((CH) * 8 + 1) * 264 + kc2) = (va.x >> 16) | (vb.x & 0xffff0000u); *(LAS unsigned*)(Vt + ((CH) * 8 + 2) * 264 + kc2) = (va.y & 0xffffu) | (vb.y << 16); *(LAS unsigned*)(Vt + ((CH) * 8 + 3) * 264 + kc2) = (va.y >> 16) | (vb.y & 0xffff0000u); *(LAS unsigned*)(Vt + ((CH) * 8 + 4) * 264 + kc2) = (va.z & 0xffffu) | (vb.z << 16); *(LAS unsigned*)(Vt + ((CH) * 8 + 5) * 264 + kc2) = (va.z >> 16) | (vb.z & 0xffff0000u); *(LAS unsigned*)(Vt + ((CH) * 8 + 6) * 264 + kc2) = (va.w & 0xffffu) | (vb.w << 16); *(LAS unsigned*)(Vt + ((CH) * 8 + 7) * 264 + kc2) = (va.w >> 16) | (vb.w & 0xffff0000u); }
    }
    __syncthreads();
    bf16x8 af[8];
#pragma unroll
    for (int ks = 0; ks < 8; ++ks) af[ks] = *(const LAS bf16x8*)(Kt + (16 * w + r) * 264 + 32 * ks + 8 * quad);
    const bf16x8 ones = {(short)0x3f80, (short)0x3f80, (short)0x3f80, (short)0x3f80, (short)0x3f80, (short)0x3f80, (short)0x3f80, (short)0x3f80};
    const bf16x8 zeros = {0, 0, 0, 0, 0, 0, 0, 0};
#pragma unroll 1
    for (int dir = 0; dir < 2; ++dir) {
        asm volatile("" ::: "memory");
        bf16x8 ad[8];
#pragma unroll
        for (int ks = 0; ks < 8; ++ks) { const f32x4 w0 = *(const LAS f32x4*)(wgt + dir * 256 + 32 * ks + 8 * quad), w1 = *(const LAS f32x4*)(wgt + dir * 256 + 32 * ks + 8 * quad + 4);
            float f[8]; unpack8(__builtin_bit_cast(u32x4, af[ks]), f);
            f[0] *= w0[0]; f[1] *= w0[1]; f[2] *= w0[2]; f[3] *= w0[3]; f[4] *= w1[0]; f[5] *= w1[1]; f[6] *= w1[2]; f[7] *= w1[3];
            ad[ks] = __builtin_bit_cast(bf16x8, pack8(f)); }
        bf16_t* st = (bf16_t*)(V.big + B_ST) + (size_t)(dir == 0 ? uf : ubk) * ST_ELEMS;
#pragma unroll
        for (int db = 0; db < 9; ++db) { f32x4 acc = {0.f, 0.f, 0.f, 0.f};
#pragma unroll
            for (int ks = 0; ks < 8; ++ks) { bf16x8 bfr;
                if (db < 8) bfr = *(const LAS bf16x8*)(Vt + (16 * db + r) * 264 + 32 * ks + 8 * quad); else bfr = (r == 0) ? ones : zeros;
                acc = MFMA16(ad[ks], bfr, acc); }
            u32x2 pw; pw.x = pk2(acc[0], acc[1]); pw.y = pk2(acc[2], acc[3]);
            if (db < 8) *(u32x2*)(st + (size_t)(16 * db + r) * 128 + 16 * w + 4 * quad) = pw;
            else if (r == 0) *(u32x2*)(st + (size_t)128 * 128 + 16 * w + 4 * quad) = pw; }
    }
}
__device__ __forceinline__ void lstm_scan(const Frame& F, const PView& V) {
    bf16_t* ST = (bf16_t*)(V.big + B_ST); const float* DEC = (const float*)(V.ws + WS_DEC);
    const int per = ST_ELEMS / 8;
    for (int gid = F.bid * 512 + F.tid; gid < 32 * per; gid += F.G * 512) {
        const int chain = gid / per, e8 = gid % per, dir = chain & 1; const int ub = chain * NBLK;
        float sv[8];
#pragma unroll
        for (int q = 0; q < 8; ++q) sv[q] = 0.f;
#pragma unroll 1
        for (int g = 0; g < 3; ++g) { u32x4 tmp[11]; float dc[11];
#pragma unroll
            for (int j = 0; j < 11; ++j) { const int i = g * 11 + j; const int blk = (dir == 0 || i == 0) ? i : 33 - i;
                tmp[j] = *(const u32x4*)(ST + (size_t)(ub + blk) * ST_ELEMS + e8 * 8); dc[j] = DEC[ub + blk]; }
#pragma unroll
            for (int j = 0; j < 11; ++j) { const int i = g * 11 + j; const int blk = (dir == 0 || i == 0) ? i : 33 - i;
                *(u32x4*)(ST + (size_t)(ub + blk) * ST_ELEMS + e8 * 8) = pack8(sv); float f[8]; unpack8(tmp[j], f);
#pragma unroll
                for (int q = 0; q < 8; ++q) sv[q] = sv[q] * dc[j] + f[q]; } }
    }
}
__device__ __forceinline__ void lstm_pass2_unit(const Frame& F, const PView& V, int l, int b, int h, int blk, int qh) {
    const int tid = F.tid, lane = F.lane, w = F.wave, r = lane & 15, quad = lane >> 4;
    const int rowbase = blk_rowbase(b, blk); const bool seq_first = blk <= 1, seq_last = (blk == 0 || blk == 32);
    const bf16_t* PL = (const bf16_t*)(V.big + B_PLSTM);
    LAS float* cf = (LAS float*)F.lds; LAS float* cb = cf + 256; LAS float* igf = cf + 512; LAS float* igb = cf + 768;
    LAS float* sws = cf + 1024;
    LAS float* cwq = cf + 1056;
    LAS float* cwk = cwq + 384;
    LAS bf16_t* CTf = (LAS bf16_t*)(F.lds + 7424);
    LAS bf16_t* CTb = (LAS bf16_t*)(F.lds + 42512);
    LAS bf16_t* Kh = (LAS bf16_t*)(F.lds + 77600);
    LAS bf16_t* Vt = (LAS bf16_t*)(F.lds + 112416);
    const int qi = 8 * qh + w, t = 16 * qi + r; const int qrow = rowbase + t;
    __syncthreads();
    float cwq_v = 0.f, cwk_v = 0.f;
    if (tid < 384) { cwq_v = V.in(8)[(size_t)l * 3072 + (tid >> 7) * 1024 + h * 128 + (tid & 127)]; cwk_v = V.in(8)[(size_t)l * 3072 + (tid >> 7) * 1024 + 512 + h * 128 + (tid & 127)]; }
    float cfv = 0.f, cbv = 0.f, gif = 0.f, gib = 0.f;
    if (tid < 256) { const float* gtf = (const float*)(V.big + B_GT) + (size_t)(((b * 4 + h) * 2 + 0) * NBLK + blk) * 512; const float* gtb = gtf + (size_t)NBLK * 512;
        cfv = gtf[tid]; gif = gtf[256 + tid]; cbv = gtb[tid]; gib = gtb[256 + tid]; }
    u32x4 qc[4], qp_[4], qn[4];
#pragma unroll
    for (int ks = 0; ks < 4; ++ks) { const bf16_t* qp = PL + (size_t)qrow * NLSTM + h * 128 + 32 * ks + 8 * quad;
        qc[ks] = ldg16(qp); qp_[ks] = (u32x4){0u, 0u, 0u, 0u}; qn[ks] = qp_[ks];
        if (!(seq_first && t == 0)) qp_[ks] = ldg16(qp - NLSTM);
        if (!(seq_last && t == 255)) qn[ks] = ldg16(qp + NLSTM); }
    u32x2 og[8];
    const bf16_t* sf = (const bf16_t*)(V.big + B_ST) + (size_t)(((b * 4 + h) * 2 + 0) * NBLK + blk) * ST_ELEMS; const bf16_t* sb = sf + (size_t)NBLK * ST_ELEMS;
    const bool carried = blk != 0;
    if (tid < 384) { cwq[tid] = cwq_v; cwk[tid] = cwk_v; }
    if (tid < 256) { cf[tid] = cfv; cb[tid] = cbv; igf[tid] = gif; igb[tid] = gib; }
    __builtin_amdgcn_sched_barrier(0);
    if (carried) { u32x4 fa[5], fc[5];
#pragma unroll
        for (int it = 0; it < 5; ++it) { const int i = tid + 512 * it; fa[it] = (u32x4){0u, 0u, 0u, 0u}; fc[it] = fa[it];
            if (i < ST_ELEMS / 8) { fa[it] = *(const u32x4*)(sf + (size_t)i * 8); fc[it] = *(const u32x4*)(sb + (size_t)i * 8); } }
#pragma unroll
        for (int it = 0; it < 5; ++it) { const int i = tid + 512 * it; if (i < ST_ELEMS / 8) { const int row = i >> 4, c8 = (i & 15) * 8;
            *(LAS u32x4*)(CTf + row * 136 + c8) = fa[it]; *(LAS u32x4*)(CTb + row * 136 + c8) = fc[it]; } } }
    __builtin_amdgcn_sched_barrier(0);
    u32x4 kc[4], kp_[4], kn[4], vv[4];
#define P2_KV_LOAD(kh_) do { _Pragma("unroll") for (int it = 0; it < 4; ++it) { const int task = it * 512 + tid, chunk = task & 15, key = task >> 4, tau = 128 * (kh_) + key; \
        const bf16_t* kp = PL + (size_t)(rowbase + tau) * NLSTM + 512 + h * 128 + chunk * 8; \
        kc[it] = ldg16(kp); kp_[it] = (u32x4){0u, 0u, 0u, 0u}; kn[it] = kp_[it]; \
        if (!(seq_first && tau == 0)) kp_[it] = ldg16(kp - NLSTM); \
        if (!(seq_last && tau == 255)) kn[it] = ldg16(kp + NLSTM); \
        } } while (0)
#define P2_V_LOAD(kh_) do { _Pragma("unroll") for (int it = 0; it < 2; ++it) { const int pt = it * 512 + tid; \
        const bf16_t* vp = PL + (size_t)(rowbase + 128 * (kh_) + 2 * (pt & 63)) * NLSTM + 1024 + h * 128 + (pt >> 6) * 8; vv[2 * it] = ldg16(vp); vv[2 * it + 1] = ldg16(vp + NLSTM); } } while (0)
#define P2_KV_STORE(KD, VD) do { _Pragma("unroll") for (int it = 0; it < 4; ++it) { const int task = it * 512 + tid, chunk = task & 15, key = task >> 4; \
        float o[8]; conv_silu8(kp_[it], kc[it], kn[it], cwk + chunk * 8, cwk + 128 + chunk * 8, cwk + 256 + chunk * 8, 0.08838834764831845f, o); \
        *(LAS u32x4*)((KD) + key * 136 + chunk * 8) = pack8(o); } \
        _Pragma("unroll") for (int it = 0; it < 2; ++it) { const int pt = it * 512 + tid; const int CH = pt >> 6, kc2 = 2 * (pt & 63); LAS bf16_t* vd_ = (VD); const u32x4 va = vv[2 * it], vb = vv[2 * it + 1]; \
        *(LAS unsigned*)(vd_ + ((CH) * 8 + 0) * 136 + kc2) = (va.x & 0xffffu) | (vb.x << 16); \
         *(LAS unsigned*)(vd_ + ((CH) * 8 + 1) * 136 + kc2) = (va.x >> 16) | (vb.x & 0xffff0000u); \
         *(LAS unsigned*)(vd_ + ((CH) * 8 + 2) * 136 + kc2) = (va.y & 0xffffu) | (vb.y << 16); \
         *(LAS unsigned*)(vd_ + ((CH) * 8 + 3) * 136 + kc2) = (va.y >> 16) | (vb.y & 0xffff0000u); \
         *(LAS unsigned*)(vd_ + ((CH) * 8 + 4) * 136 + kc2) = (va.z & 0xffffu) | (vb.z << 16); \
         *(LAS unsigned*)(vd_ + ((CH) * 8 + 5) * 136 + kc2) = (va.z >> 16) | (vb.z & 0xffff0000u); \
         *(LAS unsigned*)(vd_ + ((CH) * 8 + 6) * 136 + kc2) = (va.w & 0xffffu) | (vb.w << 16); \
         *(LAS unsigned*)(vd_ + ((CH) * 8 + 7) * 136 + kc2) = (va.w >> 16) | (vb.w & 0xffff0000u); } } while (0)
    __syncthreads();
    bf16x8 qf[4];
#pragma unroll
    for (int ks = 0; ks < 4; ++ks) { const int c0 = 32 * ks + 8 * quad; float o[8]; conv_silu8(qp_[ks], qc[ks], qn[ks], cwq + c0, cwq + 128 + c0, cwq + 256 + c0, 1.0f, o);
        qf[ks] = __builtin_bit_cast(bf16x8, pack8(o)); }
    __builtin_amdgcn_sched_barrier(0);
    P2_KV_LOAD(0);
    __builtin_amdgcn_sched_barrier(0);
    const bf16x8 ones = {(short)0x3f80, (short)0x3f80, (short)0x3f80, (short)0x3f80, (short)0x3f80, (short)0x3f80, (short)0x3f80, (short)0x3f80};
    const bf16x8 zeros = {0, 0, 0, 0, 0, 0, 0, 0};
    f32x4 accf[9], accb[9];
#pragma unroll
    for (int db = 0; db < 9; ++db) { accf[db] = (f32x4){0.f, 0.f, 0.f, 0.f}; accb[db] = accf[db]; }
    if (carried) { const float ef = __expf(cf[t]), eb = __expf(cb[t]);
#pragma unroll
        for (int db = 0; db < 9; ++db) { f32x4 a = {0.f, 0.f, 0.f, 0.f}, c = {0.f, 0.f, 0.f, 0.f};
#pragma unroll
            for (int ks = 0; ks < 4; ++ks) { bf16x8 xf, xb;
                if (db < 8) { xf = *(const LAS bf16x8*)(CTf + (16 * db + r) * 136 + 32 * ks + 8 * quad); xb = *(const LAS bf16x8*)(CTb + (16 * db + r) * 136 + 32 * ks + 8 * quad); }
                else { xf = zeros; xb = zeros; if (r == 0) { xf = *(const LAS bf16x8*)(CTf + 128 * 136 + 32 * ks + 8 * quad); xb = *(const LAS bf16x8*)(CTb + 128 * 136 + 32 * ks + 8 * quad); } }
                a = MFMA16(xf, qf[ks], a); c = MFMA16(xb, qf[ks], c); }
            accf[db] = a * ef; accb[db] = c * eb; } }
    const float cft = cf[t], cbt = cb[t];
    P2_V_LOAD(0);
    P2_KV_STORE(Kh, Vt);
    __syncthreads();
    P2_KV_LOAD(1); P2_V_LOAD(1);
    P2_KV_STORE(CTf, CTf + 128 * 136);
    __syncthreads();
#pragma unroll 1
    for (int kh = 0; kh < 2; ++kh) {
        const LAS bf16_t* Kc = kh == 0 ? Kh : CTf; const LAS bf16_t* Vc = kh == 0 ? Vt : CTf + 128 * 136;
#pragma unroll
        for (int dir = 0; dir < 2; ++dir) {
            int s0, s1;
            if (dir == 0) { if (kh > qh) continue; s0 = 0; s1 = (kh < qh) ? 4 : (w >> 1) + 1; }
            else { if (kh < qh) continue; s1 = 4; s0 = (kh > qh) ? 0 : (w >> 1); }
            const LAS float* cs = dir == 0 ? cf : cb; const LAS float* gs = dir == 0 ? igf : igb; const float ct = dir == 0 ? cft : cbt;
#pragma unroll 1
            for (int st = s0; st < s1; ++st) {
                f32x4 T0 = {0.f, 0.f, 0.f, 0.f}, T1 = {0.f, 0.f, 0.f, 0.f};
#pragma unroll
                for (int ks = 0; ks < 4; ++ks) { const bf16x8 k0 = *(const LAS bf16x8*)(Kc + (32 * st + r) * 136 + 32 * ks + 8 * quad), k1 = *(const LAS bf16x8*)(Kc + (32 * st + 16 + r) * 136 + 32 * ks + 8 * quad);
                    T0 = MFMA16(k0, qf[ks], T0); T1 = MFMA16(k1, qf[ks], T1); }
                const int sg0 = 128 * kh + 32 * st + 4 * quad;
                const f32x4 c0 = *(const LAS f32x4*)(cs + sg0), c1 = *(const LAS f32x4*)(cs + sg0 + 16), e0 = *(const LAS f32x4*)(gs + sg0), e1 = *(const LAS f32x4*)(gs + sg0 + 16);
                float p[8];
#pragma unroll
                for (int j = 0; j < 4; ++j) { const int sa = sg0 + j, sb = sg0 + 16 + j;
                    const bool va = dir == 0 ? (sa <= t) : (sa >= t), vb = dir == 0 ? (sb <= t) : (sb >= t);
                    const float da = __expf(ct - c0[j] + e0[j]), dbb = __expf(ct - c1[j] + e1[j]);
                    p[j] = va ? T0[j] * da : 0.f; p[4 + j] = vb ? T1[j] * dbb : 0.f; }
                const bf16x8 pf = __builtin_bit_cast(bf16x8, pack8(p));
#pragma unroll
                for (int db = 0; db < 9; ++db) { bf16x8 vf;
                    if (db < 8) { const s16x4 lo = *(const LAS s16x4*)(Vc + (16 * db + r) * 136 + 32 * st + 4 * quad), hi = *(const LAS s16x4*)(Vc + (16 * db + r) * 136 + 32 * st + 16 + 4 * quad);
                        vf = __builtin_shufflevector(lo, hi, 0, 1, 2, 3, 4, 5, 6, 7); }
                    else vf = (r == 0) ? ones : zeros;
                    if (dir == 0) accf[db] = MFMA16(vf, pf, accf[db]); else accb[db] = MFMA16(vf, pf, accb[db]); }
            }
        }
    }
#undef P2_KV_LOAD
#undef P2_V_LOAD
#undef P2_KV_STORE
#pragma unroll
    for (int db = 0; db < 8; ++db) og[db] = *(const u32x2*)(PL + (size_t)qrow * NLSTM + 1536 + h * 128 + 16 * db + 4 * quad);
    const float denf = lshfl(accf[8][0], r), denb = lshfl(accb[8][0], r);
    const float invf = 1.0f / fmaxf(fabsf(denf), 1.0f), invb = 1.0f / fmaxf(fabsf(denb), 1.0f);
    bf16_t* ya = (bf16_t*)(V.big + B_YSA);
#pragma unroll
    for (int db = 0; db < 8; ++db) { const int dv = 16 * db + 4 * quad; const u32x2 ov = og[db];
        const float o0 = lo16(ov.x), o1 = hi16(ov.x), o2 = lo16(ov.y), o3 = hi16(ov.y);
        const f32x4 hv = accf[db] * invf + accb[db] * invb;
        u32x2 wv; wv.x = pk2(sigmoidf_(o0) * hv[0], sigmoidf_(o1) * hv[1]); wv.y = pk2(sigmoidf_(o2) * hv[2], sigmoidf_(o3) * hv[3]);
        *(u32x2*)(ya + (size_t)qrow * 512 + h * 128 + dv) = wv; }
}

__device__ __forceinline__ void attn_unit(const Frame& F, const PView& V, int l, bool isctx, int b, int g, int qs) {
    const int tid = F.tid, lane = F.lane, w = F.wave, r = lane & 15, quad = lane >> 4;
    const bf16_t* PR = (const bf16_t*)(V.big + B_PREST); const LAS float* ropel = (const LAS float*)(F.lds + 36864);
    LAS bf16_t* Ks = (LAS bf16_t*)F.lds;
    LAS bf16_t* Vt = (LAS bf16_t*)(F.lds + 18432);
    const int head = g * 4 + (w >> 1), qhalf = w & 1;
    const int qrow0 = isctx ? ML + b * 256 + qs * 64 : b * SEQ + qs * 64;
    const float sink = V.in(12)[l * 8 + head];
    bf16x8 qf[2][2];
#pragma unroll
    for (int qk = 0; qk < 2; ++qk) { const int qi = qhalf * 32 + qk * 16 + r, tpos = qs * 64 + qi; const bf16_t* qp = PR + (size_t)(qrow0 + qi) * NREST + PR_AQ + head * 64;
#pragma unroll
        for (int ks = 0; ks < 2; ++ks) { const int d0 = 32 * ks + 8 * quad; float own[8], par[8], o[8]; unpack8(ldg16(qp + d0), own); unpack8(ldg16(qp + (d0 ^ 16)), par);
            if (!isctx) { const int pos = ks == 0 ? (tpos >> 6) : (tpos & 63); const LAS float* rp = ropel + (pos * 16 + 8 * (quad & 1)) * 2;
#pragma unroll
                for (int j = 0; j < 8; ++j) { const float c = rp[2 * j], sn = rp[2 * j + 1]; o[j] = (quad < 2) ? own[j] * c - par[j] * sn : par[j] * sn + own[j] * c; } }
            else {
#pragma unroll
                for (int j = 0; j < 8; ++j) o[j] = own[j]; }
#pragma unroll
            for (int j = 0; j < 8; ++j) o[j] *= 0.18033688011112042f;
            qf[qk][ks] = __builtin_bit_cast(bf16x8, pack8(o)); } }
    float mrun[2], lsum[2]; f32x4 acc[2][4];
    const float sinkl = sink * 1.4426950408889634f;
#pragma unroll
    for (int qk = 0; qk < 2; ++qk) { mrun[qk] = sinkl; lsum[qk] = 0.f;
#pragma unroll
        for (int db = 0; db < 4; ++db) acc[qk][db] = (f32x4){0.f, 0.f, 0.f, 0.f}; }
    const int ntile = isctx ? 2 : 5; const int ltm = 4 * quad - r - 32 * qhalf; const int qb = qs >> 1;
    const unsigned vmask = isctx ? 3u : (3u | (qb >= 1 ? 4u : 0u) | 8u | (qb <= 62 ? 16u : 0u));
    const int skey = tid >> 2, sa = (tid >> 1) & 1, sfh = tid & 1;
    u32x4 pk1, pk2v, pv0, pv1;
#define ATT_LOAD(tl) do { const int _kr = (tl) < 2 ? ML + b * 256 + (tl) * 128 : b * SEQ + (qb + (tl) - 3) * 128; \
        const bf16_t* _kp = PR + (size_t)(_kr + skey) * NREST + PR_AK + g * 64 + sa * 32 + sfh * 8; pk1 = ldg16(_kp); pk2v = ldg16(_kp + 16); \
        const bf16_t* _vp = PR + (size_t)(_kr + 2 * (tid & 63)) * NREST + PR_AV + g * 64 + (tid >> 6) * 8; pv0 = ldg16(_vp); pv1 = ldg16(_vp + NREST); } while (0)
    ATT_LOAD(0);
#pragma unroll 1
    for (int tile = 0; tile < ntile; ++tile) {
        if (!((vmask >> tile) & 1u)) continue;
        int kb = 0, base = 0; bool band = false;
        if (tile >= 2) { kb = qb + tile - 3; band = true; base = 128 * kb - 64 * qs; }
        __syncthreads();
        { float x1[8], x2[8], o1[8], o2[8]; unpack8(pk1, x1); unpack8(pk2v, x2);
            if (band) { const int kpos = kb * 128 + skey, pos = sa == 0 ? (kpos >> 6) : (kpos & 63); const LAS float* rp = ropel + (pos * 16 + sfh * 8) * 2;
#pragma unroll
                for (int j = 0; j < 8; ++j) { const float c = rp[2 * j], sn = rp[2 * j + 1]; o1[j] = x1[j] * c - x2[j] * sn; o2[j] = x1[j] * sn + x2[j] * c; } }
            else {
#pragma unroll
                for (int j = 0; j < 8; ++j) { o1[j] = x1[j]; o2[j] = x2[j]; } }
            *(LAS u32x4*)(Ks + skey * 72 + sa * 32 + sfh * 8) = pack8(o1); *(LAS u32x4*)(Ks + skey * 72 + sa * 32 + 16 + sfh * 8) = pack8(o2); }
        { const int CH = tid >> 6, kc2 = 2 * (tid & 63); *(LAS unsigned*)(Vt + ((CH) * 8 + 0) * 136 + kc2) = (pv0.x & 0xffffu) | (pv1.x << 16); *(LAS unsigned*)(Vt + ((CH) * 8 + 1) * 136 + kc2) = (pv0.x >> 16) | (pv1.x & 0xffff0000u); *(LAS unsigned*)(Vt + ((CH) * 8 + 2) * 136 + kc2) = (pv0.y & 0xffffu) | (pv1.y << 16); *(LAS unsigned*)(Vt + ((CH) * 8 + 3) * 136 + kc2) = (pv0.y >> 16) | (pv1.y & 0xffff0000u); *(LAS unsigned*)(Vt + ((CH) * 8 + 4) * 136 + kc2) = (pv0.z & 0xffffu) | (pv1.z << 16); *(LAS unsigned*)(Vt + ((CH) * 8 + 5) * 136 + kc2) = (pv0.z >> 16) | (pv1.z & 0xffff0000u); *(LAS unsigned*)(Vt + ((CH) * 8 + 6) * 136 + kc2) = (pv0.w & 0xffffu) | (pv1.w << 16); *(LAS unsigned*)(Vt + ((CH) * 8 + 7) * 136 + kc2) = (pv0.w >> 16) | (pv1.w & 0xffff0000u); }
        __syncthreads();
        { int nx = tile + 1; while (nx < ntile && !((vmask >> nx) & 1u)) ++nx; if (nx < ntile) ATT_LOAD(nx); }
        const bool domask = band && base != 0 && base != -64;
        f32x4 T[2][8];
#pragma unroll
        for (int kt = 0; kt < 8; ++kt) { f32x4 a0 = {0.f, 0.f, 0.f, 0.f}, a1 = {0.f, 0.f, 0.f, 0.f};
#pragma unroll
            for (int ks = 0; ks < 2; ++ks) { const bf16x8 kf = *(const LAS bf16x8*)(Ks + (16 * kt + r) * 72 + 32 * ks + 8 * quad); a0 = MFMA16(kf, qf[0][ks], a0); a1 = MFMA16(kf, qf[1][ks], a1); }
            T[0][kt] = a0; T[1][kt] = a1; }
        bf16x8 pf[2][4];
#pragma unroll
        for (int qk = 0; qk < 2; ++qk) {
            if (domask) {
#pragma unroll
                for (int kt = 0; kt < 8; ++kt)
#pragma unroll
                    for (int j = 0; j < 4; ++j) { const int dlt = base + (16 * kt + j - 16 * qk) + ltm; if (dlt > 128 || dlt < -128) T[qk][kt][j] = -8e30f; }
            }
            float tmax = -1e30f;
#pragma unroll
            for (int kt = 0; kt < 8; ++kt)
#pragma unroll
                for (int j = 0; j < 4; ++j) tmax = fmaxf(tmax, T[qk][kt][j]);
            tmax = fmaxf(tmax, lshfl(tmax, lane ^ 16)); tmax = fmaxf(tmax, lshfl(tmax, lane ^ 32));
            const float mnew = fmaxf(mrun[qk], tmax), alpha = __builtin_amdgcn_exp2f(mrun[qk] - mnew); mrun[qk] = mnew;
            float psum = 0.f;
#pragma unroll
            for (int kt = 0; kt < 8; ++kt)
#pragma unroll
                for (int j = 0; j < 4; ++j) { const float pv = __builtin_amdgcn_exp2f(T[qk][kt][j] - mnew); T[qk][kt][j] = pv; psum += pv; }
            lsum[qk] = lsum[qk] * alpha + psum;
#pragma unroll
            for (int db = 0; db < 4; ++db) acc[qk][db] = acc[qk][db] * alpha;
#pragma unroll
            for (int st = 0; st < 4; ++st) { float p[8];
#pragma unroll
                for (int j = 0; j < 4; ++j) { p[j] = T[qk][2 * st][j]; p[4 + j] = T[qk][2 * st + 1][j]; }
                pf[qk][st] = __builtin_bit_cast(bf16x8, pack8(p)); }
        }
#pragma unroll
        for (int st = 0; st < 4; ++st)
#pragma unroll
            for (int db = 0; db < 4; ++db) { const s16x4 lo = *(const LAS s16x4*)(Vt + (16 * db + r) * 136 + 32 * st + 4 * quad), hi = *(const LAS s16x4*)(Vt + (16 * db + r) * 136 + 32 * st + 16 + 4 * quad);
                const bf16x8 vf = __builtin_shufflevector(lo, hi, 0, 1, 2, 3, 4, 5, 6, 7);
                acc[0][db] = MFMA16(vf, pf[0][st], acc[0][db]); acc[1][db] = MFMA16(vf, pf[1][st], acc[1][db]); }
    }
    bf16_t* yc = (bf16_t*)(V.big + B_YSB + 1 * YS_STRIDE);
#pragma unroll
    for (int qk = 0; qk < 2; ++qk) { const int qi = qhalf * 32 + qk * 16 + r; float lt = lsum[qk]; lt += lshfl(lt, lane ^ 16); lt += lshfl(lt, lane ^ 32); lt += __builtin_amdgcn_exp2f(sinkl - mrun[qk]);
        const float inv = 1.0f / lt;
#pragma unroll
        for (int db = 0; db < 4; ++db) { const f32x4 o = acc[qk][db] * inv; u32x2 wv; wv.x = pk2(o[0], o[1]); wv.y = pk2(o[2], o[3]);
            *(u32x2*)(yc + (size_t)(qrow0 + qi) * 512 + head * 64 + 16 * db + 4 * quad) = wv; } }
#undef ATT_LOAD
}
__device__ __forceinline__ void seq_of_row(int row0, int& seqbase, int& T) { seqbase = row0 < ML ? (row0 & ~(SEQ - 1)) : ML + ((row0 - ML) & ~(CTX - 1)); T = row0 < ML ? SEQ : CTX; }
__device__ __forceinline__ void pool_tasks(const Frame& F, const PView& V, int Mrows) {
    const bf16_t* PR = (const bf16_t*)(V.big + B_PREST); bf16_t* yb = (bf16_t*)(V.big + B_YSB + 0 * YS_STRIDE);
    const int ntask = (Mrows / 8) * 64;
#pragma unroll 1
    for (int t = F.bid * 512 + F.tid; t < ntask; t += F.G * 512) {
        const int cg = t & 15, rbl = (t >> 4) & 3, g = (t >> 6) & 3, rb = ((t >> 8) << 2) + rbl, half = 1 << g;
        const int row0 = rb * 8; int seqbase, T; seq_of_row(row0, seqbase, T); const int t0 = row0 - seqbase;
        const bf16_t* base = PR + (size_t)row0 * NREST + PR_POOL + (g * 16 + cg) * 8;
        u32x4 rw[24];
#pragma unroll
        for (int i = 0; i < 24; ++i) { const int tt = t0 - half + i; rw[i] = (u32x4){0u, 0u, 0u, 0u};
            if (i < 8 + 2 * half && tt >= 0 && tt < T) rw[i] = ldg16(base + (ptrdiff_t)(i - half) * NREST); }
        float sum[8];
#pragma unroll
        for (int j = 0; j < 8; ++j) sum[j] = 0.f;
#pragma unroll
        for (int i = 0; i < 16; ++i) if (i < 2 * half) { float f[8]; unpack8(rw[i], f);
#pragma unroll
            for (int j = 0; j < 8; ++j) sum[j] += f[j]; }
#pragma unroll
        for (int i = 0; i < 8; ++i) {
            const int tc = t0 + i, lo = tc - half < 0 ? 0 : tc - half, hi = tc + half > T ? T : tc + half; const float inv = 1.0f / (float)(hi - lo);
            float c[8], o[8];
            if (g == 0) unpack8(rw[i + 1], c); else if (g == 1) unpack8(rw[i + 2], c); else if (g == 2) unpack8(rw[i + 4], c); else unpack8(rw[i + 8], c);
#pragma unroll
            for (int j = 0; j < 8; ++j) o[j] = sum[j] * inv - c[j];
            *(u32x4*)(yb + (size_t)(row0 + i) * 512 + (g * 16 + cg) * 8) = pack8(o);
            if (i < 7) { float fa[8], fs[8]; unpack8(rw[i], fs);
                if (g == 0) unpack8(rw[i + 2], fa); else if (g == 1) unpack8(rw[i + 4], fa); else if (g == 2) unpack8(rw[i + 8], fa); else unpack8(rw[i + 16], fa);
#pragma unroll
                for (int j = 0; j < 8; ++j) sum[j] += fa[j] - fs[j]; }
        }
    }
}
__device__ __forceinline__ void sconv_tasks(const Frame& F, const PView& V, int l, int Mrows) {
    const bf16_t* PR = (const bf16_t*)(V.big + B_PREST); bf16_t* yd = (bf16_t*)(V.big + B_YSB + 2 * YS_STRIDE);
    const int ntask = (Mrows / 8) * 64;
#pragma unroll 1
    for (int t = F.bid * 512 + F.tid; t < ntask; t += F.G * 512) {
        const int chunk = t & 63, rb = t >> 6; const int row0 = rb * 8; int seqbase, T; seq_of_row(row0, seqbase, T); const int t0 = row0 - seqbase;
        const float* cw = V.in(13) + (size_t)l * 1536 + chunk * 8;
        const bf16_t* base = PR + (size_t)row0 * NREST + chunk * 8;
        u32x4 cr[10], xr[10], br[8];
#pragma unroll
        for (int i = 0; i < 10; ++i) { const int tt = t0 - 1 + i; cr[i] = (u32x4){0u, 0u, 0u, 0u}; xr[i] = cr[i];
            if (tt >= 0 && tt < T) { cr[i] = ldg16(base + (ptrdiff_t)(i - 1) * NREST + PR_SC); xr[i] = ldg16(base + (ptrdiff_t)(i - 1) * NREST + PR_SX); } }
#pragma unroll
        for (int i = 0; i < 8; ++i) br[i] = ldg16(base + (size_t)i * NREST + PR_SB);
        float w0[8], w1[8], w2[8];
#pragma unroll
        for (int j = 0; j < 8; ++j) { w0[j] = cw[j]; w1[j] = cw[512 + j]; w2[j] = cw[1024 + j]; }
        float pa[8], pb[8], pc[8], c[8], x[8];
        unpack8(cr[0], c); unpack8(xr[0], x);
#pragma unroll
        for (int j = 0; j < 8; ++j) pa[j] = c[j] * x[j];
        unpack8(cr[1], c); unpack8(xr[1], x);
#pragma unroll
        for (int j = 0; j < 8; ++j) pb[j] = c[j] * x[j];
#pragma unroll
        for (int i = 0; i < 8; ++i) { unpack8(cr[i + 2], c); unpack8(xr[i + 2], x); float bv[8], o[8]; unpack8(br[i], bv);
#pragma unroll
            for (int j = 0; j < 8; ++j) { pc[j] = c[j] * x[j]; o[j] = bv[j] * (w0[j] * pa[j] + w1[j] * pb[j] + w2[j] * pc[j]); pa[j] = pb[j]; pb[j] = pc[j]; }
            *(u32x4*)(yd + (size_t)(row0 + i) * 512 + chunk * 8) = pack8(o); }
    }
}
constexpr int PH_PER_LAYER = 15, N_PHASES = 2 + DEPTH * PH_PER_LAYER - 1;
constexpr int F3C_WGS = ((MT - ML) / 256) * 4;
__device__ __forceinline__ void ph_prologue(Frame F0) { const Frame F = uniform_frame(F0); const PView V = pview(F);
    for (int u = F.bid; u < DEPTH * 96; u += F.G) mod_unit(F, V, u / 96, u % 96);
    if (F.bid == F.G - 1) rope_table(F, V);
    prep_weights(F, V, 0, 0, PREP_NT, F.bid, F.G, true);
}
__device__ __forceinline__ void ph_rows(Frame F0, int kind, int l) { const Frame F = uniform_frame(F0); const PView V = pview(F); kind = RFL(kind); l = RFL(l);
    const float* modall = (const float*)(V.ws + WS_MOD); const float* modl = modall + (size_t)l * 5 * 6144; const float* ng = V.in(6) + (size_t)l * 4 * 1024;
    bf16_t* U = (bf16_t*)V.out; bf16_t* X = (bf16_t*)(V.ws + WS_X); float* H = (float*)(V.ws + WS_H); const bool ctx_out = l < DEPTH - 1;
    if (kind == 0) rows_phase(F, V, MT, V.in(0), true, V.in(2), X, false, H, nullptr, nullptr, nullptr, 0, true, ng, modl, 0, 1, U, F.bid, F.G, 0, 2);
    else if (kind == 1) { const int skip = ctx_out ? F3C_WGS : 0;
        if (F.bid >= skip) rows_phase(F, V, ML, X, false, H, X, false, H, (const bf16_t*)(V.big + B_MX), ng + 1024, modl, 2, true, ng + 2048, modl, 3, 4, U, F.bid - skip, F.G - skip, 0, 1); }
    else if (kind == 4) rows_phase(F, V, MT, X, false, H, X, false, H, (const bf16_t*)(V.big + B_MX), ng + 1024, modl, 2, true, ng + 2048, modl, 3, 4, U, F.bid, F.G, 1, 2);
    else if (kind == 2) { const int skip = ctx_out ? F3C_WGS : 0;
        if (F.bid >= skip) rows_phase(F, V, ML, X, false, H, ctx_out ? (void*)X : (void*)V.out, !ctx_out, H, (const bf16_t*)(V.big + B_FX), ng + 3072, modl, 5, ctx_out, ng + 4096, modl + 5 * 6144, 0, 1, U, F.bid - skip, F.G - skip, 0, 1); }
    else rows_phase(F, V, MT, X, false, H, X, false, H, (const bf16_t*)(V.big + B_FX), ng + 3072, modl, 5, true, ng + 4096, modl + 5 * 6144, 0, 1, U, F.bid, F.G, 1, 2);
}
__device__ __forceinline__ void ph_gemm_store(Frame F0, int which, int l) { const Frame F = uniform_frame(F0); const PView V = pview(F); which = RFL(which); l = RFL(l);
    unsigned char* ws = V.ws; unsigned char* big = V.big; const char* U = (const char*)V.out; const int nMr = (l < DEPTH - 1 ? MT : ML) / 256;
    pg8::Sched S; pg8::EpiStore E; int K = 1024;
    S.A0 = U; S.A1 = U; S.A2 = U; S.A3 = U; S.lda = 1024; S.ldb = 1024; S.G = F.G; S.c = F.bid;
    if (which == 0) { S.B = (const char*)(ws + W_LSTM); S.nM = MT / 256; S.nN = NLSTM / 256; S.grp = S.nN; E.O = (bf16_t*)(big + B_PLSTM); E.ldc = NLSTM; }
    else if (which == 1) { S.B = (const char*)(ws + W_REST); S.nM = MT / 256; S.nN = NREST / 256; S.grp = S.nN; E.O = (bf16_t*)(big + B_PREST); E.ldc = NREST; }
    else if (which == 2) { const char* ys = (const char*)(big + B_YSB); S.A0 = (const char*)(big + B_YSA); S.A1 = ys; S.A2 = ys + YS_STRIDE; S.A3 = ys + 2 * YS_STRIDE; S.B = (const char*)(ws + W_B); S.lda = 512; S.ldb = 512;
        S.nM = nMr; S.nN = 16; S.grp = 4; E.O = (bf16_t*)(big + B_PROJ); E.ldc = PROJ_LD; K = 512; }
    else if (which == 3 || which == 8) { const size_t p0 = which == 8 ? (size_t)ML : 0;
        const char* a = (const char*)(big + B_MERGED) + p0 * 1024 * 2; S.A0 = a; S.A1 = a; S.A2 = a; S.A3 = a; S.B = (const char*)(ws + W_O); S.nM = which == 8 ? (MT - ML) / 256 : ML / 256; S.nN = 4; S.grp = 4; E.O = (bf16_t*)(big + B_MX) + p0 * 1024; E.ldc = 1024; }
    else { const size_t p0 = which == 7 ? (size_t)ML : 0;
        const char* a = (const char*)(big + B_ACT) + p0 * DFF * 2; S.A0 = a; S.A1 = a; S.A2 = a; S.A3 = a; S.B = (const char*)(ws + W_DN); S.lda = DFF; S.ldb = DFF; S.nM = which == 7 ? (MT - ML) / 256 : ML / 256; S.nN = 4; S.grp = 4;
        E.O = (bf16_t*)(big + B_FX) + p0 * 1024; E.ldc = 1024; K = DFF; }
    pg8::gemm_phase(F.lds, F.tid, K, S, E);
    if (l > 0 && which == 2) tail_prep(uniform_frame(F0), V, l, S.nM * S.nN, PREP_T4, PREP_T5, 0, 0, false);
}
__device__ __forceinline__ void ph_gemm_ffn(Frame F0, int l) { const Frame F = uniform_frame(F0); const PView V = pview(F); l = RFL(l);
    const char* U = (const char*)V.out; const int nMr = (l < DEPTH - 1 ? MT : ML) / 256;
    pg8::Sched S{U, U, U, U, (const char*)(V.ws + W_UP), 1024, 1024, nMr, 22, 22, F.G, F.bid};
    pg8::EpiFfn E{(bf16_t*)(V.big + B_ACT), (float*)(V.big + B_HB), V.in(17) + (size_t)l * 3 * 5632, (LAS float*)(F.lds + 132096)};
    pg8::gemm_phase(F.lds, F.tid, 1024, S, E);
    if (l > 0) tail_prep(uniform_frame(F0), V, l, S.nM * S.nN, PREP_T5, PREP_NT, 0, 0, false);
    if (l < DEPTH - 1) tail_prep(uniform_frame(F0), V, l + 1, S.nM * S.nN, PREP_T1, PREP_T2, PREP_T3, PREP_T4, false);
}
__device__ __forceinline__ void ph_ffn_fix(Frame F0, int l) { const Frame F = uniform_frame(F0); const PView V = pview(F); l = RFL(l);
    const int nMr = (l < DEPTH - 1 ? MT : ML) / 256; const float* HB = (const float*)(V.big + B_HB); bf16_t* act = (bf16_t*)(V.big + B_ACT); const float* cw = V.in(17) + (size_t)l * 3 * 5632;
    const int ntask = nMr * 2 * 352;
#pragma unroll 1
    for (int t = F.bid * 512 + F.tid; t < ntask; t += F.G * 512) { const int chunk = t % 352, q = t / 352, which = q & 1, pm = q >> 1, c0 = chunk * 8;
        const bool first = pm >= 128 || (pm & 31) == 0, last = pm >= 128 || (pm & 31) == 31;
        const float* hp = HB + (size_t)pm * 4 * 5632;
        const float* rp = which == 0 ? (first ? nullptr : hp - 5632) : hp + 2 * 5632;
        const float* rc = which == 0 ? hp : hp + 3 * 5632;
        const float* rn = which == 0 ? hp + 5632 : (last ? nullptr : hp + 4 * 5632);
        float o[8];
#pragma unroll
        for (int half = 0; half < 2; ++half) { float res[2][4];
#pragma unroll
            for (int bj = 0; bj < 2; ++bj) { const int col = bj * 2816 + c0 + 4 * half; const f32x4 z = {0.f, 0.f, 0.f, 0.f};
                const f32x4 p = rp ? *(const f32x4*)(rp + col) : z, c = *(const f32x4*)(rc + col), n = rn ? *(const f32x4*)(rn + col) : z;
                const f32x4 w0 = *(const f32x4*)(cw + col), w1 = *(const f32x4*)(cw + 5632 + col), w2 = *(const f32x4*)(cw + 2 * 5632 + col);
#pragma unroll
                for (int j = 0; j < 4; ++j) res[bj][j] = w0[j] * p[j] + w1[j] * c[j] + w2[j] * n[j]; }
#pragma unroll
            for (int j = 0; j < 4; ++j) o[4 * half + j] = siluf_(res[0][j]) * res[1][j]; }
        *(u32x4*)(act + (size_t)(pm * 256 + (which ? 255 : 0)) * DFF + c0) = pack8(o); }
}
__device__ __forceinline__ void ph_gemm_merge(Frame F0, int l) { const Frame F = uniform_frame(F0); const PView V = pview(F); l = RFL(l);
    const char* U = (const char*)V.out; const int nMr = (l < DEPTH - 1 ? MT : ML) / 256;
    pg8::Sched S{U, U, U, U, (const char*)(V.ws + W_GATE), 1024, 1024, nMr, 16, 16, F.G, F.bid};
    pg8::EpiMerge E{(const bf16_t*)(V.big + B_PROJ), (bf16_t*)(V.big + B_MERGED)}; pg8::gemm_phase(F.lds, F.tid, 1024, S, E);
    if (l < DEPTH - 1) tail_prep(uniform_frame(F0), V, l + 1, S.nM * S.nN, 0, PREP_T1, PREP_T2, PREP_T3, true);
}
__device__ __forceinline__ void ph_pass1(Frame F0, int l) { const Frame F = uniform_frame(F0); const PView V = pview(F); l = RFL(l);
    for (int u = F.G - 1 - F.bid; u < NCHAIN_UNITS / 2; u += F.G) lstm_pass1_unit(unit_frame(F), V, l, u); }
__device__ __forceinline__ void ph_scan(Frame F0) { const Frame F = uniform_frame(F0); const PView V = pview(F); lstm_scan(F, V); }
__device__ __forceinline__ void ph_pass2(Frame F0, int l) { const Frame F = uniform_frame(F0); const PView V = pview(F); l = RFL(l);
    const int nlat = NB * 4 * 32 * 2, nu = nlat + ((l < DEPTH - 1) ? NB * 4 * 2 : 0);
    for (int u = F.bid; u < nu; u += F.G) { const int qh = u & 1; int blk, bh;
        if (u < nlat) { const int r = u >> 1; blk = 1 + (r & 31); bh = r >> 5; } else { blk = 0; bh = (u - nlat) >> 1; }
        lstm_pass2_unit(unit_frame(F), V, l, bh >> 2, bh & 3, blk, qh); } }
__device__ __forceinline__ void ph_attn(Frame F0, int l) { const Frame F = uniform_frame(F0); const PView V = pview(F); l = RFL(l);
    { const f32x4* rt = (const f32x4*)(V.ws + WS_ROPE); LAS f32x4* rl = (LAS f32x4*)(F.lds + 36864); __syncthreads(); rl[F.tid] = rt[F.tid]; rl[512 + F.tid] = rt[512 + F.tid]; __syncthreads(); }
    const int nlat = NB * 2 * 128, nctx = (l < DEPTH - 1) ? NB * 2 * 4 : 0;
    for (int u = F.bid; u < nlat; u += F.G) attn_unit(unit_frame(F), V, l, false, u >> 8, (u >> 7) & 1, u & 127);
    for (int q = F.G - 1 - F.bid; q < nctx; q += F.G) attn_unit(unit_frame(F), V, l, true, q >> 3, (q >> 2) & 1, q & 3); }
__device__ __forceinline__ void ph_poolconv(Frame F0, int l) { const Frame F = uniform_frame(F0); const PView V = pview(F); l = RFL(l);
    const int Mrows = (l < DEPTH - 1) ? MT : ML; pool_tasks(F, V, Mrows); sconv_tasks(F, V, l, Mrows); }

__global__ void __launch_bounds__(512, 2) fwd(Params P) {
    extern __shared__ __attribute__((aligned(16))) unsigned char lds_raw[];
    Frame F; F.lds = (LAS unsigned char*)lds_raw; F.wave = __builtin_amdgcn_readfirstlane((int)threadIdx.x >> 6); F.tid = 0; F.lane = 0; F.G = gridDim.x; F.bid = blockIdx.x; F.P = &P;
    volatile LAS unsigned* ctlw = (volatile LAS unsigned*)(F.lds + LDS_WORK);
    { const int t0 = F.wave * 64 + hw_lane(); if (t0 < 16) ctlw[t0] = 0u; }
    __syncthreads();
    const size_t bar_off = WS_CTL + (size_t)P.bar_region * 16384;
    XcdBarrier bar; bar.bar = (unsigned*)(P.ws + bar_off); bar.x = 0; bar.st = ctlw;
    const int lo = P.ph_lo, hi = P.ph_hi;
    if (hi - lo > 1) bar = xcd_barrier_post((unsigned*)(P.ws + bar_off), ctlw, F.wave == 0 && hw_lane() == 0);
#define IN(k) (lo <= (k) && (k) < hi)
#pragma unroll 1
    for (int step = lo; step < hi; ++step) {
        const int l = step < 2 ? 0 : (step - 2) / PH_PER_LAYER, k = step < 2 ? step - 2 : (step - 2) % PH_PER_LAYER;
        if (l == DEPTH - 1 && k == 9) continue;
        switch (k) {
            case -2: if (KON(0)) ph_prologue(F); break;
            case -1: if (KON(1)) ph_rows(F, 0, 0); break;
            case 0: case 1: case 5: case 7: case 8: case 12: case 13:
                if (k == 1 && KON(3)) ph_pass1(F, l);
                if (KON(2) && !((k == 8 || k == 13) && l == DEPTH - 1)) ph_gemm_store(F, k == 0 ? 0 : (k == 1 ? 1 : (k == 5 ? 2 : (k == 7 ? 3 : (k == 8 ? 8 : (k == 12 ? 6 : 7))))), l);
                if ((k == 8 || k == 13) && KON(1)) ph_rows(F, k == 8 ? 1 : 2, l);
                break;
            case 10: if (KON(8)) ph_gemm_ffn(F, l); break;
            case 11: if (KON(8)) ph_ffn_fix(F, l); break;
            case 2: if (KON(4)) ph_scan(F); break;
            case 3: if (KON(5)) ph_pass2(F, l); break;
            case 4: if (KON(6)) ph_attn(F, l); if (KON(9)) ph_poolconv(F, l); break;
            case 6: if (KON(7)) ph_gemm_merge(F, l); break;
            default: if (KON(1)) ph_rows(F, k == 9 ? 4 : 3, l); break;
        }
        if (step + 1 < hi) { unsigned long long bp = (unsigned long long)(P.ws + bar_off); asm volatile("" : "+v"(bp)); bar.bar = (unsigned*)bp; xcd_barrier(bar, F.wave == 0 && hw_lane() == 0); }
    }
#undef IN
}

extern "C" void kernel_launch(void* const* d_in, const int* in_sizes, int n_in, void* d_out, int out_size, void* d_ws, size_t ws_size, hipStream_t stream) {
    static int grid = 0;
    if (grid == 0) {
        if (n_in != 19 || out_size != ML * D || ws_size < WS_END) { fprintf(stderr, "kernel_launch: need 19 inputs, out %d, ws >= %zu; got %d, %d, %zu\n", ML * D, (size_t)WS_END, n_in, out_size, ws_size); grid = -1; return; }
        int dev = 0, cus = 0, per_cu = 0;
        if (hipGetDevice(&dev) != hipSuccess || hipDeviceGetAttribute(&cus, hipDeviceAttributeMultiprocessorCount, dev) != hipSuccess) { grid = -1; return; }
        if (hipFuncSetAttribute((const void*)fwd, hipFuncAttributeMaxDynamicSharedMemorySize, LDS_BYTES) != hipSuccess) { fprintf(stderr, "kernel_launch: hipFuncSetAttribute failed\n"); grid = -1; return; }
        if (hipOccupancyMaxActiveBlocksPerMultiprocessor(&per_cu, (const void*)fwd, 512, LDS_BYTES) != hipSuccess || per_cu < 1) { fprintf(stderr, "kernel_launch: occupancy query says %d\n", per_cu); (void)hipGetLastError(); }
        grid = cus;
    }
    if (grid < 0) return;
    (void)hipMemsetAsync((char*)d_ws + WS_CTL, 0, 131072, stream);
    Params p{};
    for (int i = 0; i < 19; ++i) p.in[i] = (const float*)d_in[i];
    p.out = (float*)d_out; p.ws = (unsigned char*)d_ws;
#if MK_PER_PHASE
    for (int k = 0; k < N_PHASES; ++k) { p.ph_lo = k; p.ph_hi = k + 1; hipLaunchKernelGGL(fwd, dim3(grid), dim3(512), LDS_BYTES, stream, p); }
#elif defined(PROBE_K)
    { int lo = 0, reg = 0;
      for (int l = 0; l < DEPTH; ++l) { const int st = (PROBE_K < 0) ? PROBE_K + 2 : 2 + l * PH_PER_LAYER + PROBE_K; if (PROBE_K < 0 && l > 0) break;
          p.ph_lo = lo; p.ph_hi = st + 1; p.bar_region = reg++; hipLaunchKernelGGL(fwd, dim3(grid), dim3(512), LDS_BYTES, stream, p);
          for (int r = 0; r < PROBE_R; ++r) { p.ph_lo = st; p.ph_hi = st + 1; p.bar_region = 7; hipLaunchKernelGGL(fwd, dim3(grid), dim3(512), LDS_BYTES, stream, p); }
          lo = st + 1; }
      if (lo < N_PHASES) { p.ph_lo = lo; p.ph_hi = N_PHASES; p.bar_region = reg++; hipLaunchKernelGGL(fwd, dim3(grid), dim3(512), LDS_BYTES, stream, p); } }
#else
    p.ph_lo = 0; p.ph_hi = N_PHASES; p.bar_region = 0;
    hipLaunchKernelGGL(fwd, dim3(grid), dim3(512), LDS_BYTES, stream, p);
#endif
}
```

```cpp
#include <hip/hip_runtime.h>
#include <cstdio>
#include <cstdint>

#ifndef MK_PER_PHASE
#define MK_PER_PHASE 0
#endif

#ifndef MK_ONLY
#define MK_ONLY -1
#endif
#define KON(k) (MK_ONLY < 0 || MK_ONLY == (k))
#define LAS __attribute__((address_space(3)))
typedef unsigned short bf16_t;
typedef short bf16x8 __attribute__((ext_vector_type(8)));
typedef short s16x4 __attribute__((ext_vector_type(4)));
typedef float f32x4 __attribute__((ext_vector_type(4)));
typedef float f32x2 __attribute__((ext_vector_type(2)));
typedef unsigned u32x4 __attribute__((ext_vector_type(4)));
typedef unsigned u32x2 __attribute__((ext_vector_type(2)));
typedef __bf16 bf16v2 __attribute__((ext_vector_type(2)));

constexpr int D = 1024, NB = 4, SEQ = 8192, CTX = 256, DEPTH = 4;
constexpr int ML = NB * SEQ, MC = NB * CTX, MT = ML + MC;
constexpr int INW = 8976;
constexpr int NLSTM = 2304, NREST = 2816, NGATE = 4096, DFF = 2816, NUPH = 2816;
constexpr int PROJ_LD = 4160;
constexpr int NBLK = 33;
constexpr int NCHAIN_UNITS = NB * 4 * 2 * NBLK;
constexpr int ST_ELEMS = 129 * 128;
constexpr float EPS = 1e-6f;
constexpr int PR_POOL = 0, PR_AQ = 512, PR_AK = 1024, PR_AV = 1152, PR_SB = 1280, PR_SC = 1792, PR_SX = 2304;

constexpr size_t WS_CTL = 0;
constexpr size_t WS_MOD = 131072;
constexpr size_t WS_ROPE = WS_MOD + (size_t)DEPTH * 5 * 6144 * 4;
constexpr size_t WS_DEC = WS_ROPE + 128 * 16 * 2 * 4;
constexpr size_t WS_W = 1048576;
constexpr size_t W_LSTM = WS_W;
constexpr size_t W_REST = W_LSTM + (size_t)NLSTM * 1024 * 2;
constexpr size_t W_GATE = W_REST + (size_t)NREST * 1024 * 2;
constexpr size_t W_B = W_GATE + (size_t)NGATE * 1024 * 2;
constexpr size_t W_O = W_B + (size_t)4 * 1024 * 512 * 2;
constexpr size_t W_UP = W_O + (size_t)1024 * 1024 * 2;
constexpr size_t W_DN = W_UP + (size_t)2 * NUPH * 1024 * 2;
constexpr size_t WS_H = W_DN + (size_t)1024 * DFF * 2;
constexpr size_t WS_X = WS_H + (size_t)MC * 1024 * 4, WS_U = WS_X;
constexpr size_t WS_BIG = WS_U + (size_t)MT * 1024 * 2;
constexpr size_t YS_STRIDE = (size_t)MT * 512 * 2;
constexpr size_t B_PLSTM = 0;
constexpr size_t B_ST = (size_t)MT * NLSTM * 2;
constexpr size_t B_PREST = B_ST + (size_t)NCHAIN_UNITS * ST_ELEMS * 2;
constexpr size_t B_YSB = 0;
constexpr size_t B_PROJ = 3 * YS_STRIDE;
constexpr size_t B_YSA = B_PROJ + (size_t)MT * PROJ_LD * 2;
constexpr size_t B_MERGED = 0, B_MX = B_PROJ, B_ACT = (size_t)MT * NUPH * 2, B_FX = 0;
constexpr size_t B_HB = B_ACT + (size_t)MT * DFF * 2;
constexpr size_t B_GT = B_HB + 1048576;
constexpr size_t BIG_BYTES = B_YSA + YS_STRIDE;
constexpr size_t WS_END = WS_BIG + BIG_BYTES;
static_assert(B_PREST + (size_t)MT * NREST * 2 <= B_YSA && B_PREST % 256 == 0 && B_PROJ % 256 == 0 && B_YSA % 256 == 0, "layout");
static_assert(B_HB + (size_t)(MT / 256) * 4 * 5632 * 4 <= BIG_BYTES && B_GT >= B_PREST + (size_t)MT * NREST * 2 && B_GT + (size_t)NCHAIN_UNITS * 512 * 4 <= B_YSA, "act + halo rows overflow / gate table placement");
static_assert(W_LSTM % 256 == 0 && WS_U % 256 == 0 && WS_BIG % 256 == 0, "alignment");

constexpr int LDS_WORK = 155648;
constexpr int LDS_BYTES = LDS_WORK + 256;

struct Params { const float* in[19]; float* out; unsigned char* ws; int ph_lo, ph_hi, bar_region, pad; };

__device__ __forceinline__ float bf2f(bf16_t b) { return __uint_as_float(((unsigned)b) << 16); }
__device__ __forceinline__ unsigned pk2(float lo, float hi) { f32x2 v = {lo, hi}; bf16v2 r = __builtin_convertvector(v, bf16v2); return __builtin_bit_cast(unsigned, r); }
__device__ __forceinline__ bf16_t f2bf(float f) { return (bf16_t)(pk2(f, 0.f) & 0xffffu); }
__device__ __forceinline__ float lo16(unsigned w) { return __uint_as_float(w << 16); }
__device__ __forceinline__ float hi16(unsigned w) { return __uint_as_float(w & 0xffff0000u); }
__device__ __forceinline__ void unpack8(const u32x4 v, float (&f)[8]) { f[0] = lo16(v.x); f[1] = hi16(v.x); f[2] = lo16(v.y); f[3] = hi16(v.y); f[4] = lo16(v.z); f[5] = hi16(v.z); f[6] = lo16(v.w); f[7] = hi16(v.w); }
__device__ __forceinline__ u32x4 pack8(const float (&f)[8]) { u32x4 r; r.x = pk2(f[0], f[1]); r.y = pk2(f[2], f[3]); r.z = pk2(f[4], f[5]); r.w = pk2(f[6], f[7]); return r; }
__device__ __forceinline__ float sigmoidf_(float x) { return __builtin_amdgcn_rcpf(1.0f + __builtin_amdgcn_exp2f(x * -1.4426950408889634f)); }
__device__ __forceinline__ float siluf_(float x) { return x * __builtin_amdgcn_rcpf(1.0f + __builtin_amdgcn_exp2f(x * -1.4426950408889634f)); }
__device__ __forceinline__ float logsigmoidf_(float x) { return fminf(x, 0.f) - __logf(1.0f + __expf(-fabsf(x))); }
__device__ __forceinline__ float lshfl(float v, int src) { return __int_as_float(__builtin_amdgcn_ds_bpermute(src << 2, __float_as_int(v))); }
__device__ __forceinline__ float wave_sum(float v, int lane) {
#pragma unroll
    for (int o = 32; o >= 1; o >>= 1) v += lshfl(v, lane ^ o);
    return v; }
__device__ __forceinline__ u32x4 ldg16(const bf16_t* p) { return *(const u32x4*)p; }
#define MFMA16(a, b, c) __builtin_amdgcn_mfma_f32_16x16x32_bf16((a), (b), (c), 0, 0, 0)

__device__ __forceinline__ int hw_lane() { int l; asm volatile("v_mbcnt_lo_u32_b32 %0, -1, 0\n\tv_mbcnt_hi_u32_b32 %0, -1, %0" : "=v"(l)); return l; }
#define XB_TMO      128
#define XB_XCNT(j)  (256  + 64 * (j))
#define XB_XSUB(j)  (1280 + 64 * (j))
#define XB_XGEN(j)  (2304 + 64 * (j))
#define XB_TOP      3328
#define XB_TOPGEN   3392
#define XCD_BAR_WORDS 3456
#define XB_SPIN_CAP (1u << 22)
__device__ __forceinline__ unsigned xb_ld(unsigned* p)              { return __hip_atomic_load(p, __ATOMIC_RELAXED, __HIP_MEMORY_SCOPE_AGENT); }
__device__ __forceinline__ unsigned xb_add(unsigned* p, unsigned v) { return __hip_atomic_fetch_add(p, v, __ATOMIC_RELAXED, __HIP_MEMORY_SCOPE_AGENT); }
__device__ __forceinline__ unsigned xb_xcc_id() { return (unsigned)__builtin_amdgcn_s_getreg((3 << 11) | 20) & 0xFu; }
#define XB_SPIN(cond, bar) do { unsigned _sp = 0; while (cond) { __builtin_amdgcn_s_sleep(1); \
    if ((++_sp & 255u) == 0u) { if (xb_ld(&(bar)[XB_TMO])) break; if (_sp > XB_SPIN_CAP) { atomicAdd(&(bar)[XB_TMO], 1u); break; } } } } while (0)
struct XcdBarrier { unsigned* bar; unsigned x; volatile LAS unsigned* st; };
__device__ __forceinline__ XcdBarrier xcd_barrier_post(unsigned* bar, volatile LAS unsigned* st, bool leader) {
    XcdBarrier b; b.bar = bar; b.x = xb_xcc_id(); b.st = st;
    if (leader) (void)xb_add(&bar[XB_XCNT(b.x)], 1u);
    return b;
}
__device__ __forceinline__ void xcd_barrier_complete(unsigned* bar, unsigned x, unsigned& nloc, unsigned& nx) {
    const unsigned G = gridDim.x * gridDim.y * gridDim.z;
    unsigned sum, cnt, mine, sp = 0u;
    for (;;) {
        sum = 0u; cnt = 0u; mine = 0u;
#pragma unroll
        for (unsigned j = 0; j < 16; ++j) { const unsigned c = xb_ld(&bar[XB_XCNT(j)]); sum += c; cnt += (c > 0u) ? 1u : 0u; }
        mine = xb_ld(&bar[XB_XCNT(x)]);
        if (sum == G) break;
        __builtin_amdgcn_s_sleep(1);
        if ((++sp & 255u) == 0u) { if (xb_ld(&bar[XB_TMO])) break; if (sp > XB_SPIN_CAP) { atomicAdd(&bar[XB_TMO], 1u); break; } }
    }
    nloc = mine > 0u ? mine : 1u; nx = cnt > 0u ? cnt : 1u;
}
__device__ __forceinline__ void xcd_barrier(const XcdBarrier& b, bool leader) {
    asm volatile("s_waitcnt vmcnt(0)" ::: "memory");
    __syncthreads();
    if (leader) {
        unsigned* bar = b.bar;
        __builtin_amdgcn_s_waitcnt(0);
        unsigned nloc = b.st[0], nx = b.st[1];
        if (nloc == 0u) { xcd_barrier_complete(bar, b.x, nloc, nx); b.st[0] = nloc; b.st[1] = nx; }
        const unsigned old = xb_add(&bar[XB_XSUB(b.x)], 1u);
        const unsigned gen = old / nloc;
        if (old + 1u == (gen + 1u) * nloc) {
            __builtin_amdgcn_fence(__ATOMIC_RELEASE, "agent");
            asm volatile("s_waitcnt vmcnt(0)" ::: "memory");
            const unsigned og = xb_add(&bar[XB_TOP], 1u);
            const unsigned tg = og / nx;
            if (og + 1u == (tg + 1u) * nx) xb_add(&bar[XB_TOPGEN], 1u);
            else XB_SPIN(xb_ld(&bar[XB_TOPGEN]) == tg, bar);
            __builtin_amdgcn_fence(__ATOMIC_ACQUIRE, "agent");
            xb_add(&bar[XB_XGEN(b.x)], 1u);
            asm volatile("s_waitcnt vmcnt(0)" ::: "memory");
        } else {
            XB_SPIN(xb_ld(&bar[XB_XGEN(b.x)]) == gen, bar);
            __builtin_amdgcn_fence(__ATOMIC_ACQUIRE, "agent");
            asm volatile("s_waitcnt vmcnt(0)" ::: "memory");
        }
    }
    __syncthreads();
}

namespace pg8 {
constexpr int BM = 256, BK = 64, HALF = 128, HTB = HALF * BK * 2, STAGE_BYTES = 8 * HTB, NXCD = 8, WGM = 8;
__device__ __forceinline__ int lds_byte(int r, int c) { const int st = (r >> 4) * 2 + (c >> 5), rr = r & 15, cc = c & 31, ob = rr * 64 + cc * 2; return st * 1024 + (ob ^ (((ob >> 9) & 1) << 5)); }
__device__ __forceinline__ void stage_rc(int b, int& R, int& C) { const int st = b / 1024, sb = b % 1024, swz = sb ^ (((sb >> 9) & 1) << 5); R = (st >> 1) * 16 + swz / 64; C = (st & 1) * 32 + (swz % 64) / 2; }
__device__ __forceinline__ int perm32(int rho) { const int n = rho >> 4, i = rho & 15; return 8 * (i >> 2) + 4 * n + (i & 3); }
struct Unit { const char* a; const char* b; int orow, ocol; };
struct Sched {
    const char* A0; const char* A1; const char* A2; const char* A3; const char* B;
    int lda, ldb, nM, nN, grp, G, c;
    __device__ __forceinline__ bool next(int i, Unit& u) const {
        const int nwg = nM * nN; const int L = i * G + c; if (L >= nwg) return false;
        int wgid = L; { const int q = nwg / NXCD, r = nwg % NXCD, xcd = wgid % NXCD, off = wgid / NXCD; wgid = (xcd < r ? xcd * (q + 1) : r * (q + 1) + (xcd - r) * q) + off; }
        const int nig = WGM * nN, gid = wgid / nig, fm = gid * WGM, gsz = (nM - fm) < WGM ? (nM - fm) : WGM;
        const int pm = fm + ((wgid % nig) % gsz), pn = (wgid % nig) / gsz;
        const int ag = pn / grp; const char* ab = ag == 0 ? A0 : (ag == 1 ? A1 : (ag == 2 ? A2 : A3));
        u.a = ab + (size_t)pm * BM * lda * 2; u.b = B + (size_t)pn * BM * ldb * 2; u.orow = pm * BM; u.ocol = pn * BM; return true;
    }
};
struct EpiStore {
    static constexpr bool PERM = true, QUAD = true;
    template <int AI, int BJ> __device__ __forceinline__ void quad(const f32x4 (&acc)[2][2][4][2], const Unit& u, int wr, int wc, int fr, int fq) const {
        const int row0 = u.orow + wr * 64 + fr + AI * HALF, col0 = u.ocol + wc * 32 + 8 * fq + BJ * HALF;
#pragma unroll
        for (int m = 0; m < 4; ++m) { const f32x4 v0 = acc[AI][BJ][m][0], v1 = acc[AI][BJ][m][1];
            u32x4 w; w.x = pk2(v0[0], v0[1]); w.y = pk2(v0[2], v0[3]); w.z = pk2(v1[0], v1[1]); w.w = pk2(v1[2], v1[3]);
            *(u32x4*)(O + (size_t)(row0 + m * 16) * ldc + col0) = w; }
    }
    bf16_t* O; int ldc;
    __device__ __forceinline__ void operator()(const f32x4 (&acc)[2][2][4][2], const Unit& u, int wr, int wc, int fr, int fq) const {
        const int row0 = u.orow + wr * 64 + fr, col0 = u.ocol + wc * 32 + 8 * fq;
#pragma unroll
        for (int ai = 0; ai < 2; ++ai)
#pragma unroll
            for (int m = 0; m < 4; ++m) { bf16_t* rowp = O + (size_t)(row0 + ai * HALF + m * 16) * ldc + col0;
#pragma unroll
                for (int bj = 0; bj < 2; ++bj) { const f32x4 v0 = acc[ai][bj][m][0], v1 = acc[ai][bj][m][1];
                    u32x4 w; w.x = pk2(v0[0], v0[1]); w.y = pk2(v0[2], v0[3]); w.z = pk2(v1[0], v1[1]); w.w = pk2(v1[2], v1[3]);
                    *(u32x4*)(rowp + bj * HALF) = w; } }
    }
};
struct EpiMerge {
    static constexpr bool PERM = false, QUAD = false;
    const bf16_t* PROJ; bf16_t* O;
    __device__ __forceinline__ void operator()(f32x4 (&acc)[2][2][4][2], const Unit& u, int wr, int wc, int fr, int fq) const {
        const int row0 = u.orow + wr * 64 + fr, d0 = (u.ocol >> 8) * 64 + wc * 16 + 4 * fq;
        u32x2 pv[2][4][4];
#pragma unroll
        for (int ai = 0; ai < 2; ++ai)
#pragma unroll
            for (int m = 0; m < 4; ++m) { const bf16_t* pp = PROJ + (size_t)(row0 + ai * HALF + m * 16) * PROJ_LD + d0;
#pragma unroll
                for (int nb = 0; nb < 4; ++nb) pv[ai][m][nb] = *(const u32x2*)(pp + nb * 1024); }
        __builtin_amdgcn_sched_barrier(0);
#pragma unroll
        for (int ai = 0; ai < 2; ++ai)
#pragma unroll
            for (int bj = 0; bj < 2; ++bj)
#pragma unroll
                for (int m = 0; m < 4; ++m)
#pragma unroll
                    for (int n = 0; n < 2; ++n) { f32x4 a = acc[ai][bj][m][n]; a[0] = sigmoidf_(a[0]); a[1] = sigmoidf_(a[1]); a[2] = sigmoidf_(a[2]); a[3] = sigmoidf_(a[3]); acc[ai][bj][m][n] = a; }
        __builtin_amdgcn_sched_barrier(0);
#pragma unroll
        for (int ai = 0; ai < 2; ++ai)
#pragma unroll
            for (int m = 0; m < 4; ++m) { f32x4 s = {0.f, 0.f, 0.f, 0.f};
#pragma unroll
                for (int bj = 0; bj < 2; ++bj)
#pragma unroll
                    for (int n = 0; n < 2; ++n) { const u32x2 p2 = pv[ai][m][2 * bj + n]; const f32x4 a = acc[ai][bj][m][n];
                        s[0] += a[0] * lo16(p2.x); s[1] += a[1] * hi16(p2.x); s[2] += a[2] * lo16(p2.y); s[3] += a[3] * hi16(p2.y); }
                u32x2 w; w.x = pk2(s[0], s[1]); w.y = pk2(s[2], s[3]);
                *(u32x2*)(O + (size_t)(row0 + ai * HALF + m * 16) * 1024 + d0) = w; }
    }
};

__device__ __forceinline__ float dpp_prev_keep(float edge, float cur) { return __int_as_float(__builtin_amdgcn_update_dpp(__float_as_int(edge), __float_as_int(cur), 0x111, 0xf, 0xf, false)); }
__device__ __forceinline__ float dpp_next_keep(float edge, float cur) { return __int_as_float(__builtin_amdgcn_update_dpp(__float_as_int(edge), __float_as_int(cur), 0x101, 0xf, 0xf, false)); }
__device__ __forceinline__ float dpp_ror1(float v) { return __int_as_float(__builtin_amdgcn_update_dpp(0, __float_as_int(v), 0x121, 0xf, 0xf, true)); }
__device__ __forceinline__ float dpp_ror15(float v) { return __int_as_float(__builtin_amdgcn_update_dpp(0, __float_as_int(v), 0x12f, 0xf, 0xf, true)); }
struct EpiFfn {
    static constexpr bool PERM = true, QUAD = false;
    bf16_t* act; float* HB; const float* cw; LAS float* XB;
    __device__ __forceinline__ void operator()(f32x4 (&acc)[2][2][4][2], const Unit& u, int wr, int wc, int fr, int fq) const {
        asm volatile("" : "+v"(fr), "+v"(fq));
        const int pm = u.orow >> 8, pt = u.ocol >> 8, ch0 = pt * 128 + wc * 32 + 8 * fq, wv = wr * 4 + wc;
#pragma unroll
        for (int ai = 0; ai < 2; ++ai) {
            if (fr == 0) { LAS f32x4* d = (LAS f32x4*)(XB + (((wv * 4) + ai * 2 + 0) * 4 + fq) * 16); d[0] = acc[ai][0][0][0]; d[1] = acc[ai][0][0][1]; d[2] = acc[ai][1][0][0]; d[3] = acc[ai][1][0][1]; }
            if (fr == 15) { LAS f32x4* d = (LAS f32x4*)(XB + (((wv * 4) + ai * 2 + 1) * 4 + fq) * 16); d[0] = acc[ai][0][3][0]; d[1] = acc[ai][0][3][1]; d[2] = acc[ai][1][3][0]; d[3] = acc[ai][1][3][1]; } }
        if (wr == 0 && fr < 2) { float* h = HB + ((size_t)pm * 4 + fr) * 5632 + ch0;
            *(f32x4*)h = acc[0][0][0][0]; *(f32x4*)(h + 4) = acc[0][0][0][1]; *(f32x4*)(h + 2816) = acc[0][1][0][0]; *(f32x4*)(h + 2820) = acc[0][1][0][1]; }
        if (wr == 1 && fr >= 14) { float* h = HB + ((size_t)pm * 4 + (fr - 12)) * 5632 + ch0;
            *(f32x4*)h = acc[1][0][3][0]; *(f32x4*)(h + 4) = acc[1][0][3][1]; *(f32x4*)(h + 2816) = acc[1][1][3][0]; *(f32x4*)(h + 2820) = acc[1][1][3][1]; }
        asm volatile("s_waitcnt lgkmcnt(0)" ::: "memory"); __builtin_amdgcn_s_barrier(); asm volatile("" ::: "memory");
        __builtin_amdgcn_s_barrier(); asm volatile("" ::: "memory");
#pragma unroll
        for (int bj = 0; bj < 2; ++bj)
#pragma unroll
            for (int nn = 0; nn < 2; ++nn) {
                const f32x4 w0 = *(const f32x4*)(cw + bj * 2816 + ch0 + 4 * nn), w1 = *(const f32x4*)(cw + 5632 + bj * 2816 + ch0 + 4 * nn), w2 = *(const f32x4*)(cw + 2 * 5632 + bj * 2816 + ch0 + 4 * nn);
#pragma unroll
                for (int ai = 0; ai < 2; ++ai) {
                    f32x4 xp = {0.f, 0.f, 0.f, 0.f}, xn = xp;
                    if (wr == 1 || ai == 1) { const int swv = wr == 1 ? wc : 4 + wc, sslot = wr == 1 ? ai * 2 + 1 : 1; xp = *(const LAS f32x4*)(XB + (((swv * 4) + sslot) * 4 + fq) * 16 + bj * 8 + nn * 4); }
                    if (wr == 0 || ai == 0) { const int swv = wr == 0 ? 4 + wc : wc, sslot = wr == 0 ? ai * 2 : 2; xn = *(const LAS f32x4*)(XB + (((swv * 4) + sslot) * 4 + fq) * 16 + bj * 8 + nn * 4); }
                    f32x4 po = xp;
#pragma unroll
                    for (int m = 0; m < 4; ++m) { const f32x4 c = acc[ai][bj][m][nn]; f32x4 rr;
#pragma unroll
                        for (int j = 0; j < 4; ++j) {
                            const float pe = m > 0 ? dpp_ror1(po[j]) : xp[j];
                            const float ne = m < 3 ? dpp_ror15(acc[ai][bj][m < 3 ? m + 1 : 3][nn][j]) : xn[j];
                            const float pv = dpp_prev_keep(pe, c[j]), nv = dpp_next_keep(ne, c[j]);
                            rr[j] = w0[j] * pv + w1[j] * c[j] + w2[j] * nv; }
                        asm volatile("" : "+v"(rr[0]), "+v"(rr[1]), "+v"(rr[2]), "+v"(rr[3]));
                        po = c; acc[ai][bj][m][nn] = rr; }
                    __builtin_amdgcn_sched_barrier(0);
                }
            }
        const int row0 = u.orow + wr * 64 + fr;
#pragma unroll
        for (int ai = 0; ai < 2; ++ai)
#pragma unroll
            for (int m = 0; m < 4; ++m) { const f32x4 g0 = acc[ai][0][m][0], g1 = acc[ai][0][m][1], v0 = acc[ai][1][m][0], v1 = acc[ai][1][m][1];
                u32x4 o; o.x = pk2(siluf_(g0[0]) * v0[0], siluf_(g0[1]) * v0[1]); o.y = pk2(siluf_(g0[2]) * v0[2], siluf_(g0[3]) * v0[3]);
                o.z = pk2(siluf_(g1[0]) * v1[0], siluf_(g1[1]) * v1[1]); o.w = pk2(siluf_(g1[2]) * v1[2], siluf_(g1[3]) * v1[3]);
                *(u32x4*)(act + (size_t)(row0 + ai * HALF + m * 16) * DFF + ch0) = o; __builtin_amdgcn_sched_barrier(0); }
    }
};

template <class Epi>
__device__ __forceinline__ void gemm_phase(LAS unsigned char* lds, const int tid, const int K, const Sched& S, const Epi& E) {
    const int wid = __builtin_amdgcn_readfirstlane(tid >> 6), lane = tid & 63, wr = wid >> 2, wc = wid & 3, fr = lane & 15, fq = lane >> 4;
    const int nt = K / BK; const int lda = S.lda, ldb = S.ldb;
    unsigned voffA, voffB; { int R, C; stage_rc(tid * 16, R, C); const int Rb = Epi::PERM ? ((R & ~31) + perm32(R & 31)) : R;
        voffA = (unsigned)(R * lda + C) * 2u; voffB = (unsigned)(Rb * ldb + C) * 2u; }
    const unsigned skipoffA = (unsigned)(64 * lda * 2), skipoffB = (unsigned)(64 * ldb * 2);
    constexpr unsigned kstep = BK * 2;
    const unsigned hstepA = (unsigned)(HALF * lda * 2), hstepB = (unsigned)(HALF * ldb * 2);
    const unsigned ldsw = (unsigned)wid * 1024u;
    const int aoff = lds_byte(wr * 64 + fr, fq * 8), boff = lds_byte(wc * 32 + fr, fq * 8);
#define PG8_SA(b, h) (((b) * 2 + (h)) * HTB)
#define PG8_SB(b, h) ((4 + (b) * 2 + (h)) * HTB)
#define PG8_STAGE(bufoff, gbase, voff) do { _Pragma("unroll") for (int _i = 0; _i < 2; ++_i) \
        __builtin_amdgcn_global_load_lds((const unsigned*)((const char*)(gbase) + (_i ? skip##voff : 0u) + (v##voff)), (LAS unsigned*)(lds + (bufoff) + ldsw + _i * 8192), 16, 0, 0); } while (0)
#define PG8_LDA(dst, b, h) do { _Pragma("unroll") for (int m = 0; m < 4; ++m) _Pragma("unroll") for (int k = 0; k < 2; ++k) dst[m][k] = *(const LAS bf16x8*)(lds + PG8_SA(b, h) + aoff + m * 2048 + k * 1024); } while (0)
#define PG8_LDB(dst, b, h) do { _Pragma("unroll") for (int n = 0; n < 2; ++n) _Pragma("unroll") for (int k = 0; k < 2; ++k) dst[n][k] = *(const LAS bf16x8*)(lds + PG8_SB(b, h) + boff + n * 2048 + k * 1024); } while (0)
#define PG8_MMA(ai, bj, At, Bt) do { __builtin_amdgcn_s_setprio(1); _Pragma("unroll") for (int m = 0; m < 4; ++m) _Pragma("unroll") for (int n = 0; n < 2; ++n) _Pragma("unroll") for (int k = 0; k < 2; ++k) \
        acc[ai][bj][m][n] = __builtin_amdgcn_mfma_f32_16x16x32_bf16(Bt[n][k], At[m][k], acc[ai][bj][m][n], 0, 0, 0); __builtin_amdgcn_s_setprio(0); } while (0)
#define PG8_WAIT_V(n) asm volatile("s_waitcnt vmcnt(" #n ")" ::: "memory")
#define PG8_WAIT_L(n) asm volatile("s_waitcnt lgkmcnt(" #n ")" ::: "memory")
#define PG8_BAR __builtin_amdgcn_s_barrier()
#define PG8_SCHED __builtin_amdgcn_sched_barrier(0)
#define PG8_MMAZ(Z, ai, bj, At, Bt) do { __builtin_amdgcn_s_setprio(1); _Pragma("unroll") for (int m = 0; m < 4; ++m) _Pragma("unroll") for (int n = 0; n < 2; ++n) _Pragma("unroll") for (int k = 0; k < 2; ++k) \
        acc[ai][bj][m][n] = __builtin_amdgcn_mfma_f32_16x16x32_bf16(Bt[n][k], At[m][k], ((Z) && k == 0) ? (f32x4){0.f, 0.f, 0.f, 0.f} : acc[ai][bj][m][n], 0, 0, 0); __builtin_amdgcn_s_setprio(0); } while (0)
#define PG8_TRIP(FIRST, LAST) do { PG8_SCHED; asm volatile("" : "+v"(voffA), "+v"(voffB));     \
        const char* a1 = cur.a + (unsigned)(t + 1) * kstep; \
        const char* a2 = (LAST) ? nA : cur.a + (unsigned)(t + 2) * kstep; const char* b2 = (LAST) ? nB : cur.b + (unsigned)(t + 2) * kstep; \
        const char* a3 = a2 + kstep; const char* b3 = b2 + kstep; \
        PG8_LDB(B0, 0, 0); PG8_SCHED; PG8_LDA(At, 0, 0); PG8_STAGE(PG8_SA(1, 1), a1 + hstepA, offA); \
        PG8_WAIT_L(8); PG8_BAR; PG8_WAIT_L(0); PG8_MMAZ(FIRST, 0, 0, At, B0); PG8_BAR; PG8_SCHED; \
        PG8_LDB(B1, 0, 1); PG8_STAGE(PG8_SB(0, 0), b2, offB); \
        PG8_BAR; PG8_WAIT_L(0); PG8_MMAZ(FIRST, 0, 1, At, B1); PG8_BAR; \
        PG8_LDA(At, 0, 1); PG8_STAGE(PG8_SA(0, 0), a2, offA); \
        PG8_BAR; PG8_WAIT_L(0); PG8_MMAZ(FIRST, 1, 0, At, B0); PG8_BAR; PG8_SCHED; \
        PG8_STAGE(PG8_SB(0, 1), b2 + hstepB, offB); \
        PG8_WAIT_V(6); PG8_BAR; PG8_MMAZ(FIRST, 1, 1, At, B1); PG8_BAR; \
        PG8_LDB(B0, 1, 0); PG8_SCHED; PG8_LDA(At, 1, 0); PG8_STAGE(PG8_SA(0, 1), a2 + hstepA, offA); \
        PG8_WAIT_L(8); PG8_BAR; PG8_WAIT_L(0); PG8_MMA(0, 0, At, B0); PG8_BAR; PG8_SCHED; \
        PG8_LDB(B1, 1, 1); PG8_STAGE(PG8_SB(1, 0), b3, offB); \
        PG8_BAR; PG8_WAIT_L(0); PG8_MMA(0, 1, At, B1); if constexpr ((LAST) && Epi::QUAD) { const int l_ = hw_lane(); E.template quad<0, 0>(acc, cur, wr, wc, l_ & 15, l_ >> 4); }; PG8_BAR; \
        PG8_LDA(At, 1, 1); PG8_STAGE(PG8_SA(1, 0), a3, offA); \
        PG8_BAR; PG8_WAIT_L(0); PG8_MMA(1, 0, At, B0); if constexpr ((LAST) && Epi::QUAD) { const int l_ = hw_lane(); E.template quad<0, 1>(acc, cur, wr, wc, l_ & 15, l_ >> 4); }; PG8_BAR; PG8_SCHED; \
        PG8_STAGE(PG8_SB(1, 1), b3 + hstepB, offB); \
        if constexpr ((LAST) && Epi::QUAD) PG8_WAIT_V(14); else PG8_WAIT_V(6); \
        PG8_BAR; PG8_MMA(1, 1, At, B1); if constexpr ((LAST) && Epi::QUAD) { const int l_ = hw_lane(); E.template quad<1, 0>(acc, cur, wr, wc, l_ & 15, l_ >> 4); }; PG8_BAR; PG8_SCHED; \
    } while (0)
    Unit cur, nxt; int ui = 0;
    if (!S.next(0, cur)) return;
    f32x4 acc[2][2][4][2];
    bf16x8 At[4][2], B0[2][2], B1[2][2];
    PG8_STAGE(PG8_SB(0, 0), cur.b, offB); PG8_STAGE(PG8_SA(0, 0), cur.a, offA); PG8_STAGE(PG8_SB(0, 1), cur.b + hstepB, offB); PG8_STAGE(PG8_SA(0, 1), cur.a + hstepA, offA);
    if (wr == 1) PG8_BAR;
    PG8_WAIT_V(4); PG8_BAR;
    PG8_STAGE(PG8_SB(1, 0), cur.b + kstep, offB); PG8_STAGE(PG8_SA(1, 0), cur.a + kstep, offA); PG8_STAGE(PG8_SB(1, 1), cur.b + hstepB + kstep, offB);
    PG8_WAIT_V(6); PG8_BAR;
    for (;;) {
        const bool has_next = S.next(ui + 1, nxt);
        const char* nA = has_next ? nxt.a : cur.a; const char* nB = has_next ? nxt.b : cur.b;
        { const int t = 0; PG8_TRIP(true, false); }
        for (int t = 2; t < nt - 2; t += 2) PG8_TRIP(false, false);
        { const int t = nt - 2; PG8_TRIP(false, true); }
        { const int l_ = hw_lane(); if constexpr (Epi::QUAD) E.template quad<1, 1>(acc, cur, wr, wc, l_ & 15, l_ >> 4); else E(acc, cur, wr, wc, l_ & 15, l_ >> 4); }
        if (!has_next) break;
        cur = nxt; ++ui;
    }
    PG8_WAIT_V(0);
    if (wr == 0) PG8_BAR;
    PG8_BAR;
#undef PG8_SA
#undef PG8_SB
#undef PG8_STAGE
#undef PG8_LDA
#undef PG8_LDB
#undef PG8_MMA
#undef PG8_MMAZ
#undef PG8_TRIP
#undef PG8_WAIT_V
#undef PG8_WAIT_L
#undef PG8_BAR
#undef PG8_SCHED
}
}

struct Frame { LAS unsigned char* lds; int tid, lane, wave, G, bid; const Params* P; };
struct PView {
    const Params* p; unsigned char* ws; unsigned char* big; float* out;
    __device__ __forceinline__ const float* in(int k) const { return p->in[k]; }
};
__device__ __forceinline__ PView pview(const Frame& F) { PView v; v.p = F.P; v.out = F.P->out; v.ws = F.P->ws; v.big = v.ws + WS_BIG; return v; }
__device__ __forceinline__ Frame uniform_frame(Frame F) {
    int wv = F.wave, g = F.G, b = F.bid; unsigned lb = (unsigned)(size_t)F.lds;
    asm volatile("" : "+s"(wv), "+s"(g), "+s"(b), "+s"(lb));
    int t = wv * 64 + hw_lane(); asm volatile("" : "+v"(t));
    F.tid = t; F.lane = t & 63; F.wave = wv; F.G = g; F.bid = b; F.lds = (LAS unsigned char*)(size_t)lb; return F; }
#define RFL(x) __builtin_amdgcn_readfirstlane(x)
__device__ __forceinline__ Frame unit_frame(Frame F) { int t = F.tid; asm volatile("" : "+v"(t)); F.tid = t; F.lane = t & 63; return F; }

__device__ __forceinline__ void mod_unit(const Frame& F, const PView& V, int l, int nt) {
    LAS float* sc = (LAS float*)F.lds; LAS float* red = sc + 5 * 1024;
    const float* c = V.in(1); const float* cc = V.in(3);
    __syncthreads();
    for (int i = F.tid; i < 5 * 1024; i += 512) { const float v = i < 4096 ? c[i] : cc[i - 4096]; sc[i] = siluf_(v); }
    __syncthreads();
    const int nl = F.tid & 63, kg = F.tid >> 6, n = nt * 64 + nl;
    const float* w = V.in(4) + (size_t)l * 1024 * 6144 + n;
    float a0 = 0.f, a1 = 0.f, a2 = 0.f, a3 = 0.f, a4 = 0.f;
    for (int k = kg * 128; k < kg * 128 + 128; ++k) { const float wv = w[(size_t)k * 6144];
        a0 += sc[k] * wv; a1 += sc[1024 + k] * wv; a2 += sc[2048 + k] * wv; a3 += sc[3072 + k] * wv; a4 += sc[4096 + k] * wv; }
    red[(kg * 5 + 0) * 64 + nl] = a0; red[(kg * 5 + 1) * 64 + nl] = a1; red[(kg * 5 + 2) * 64 + nl] = a2; red[(kg * 5 + 3) * 64 + nl] = a3; red[(kg * 5 + 4) * 64 + nl] = a4;
    __syncthreads();
    if (F.tid < 320) { const int bi = F.tid >> 6; float s = 0.f;
#pragma unroll
        for (int g = 0; g < 8; ++g) s += red[(g * 5 + bi) * 64 + nl];
        float* mod = (float*)(V.ws + WS_MOD);
        mod[((size_t)l * 5 + bi) * 6144 + n] = s + V.in(5)[(size_t)l * 6144 + n]; }
}
__device__ __forceinline__ void rope_table(const Frame& F, const PView& V) {
    float* rt = (float*)(V.ws + WS_ROPE);
    for (int i = F.tid; i < 128 * 16; i += 512) { const int pos = i >> 4, f = i & 15;
        const float inv = powf(10000.0f, -(float)f / 16.0f); const float ang = (float)pos * inv;
        rt[2 * i] = cosf(ang); rt[2 * i + 1] = sinf(ang); }
}
__device__ __forceinline__ int srcmap(int kind, int n) {
    switch (kind) {
        case 0: return n < 2048 ? n : (n < 2064 ? n : -1);
        case 1: return 2064 + n;
        case 2: { const int dt = n >> 8, c = n & 255, bj = c >> 7, wc = (c >> 5) & 3, nn = (c >> 4) & 1, fq = (c >> 2) & 3, j = c & 3;
                  return 4880 + (2 * bj + nn) * 1024 + dt * 64 + wc * 16 + fq * 4 + j; }
        case 3: return n;
        default: { const int pt = n >> 8, c = n & 255; return (c >> 7) * 2816 + pt * 128 + (c & 127); }
    }
}
struct TileDesc { const float* src; bf16_t* dst; int ldsrc, K, n0, k0, kind; };
__device__ __forceinline__ void convert_tiles4(const Frame& F, const TileDesc (&td)[4], int ntiles) {
    LAS float* tile = (LAS float*)F.lds;
    const int nn = F.tid & 63, kq = F.tid >> 6; float v[4][8];
#pragma unroll
    for (int q = 0; q < 4; ++q) { const int sc = q < ntiles ? srcmap(td[q].kind, td[q].n0 + nn) : -1;
#pragma unroll
        for (int i = 0; i < 8; ++i) { const int kk = kq * 8 + i; v[q][i] = sc >= 0 ? td[q].src[(size_t)(td[q].k0 + kk) * td[q].ldsrc + sc] : 0.f; } }
    __syncthreads();
#pragma unroll
    for (int q = 0; q < 4; ++q)
#pragma unroll
        for (int i = 0; i < 8; ++i) tile[q * 4160 + (kq * 8 + i) * 65 + nn] = v[q][i];
    __syncthreads();
    const int n2 = F.tid >> 3, k8 = (F.tid & 7) * 8;
#pragma unroll
    for (int q = 0; q < 4; ++q) if (q < ntiles) { float f[8];
#pragma unroll
        for (int i = 0; i < 8; ++i) f[i] = tile[q * 4160 + (k8 + i) * 65 + n2];
        *(u32x4*)(td[q].dst + (size_t)(td[q].n0 + n2) * td[q].K + td[q].k0 + k8) = pack8(f); }
}
__device__ __forceinline__ void weff_unit(const Frame& F, const PView& V, int l, int g, int et) {
    LAS float* pw = (LAS float*)F.lds; LAS float* sw = pw + 128 * 129;
    const float* poolw = V.in(10) + ((size_t)l * 4 + g) * 128 * 128; const float* scale = V.in(11) + (size_t)l * 512 + g * 128;
    const float* wb1 = V.in(14) + (((size_t)l * 4 + 1) * 512 + g * 128) * 1024 + et * 64;
    __syncthreads();
    for (int i = F.tid; i < 128 * 128; i += 512) pw[(i >> 7) * 129 + (i & 127)] = poolw[i];
    for (int i = F.tid; i < 128 * 64; i += 512) { const int d = i >> 6, e = i & 63; sw[d * 65 + e] = scale[d] * wb1[(size_t)d * 1024 + e]; }
    __syncthreads();
    const int el = F.tid & 63, cg = F.tid >> 6; float acc[16];
#pragma unroll
    for (int i = 0; i < 16; ++i) acc[i] = 0.f;
    for (int d = 0; d < 128; ++d) { const float s = sw[d * 65 + el];
#pragma unroll
        for (int i = 0; i < 16; ++i) acc[i] += pw[(cg * 16 + i) * 129 + d] * s; }
    bf16_t* dst = (bf16_t*)(V.ws + W_B) + ((size_t)1024 + et * 64 + el) * 512 + g * 128 + cg * 16;
    float f0[8], f1[8];
#pragma unroll
    for (int i = 0; i < 8; ++i) { f0[i] = acc[i]; f1[i] = acc[8 + i]; }
    *(u32x4*)dst = pack8(f0); *(u32x4*)(dst + 8) = pack8(f1);
}
__device__ __forceinline__ TileDesc tile_desc(const PView& V, int l, int t) {
    unsigned char* ws = V.ws; const float* w_in = V.in(7) + (size_t)l * 1024 * INW; TileDesc d;
    const int T0 = 36 * 16, T1 = T0 + 44 * 16, T2 = T1 + 64 * 16, T3 = T2 + 3 * 16 * 8, T4 = T3 + 16 * 16, T5 = T4 + 88 * 16;
    if (t < T0) { d.src = w_in; d.ldsrc = INW; d.K = 1024; d.dst = (bf16_t*)(ws + W_LSTM); d.n0 = (t / 16) * 64; d.k0 = (t % 16) * 64; d.kind = 0; }
    else if (t < T1) { const int q = t - T0; d.src = w_in; d.ldsrc = INW; d.K = 1024; d.dst = (bf16_t*)(ws + W_REST); d.n0 = (q / 16) * 64; d.k0 = (q % 16) * 64; d.kind = 1; }
    else if (t < T2) { const int q = t - T1; d.src = w_in; d.ldsrc = INW; d.K = 1024; d.dst = (bf16_t*)(ws + W_GATE); d.n0 = (q / 16) * 64; d.k0 = (q % 16) * 64; d.kind = 2; }
    else if (t < T3) { const int q = t - T2, bi = q / 128, r = q % 128; const int nb = bi == 0 ? 0 : bi + 1;
        d.src = V.in(14) + ((size_t)l * 4 + nb) * 512 * 1024; d.ldsrc = 1024; d.K = 512; d.dst = (bf16_t*)(ws + W_B) + (size_t)nb * 1024 * 512; d.n0 = (r / 8) * 64; d.k0 = (r % 8) * 64; d.kind = 3; }
    else if (t < T4) { const int q = t - T3; d.src = V.in(15) + (size_t)l * 1024 * 1024; d.ldsrc = 1024; d.K = 1024; d.dst = (bf16_t*)(ws + W_O); d.n0 = (q / 16) * 64; d.k0 = (q % 16) * 64; d.kind = 3; }
    else if (t < T5) { const int q = t - T4; d.src = V.in(16) + (size_t)l * 1024 * 5632; d.ldsrc = 5632; d.K = 1024; d.dst = (bf16_t*)(ws + W_UP); d.n0 = (q / 16) * 64; d.k0 = (q % 16) * 64; d.kind = 4; }
    else { const int q = t - T5; d.src = V.in(18) + (size_t)l * DFF * 1024; d.ldsrc = 1024; d.K = DFF; d.dst = (bf16_t*)(ws + W_DN); d.n0 = (q / 44) * 64; d.k0 = (q % 44) * 64; d.kind = 3; }
    return d;
}
__device__ __forceinline__ void prep_weights(const Frame& F, const PView& V, int l, int t0, int t1, int wid, int nw, bool with_weff) {
#pragma unroll 1
    for (int t = t0 + wid; t < t1; t += 4 * nw) { TileDesc td[4]; int nt = 0;
#pragma unroll
        for (int q = 0; q < 4; ++q) { const int tq = t + q * nw; td[q] = tile_desc(V, l, tq < t1 ? tq : t); nt += tq < t1 ? 1 : 0; }
        convert_tiles4(F, td, nt); }
    if (with_weff) for (int q = wid; q < 64; q += nw) weff_unit(F, V, l, q >> 4, q & 15);
}
constexpr int PREP_T0 = 36 * 16, PREP_T1 = PREP_T0 + 44 * 16, PREP_T2 = PREP_T1 + 64 * 16, PREP_T3 = PREP_T2 + 3 * 16 * 8, PREP_T4 = PREP_T3 + 16 * 16, PREP_T5 = PREP_T4 + 88 * 16, PREP_NT = PREP_T5 + 16 * 44;
__device__ __forceinline__ void tail_prep(const Frame& F, const PView& V, int l, int units, int t0, int t1, int u0, int u1, bool with_weff) {
    const int nbusy = units % F.G;
    int wid = F.bid, nw = F.G;
    if (nbusy > 0) { if (F.bid < nbusy) return; wid = F.bid - nbusy; nw = F.G - nbusy; }
    prep_weights(F, V, l, t0, t1, wid, nw, with_weff);
    if (u1 > u0) prep_weights(F, V, l, u0, u1, wid, nw, false);
}

__device__ __forceinline__ void rows_phase(const Frame& F, const PView& V, int Mrows, const void* xsl, bool src_f32, const float* xsc, void* xdl, bool dst_f32, float* xdc, const bf16_t* y, const float* gpost, const float* modcur, int kgate,
                           bool has_next, const float* gpre, const float* modnext, int kshift, int kscale, bf16_t* U, int wg, int nwg, int pass_lo, int pass_hi) {
    const int lane = F.lane; const int wv = wg * 8 + F.wave, nwv = nwg * 8;
#pragma unroll 1
    for (int pass = pass_lo; pass < pass_hi; ++pass) {
        const int per = nwv >> 2; const int bi = pass == 0 ? wv / per : 4;
        int r = pass == 0 ? bi * SEQ + (wv % per) : ML + wv; const int rstep = pass == 0 ? per : nwv; const int rend = pass == 0 ? (bi + 1) * SEQ : Mrows;
        if (pass == 0 && bi > 3) continue;
        if (r >= rend) continue;
        float cA[16], cB[16], cC[16];
#pragma unroll
        for (int i = 0; i < 2; ++i)
#pragma unroll
            for (int j = 0; j < 8; ++j) { const int c = 512 * i + 8 * lane + j; cA[8 * i + j] = 0.f; cB[8 * i + j] = 0.f; cC[8 * i + j] = 0.f;
                if (y) cA[8 * i + j] = modcur[(size_t)bi * 6144 + kgate * 1024 + c] * gpost[c];
                if (has_next) { cB[8 * i + j] = gpre[c] * (1.0f + modnext[(size_t)bi * 6144 + kscale * 1024 + c]); cC[8 * i + j] = modnext[(size_t)bi * 6144 + kshift * 1024 + c]; } }
        const bool lat = pass == 0, sf = !lat || src_f32, df = !lat || dst_f32;
#define ROWS_LOAD(rr, XR, YR) do { \
            if (sf) { const float* _xs = lat ? (const float*)xsl + (size_t)(rr) * 1024 : xsc + (size_t)((rr) - ML) * 1024; \
                XR[0] = *(const u32x4*)(_xs + 8 * lane); XR[1] = *(const u32x4*)(_xs + 8 * lane + 4); XR[2] = *(const u32x4*)(_xs + 512 + 8 * lane); XR[3] = *(const u32x4*)(_xs + 512 + 8 * lane + 4); } \
            else { const bf16_t* _xs = (const bf16_t*)xsl + (size_t)(rr) * 1024; XR[0] = ldg16(_xs + 8 * lane); XR[1] = ldg16(_xs + 512 + 8 * lane); XR[2] = XR[0]; XR[3] = XR[0]; } \
            if (y) { YR[0] = ldg16(y + (size_t)(rr) * 1024 + 8 * lane); YR[1] = ldg16(y + (size_t)(rr) * 1024 + 512 + 8 * lane); } else { YR[0] = XR[0]; YR[1] = XR[0]; } } while (0)
        u32x4 xc[4], yc[2]; ROWS_LOAD(r, xc, yc);
#pragma unroll 1
        for (; r < rend; r += rstep) {
            u32x4 xn[4], yn[2]; { const int rn = r + rstep < rend ? r + rstep : r; ROWS_LOAD(rn, xn, yn); }
            float xv[16];
            if (sf) {
#pragma unroll
                for (int i = 0; i < 4; ++i) { xv[4 * i] = __uint_as_float(xc[i].x); xv[4 * i + 1] = __uint_as_float(xc[i].y); xv[4 * i + 2] = __uint_as_float(xc[i].z); xv[4 * i + 3] = __uint_as_float(xc[i].w); } }
            else {
#pragma unroll
                for (int i = 0; i < 2; ++i) { float f[8]; unpack8(xc[i], f);
#pragma unroll
                    for (int j = 0; j < 8; ++j) xv[8 * i + j] = f[j]; } }
            if (y) {
                float yv[16]; float ss = 0.f;
#pragma unroll
                for (int i = 0; i < 2; ++i) { float f[8]; unpack8(yc[i], f);
#pragma unroll
                    for (int j = 0; j < 8; ++j) { yv[8 * i + j] = f[j]; ss += f[j] * f[j]; } }
                ss = wave_sum(ss, lane); const float rs = rsqrtf(ss * (1.0f / 1024.0f) + EPS);
#pragma unroll
                for (int i = 0; i < 16; ++i) xv[i] += cA[i] * (yv[i] * rs);
            }
            if (df) { float* xd = lat ? (float*)xdl + (size_t)r * 1024 : xdc + (size_t)(r - ML) * 1024;
#pragma unroll
                for (int i = 0; i < 2; ++i) { const int c0 = 512 * i + 8 * lane;
                    *(f32x4*)(xd + c0) = (f32x4){xv[8 * i], xv[8 * i + 1], xv[8 * i + 2], xv[8 * i + 3]}; *(f32x4*)(xd + c0 + 4) = (f32x4){xv[8 * i + 4], xv[8 * i + 5], xv[8 * i + 6], xv[8 * i + 7]}; } }
            else { bf16_t* xd = (bf16_t*)xdl + (size_t)r * 1024;
#pragma unroll
                for (int i = 0; i < 2; ++i) { float f[8];
#pragma unroll
                    for (int j = 0; j < 8; ++j) f[j] = xv[8 * i + j];
                    *(u32x4*)(xd + 512 * i + 8 * lane) = pack8(f); } }
            if (has_next) {
                float ss = 0.f;
#pragma unroll
                for (int i = 0; i < 16; ++i) ss += xv[i] * xv[i];
                ss = wave_sum(ss, lane); const float rs = rsqrtf(ss * (1.0f / 1024.0f) + EPS);
#pragma unroll
                for (int i = 0; i < 2; ++i) { float f[8];
#pragma unroll
                    for (int j = 0; j < 8; ++j) f[j] = (xv[8 * i + j] * rs) * cB[8 * i + j] + cC[8 * i + j];
                    *(u32x4*)(U + (size_t)r * 1024 + 512 * i + 8 * lane) = pack8(f); }
            }
#pragma unroll
            for (int i = 0; i < 4; ++i) xc[i] = xn[i];
            yc[0] = yn[0]; yc[1] = yn[1];
        }
#undef ROWS_LOAD
    }
}

__device__ __forceinline__ int blk_rowbase(int b, int blk) { return blk == 0 ? ML + b * 256 : b * SEQ + (blk - 1) * 256; }
__device__ __forceinline__ float scan256(LAS float* ws, float v, int tid, bool suffix) {
    const int lane = tid & 63, w = tid >> 6; float x = v;
    if (!suffix) {
#pragma unroll
        for (int o = 1; o < 64; o <<= 1) { const float yv = lshfl(x, (lane - o) & 63); if (lane >= o) x += yv; }
    } else {
#pragma unroll
        for (int o = 1; o < 64; o <<= 1) { const float yv = lshfl(x, (lane + o) & 63); if (lane + o < 64) x += yv; }
    }
    __syncthreads();
    if (w < 4 && lane == (suffix ? 0 : 63)) ws[w] = x;
    __syncthreads();
    if (w < 4) {
        if (!suffix) { for (int j = 0; j < w; ++j) x += ws[j]; }
        else { for (int j = w + 1; j < 4; ++j) x += ws[j]; }
    }
    return x;
}
__device__ __forceinline__ void conv_silu8(const u32x4 pv, const u32x4 cv, const u32x4 nv, const LAS float* w0, const LAS float* w1, const LAS float* w2, float scale, float (&o)[8]) {
    float p[8], c[8], n[8]; unpack8(pv, p); unpack8(cv, c); unpack8(nv, n);
#pragma unroll
    for (int i = 0; i < 8; ++i) { const float yv = p[i] * w0[i] + c[i] * w1[i] + n[i] * w2[i]; o[i] = siluf_(yv) * scale; }
}

__device__ __forceinline__ void lstm_pass1_unit(const Frame& F, const PView& V, int l, int ub) {
    const int tid = F.tid, lane = F.lane, w = F.wave, r = lane & 15, quad = lane >> 4;
    const int blk = ub % NBLK, h = (ub / NBLK) & 3, b = ub / (4 * NBLK);
    const int uf = ((b * 4 + h) * 2 + 0) * NBLK + blk, ubk = uf + NBLK;
    const int rowbase = blk_rowbase(b, blk); const bool seq_first = blk <= 1, seq_last = (blk == 0 || blk == 32);
    const bf16_t* PL = (const bf16_t*)(V.big + B_PLSTM);
    LAS float* wgt = (LAS float*)F.lds;
    LAS float* sws = wgt + 512;
    LAS float* cw = wgt + 528;
    LAS bf16_t* Kt = (LAS bf16_t*)(F.lds + 4096);
    LAS bf16_t* Vt = (LAS bf16_t*)(F.lds + 4096 + 128 * 264 * 2);
    __syncthreads();
    if (tid < 384) cw[tid] = V.in(8)[(size_t)l * 3072 + (tid >> 7) * 1024 + 512 + h * 128 + (tid & 127)];
    float gif = 0.f, gib = 0.f, lff = 0.f, lfb = 0.f;
    if (tid < 256) { const bf16_t* gp = PL + (size_t)(rowbase + tid) * NLSTM + 2048; const float* gb = V.in(9) + (size_t)l * 16;
        gif = bf2f(gp[h]) + gb[h]; gib = bf2f(gp[4 + h]) + gb[4 + h]; lff = logsigmoidf_(bf2f(gp[8 + h]) + gb[8 + h]); lfb = logsigmoidf_(bf2f(gp[12 + h]) + gb[12 + h]); }
    const float cif = scan256(sws, lff, tid, false);
    const float cib = scan256(sws + 4, lfb, tid, false);
    __syncthreads();
    if (tid == 255) { sws[8] = cif; sws[9] = cib; }
    __syncthreads();
    const float totf = sws[8], totb = sws[9];
    if (tid < 256) { wgt[tid] = __expf(totf - cif + gif); wgt[256 + tid] = __expf(cib - lfb + gib);
        float* gt = (float*)(V.big + B_GT); gt[(size_t)uf * 512 + tid] = cif; gt[(size_t)uf * 512 + 256 + tid] = gif;
        gt[(size_t)ubk * 512 + tid] = totb - cib + lfb; gt[(size_t)ubk * 512 + 256 + tid] = gib; }
    if (tid == 0) { float* dec = (float*)(V.ws + WS_DEC); dec[uf] = __expf(totf); dec[ubk] = __expf(totb); }
    __syncthreads();
#pragma unroll 1
    for (int hb = 0; hb < 2; ++hb) {
        u32x4 cv[2][2], pv[2][2], nv[2][2], vv[2][2];
#pragma unroll
        for (int it = 0; it < 2; ++it) { const int pt = (hb * 2 + it) * 512 + tid, chunk = pt >> 7, tp = pt & 127;
#pragma unroll
            for (int e = 0; e < 2; ++e) { const int tau = 2 * tp + e; const int row = rowbase + tau;
                const bf16_t* kp = PL + (size_t)row * NLSTM + 512 + h * 128 + chunk * 8;
                cv[it][e] = ldg16(kp); pv[it][e] = (u32x4){0u, 0u, 0u, 0u}; nv[it][e] = pv[it][e];
                if (!(seq_first && tau == 0)) pv[it][e] = ldg16(kp - NLSTM);
                if (!(seq_last && tau == 255)) nv[it][e] = ldg16(kp + NLSTM);
                vv[it][e] = ldg16(PL + (size_t)row * NLSTM + 1024 + h * 128 + chunk * 8); } }
#pragma unroll
        for (int it = 0; it < 2; ++it) { const int pt = (hb * 2 + it) * 512 + tid, CH = pt >> 7, tp = pt & 127, kc2 = 2 * tp;
            float o0[8], o1[8];
            conv_silu8(pv[it][0], cv[it][0], nv[it][0], cw + CH * 8, cw + 128 + CH * 8, cw + 256 + CH * 8, 0.08838834764831845f, o0);
            conv_silu8(pv[it][1], cv[it][1], nv[it][1], cw + CH * 8, cw + 128 + CH * 8, cw + 256 + CH * 8, 0.08838834764831845f, o1);
#pragma unroll
            for (int i = 0; i < 8; ++i) *(LAS unsigned*)(Kt + (CH * 8 + i) * 264 + kc2) = pk2(o0[i], o1[i]);
            const u32x4 va = vv[it][0], vb = vv[it][1];
            *(LAS unsigned*)(Vt + ((CH) * 8 + 0) * 264 + kc2) = (va.x & 0xffffu) | (vb.x << 16); *(LAS unsigned*)(Vt + ((CH) * 8 + 1) * 264 + kc2) = (va.x >> 16) | (vb.x & 0xffff0000u); *(LAS unsigned*)(Vt + ((CH) * 8 + 2) * 264 + kc2) = (va.y & 0xffffu) | (vb.y << 16); *(LAS unsigned*)(Vt + ((CH) * 8 + 3) * 264 + kc2) = (va.y >> 16) | (vb.y & 0xffff0000u); *(LAS unsigned*)(Vt + ((CH) * 8 + 4) * 264 + kc2) = (va.z & 0xffffu) | (vb.z << 16); *(LAS unsigned*)(Vt + ((CH) * 8 + 5) * 264 + kc2) = (va.z >> 16) | (vb.z & 0xffff0000u); *(LAS unsigned*)(Vt + ((CH) * 8 + 6) * 264 + kc2) = (va.w & 0xffffu) | (vb.w << 16); *(LAS unsigned*)(Vt + ((CH) * 8 + 7) * 264 + kc2) = (va.w >> 16) | (vb.w & 0xffff0000u); }
    }
    __syncthreads();
    bf16x8 af[8];
#pragma unroll
    for (int ks = 0; ks < 8; ++ks) af[ks] = *(const LAS bf16x8*)(Kt + (16 * w + r) * 264 + 32 * ks + 8 * quad);
    const bf16x8 ones = {(short)0x3f80, (short)0x3f80, (short)0x3f80, (short)0x3f80, (short)0x3f80, (short)0x3f80, (short)0x3f80, (short)0x3f80};
    const bf16x8 zeros = {0, 0, 0, 0, 0, 0, 0, 0};
#pragma unroll 1
    for (int dir = 0; dir < 2; ++dir) {
        asm volatile("" ::: "memory");
        bf16x8 ad[8];
#pragma unroll
        for (int ks = 0; ks < 8; ++ks) { const f32x4 w0 = *(const LAS f32x4*)(wgt + dir * 256 + 32 * ks + 8 * quad), w1 = *(const LAS f32x4*)(wgt + dir * 256 + 32 * ks + 8 * quad + 4);
            float f[8]; unpack8(__builtin_bit_cast(u32x4, af[ks]), f);
            f[0] *= w0[0]; f[1] *= w0[1]; f[2] *= w0[2]; f[3] *= w0[3]; f[4] *= w1[0]; f[5] *= w1[1]; f[6] *= w1[2]; f[7] *= w1[3];
            ad[ks] = __builtin_bit_cast(bf16x8, pack8(f)); }
        bf16_t* st = (bf16_t*)(V.big + B_ST) + (size_t)(dir == 0 ? uf : ubk) * ST_ELEMS;
#pragma unroll
        for (int db = 0; db < 9; ++db) { f32x4 acc = {0.f, 0.f, 0.f, 0.f};
#pragma unroll
            for (int ks = 0; ks < 8; ++ks) { bf16x8 bfr;
                if (db < 8) bfr = *(const LAS bf16x8*)(Vt + (16 * db + r) * 264 + 32 * ks + 8 * quad); else bfr = (r == 0) ? ones : zeros;
                acc = MFMA16(ad[ks], bfr, acc); }
            u32x2 pw; pw.x = pk2(acc[0], acc[1]); pw.y = pk2(acc[2], acc[3]);
            if (db < 8) *(u32x2*)(st + (size_t)(16 * db + r) * 128 + 16 * w + 4 * quad) = pw;
            else if (r == 0) *(u32x2*)(st + (size_t)128 * 128 + 16 * w + 4 * quad) = pw; }
    }
}
__device__ __forceinline__ void lstm_scan(const Frame& F, const PView& V) {
    bf16_t* ST = (bf16_t*)(V.big + B_ST); const float* DEC = (const float*)(V.ws + WS_DEC);
    const int per = ST_ELEMS / 8;
    for (int gid = F.bid * 512 + F.tid; gid < 32 * per; gid += F.G * 512) {
        const int chain = gid / per, e8 = gid % per, dir = chain & 1; const int ub = chain * NBLK;
        float sv[8];
#pragma unroll
        for (int q = 0; q < 8; ++q) sv[q] = 0.f;
#pragma unroll 1
        for (int g = 0; g < 3; ++g) { u32x4 tmp[11]; float dc[11];
#pragma unroll
            for (int j = 0; j < 11; ++j) { const int i = g * 11 + j; const int blk = (dir == 0 || i == 0) ? i : 33 - i;
                tmp[j] = *(const u32x4*)(ST + (size_t)(ub + blk) * ST_ELEMS + e8 * 8); dc[j] = DEC[ub + blk]; }
#pragma unroll
            for (int j = 0; j < 11; ++j) { const int i = g * 11 + j; const int blk = (dir == 0 || i == 0) ? i : 33 - i;
                *(u32x4*)(ST + (size_t)(ub + blk) * ST_ELEMS + e8 * 8) = pack8(sv); float f[8]; unpack8(tmp[j], f);
#pragma unroll
                for (int q = 0; q < 8; ++q) sv[q] = sv[q] * dc[j] + f[q]; } }
    }
}
__device__ __forceinline__ void lstm_pass2_unit(const Frame& F, const PView& V, int l, int b, int h, int blk, int qh) {
    const int tid = F.tid, lane = F.lane, w = F.wave, r = lane & 15, quad = lane >> 4;
    const int rowbase = blk_rowbase(b, blk); const bool seq_first = blk <= 1, seq_last = (blk == 0 || blk == 32);
    const bf16_t* PL = (const bf16_t*)(V.big + B_PLSTM);
    LAS float* cf = (LAS float*)F.lds; LAS float* cb = cf + 256; LAS float* igf = cf + 512; LAS float* igb = cf + 768;
    LAS float* sws = cf + 1024;
    LAS float* cwq = cf + 1056;
    LAS float* cwk = cwq + 384;
    LAS bf16_t* CTf = (LAS bf16_t*)(F.lds + 7424);
    LAS bf16_t* CTb = (LAS bf16_t*)(F.lds + 42512);
    LAS bf16_t* Kh = (LAS bf16_t*)(F.lds + 77600);
    LAS bf16_t* Vt = (LAS bf16_t*)(F.lds + 112416);
    const int qi = 8 * qh + w, t = 16 * qi + r; const int qrow = rowbase + t;
    __syncthreads();
    float cwq_v = 0.f, cwk_v = 0.f;
    if (tid < 384) { cwq_v = V.in(8)[(size_t)l * 3072 + (tid >> 7) * 1024 + h * 128 + (tid & 127)]; cwk_v = V.in(8)[(size_t)l * 3072 + (tid >> 7) * 1024 + 512 + h * 128 + (tid & 127)]; }
    float cfv = 0.f, cbv = 0.f, gif = 0.f, gib = 0.f;
    if (tid < 256) { const float* gtf = (const float*)(V.big + B_GT) + (size_t)(((b * 4 + h) * 2 + 0) * NBLK + blk) * 512; const float* gtb = gtf + (size_t)NBLK * 512;
        cfv = gtf[tid]; gif = gtf[256 + tid]; cbv = gtb[tid]; gib = gtb[256 + tid]; }
    u32x4 qc[4], qp_[4], qn[4];
#pragma unroll
    for (int ks = 0; ks < 4; ++ks) { const bf16_t* qp = PL + (size_t)qrow * NLSTM + h * 128 + 32 * ks + 8 * quad;
        qc[ks] = ldg16(qp); qp_[ks] = (u32x4){0u, 0u, 0u, 0u}; qn[ks] = qp_[ks];
        if (!(seq_first && t == 0)) qp_[ks] = ldg16(qp - NLSTM);
        if (!(seq_last && t == 255)) qn[ks] = ldg16(qp + NLSTM); }
    u32x2 og[8];
    const bf16_t* sf = (const bf16_t*)(V.big + B_ST) + (size_t)(((b * 4 + h) * 2 + 0) * NBLK + blk) * ST_ELEMS; const bf16_t* sb = sf + (size_t)NBLK * ST_ELEMS;
    const bool carried = blk != 0;
    if (tid < 384) { cwq[tid] = cwq_v; cwk[tid] = cwk_v; }
    if (tid < 256) { cf[tid] = cfv; cb[tid] = cbv; igf[tid] = gif; igb[tid] = gib; }
    __builtin_amdgcn_sched_barrier(0);
    if (carried) { u32x4 fa[5], fc[5];
#pragma unroll
        for (int it = 0; it < 5; ++it) { const int i = tid + 512 * it; fa[it] = (u32x4){0u, 0u, 0u, 0u}; fc[it] = fa[it];
            if (i < ST_ELEMS / 8) { fa[it] = *(const u32x4*)(sf + (size_t)i * 8); fc[it] = *(const u32x4*)(sb + (size_t)i * 8); } }
#pragma unroll
        for (int it = 0; it < 5; ++it) { const int i = tid + 512 * it; if (i < ST_ELEMS / 8) { const int row = i >> 4, c8 = (i & 15) * 8;
            *(LAS u32x4*)(CTf + row * 136 + c8) = fa[it]; *(LAS u32x4*)(CTb + row * 136 + c8) = fc[it]; } } }
    __builtin_amdgcn_sched_barrier(0);
    u32x4 kc[4], kp_[4], kn[4], vv[4];
#define P2_KV_LOAD(kh_) do { _Pragma("unroll") for (int it = 0; it < 4; ++it) { const int task = it * 512 + tid, chunk = task & 15, key = task >> 4, tau = 128 * (kh_) + key; \
        const bf16_t* kp = PL + (size_t)(rowbase + tau) * NLSTM + 512 + h * 128 + chunk * 8; \
        kc[it] = ldg16(kp); kp_[it] = (u32x4){0u, 0u, 0u, 0u}; kn[it] = kp_[it]; \
        if (!(seq_first && tau == 0)) kp_[it] = ldg16(kp - NLSTM); \
        if (!(seq_last && tau == 255)) kn[it] = ldg16(kp + NLSTM); \
        } } while (0)
#define P2_V_LOAD(kh_) do { _Pragma("unroll") for (int it = 0; it < 2; ++it) { const int pt = it * 512 + tid; \
        const bf16_t* vp = PL + (size_t)(rowbase + 128 * (kh_) + 2 * (pt & 63)) * NLSTM + 1024 + h * 128 + (pt >> 6) * 8; vv[2 * it] = ldg16(vp); vv[2 * it + 1] = ldg16(vp + NLSTM); } } while (0)
#define P2_KV_STORE(KD, VD) do { _Pragma("unroll") for (int it = 0; it < 4; ++it) { const int task = it * 512 + tid, chunk = task & 15, key = task >> 4; \
        float o[8]; conv_silu8(kp_[it], kc[it], kn[it], cwk + chunk * 8, cwk + 128 + chunk * 8, cwk + 256 + chunk * 8, 0.08838834764831845f, o); \
        *(LAS u32x4*)((KD) + key * 136 + chunk * 8) = pack8(o); } \
        _Pragma("unroll") for (int it = 0; it < 2; ++it) { const int pt = it * 512 + tid; const int CH = pt >> 6, kc2 = 2 * (pt & 63); LAS bf16_t* vd_ = (VD); const u32x4 va = vv[2 * it], vb = vv[2 * it + 1]; \
        *(LAS unsigned*)(vd_ + ((CH) * 8 + 0) * 136 + kc2) = (va.x & 0xffffu) | (vb.x << 16); \
         *(LAS unsigned*)(vd_ + ((CH) * 8 + 1) * 136 + kc2) = (va.x >> 16) | (vb.x & 0xffff0000u); \
         *(LAS unsigned*)(vd_ + ((CH) * 8 + 2) * 136 + kc2) = (va.y & 0xffffu) | (vb.y << 16); \
         *(LAS unsigned*)(vd_ + ((CH) * 8 + 3) * 136 + kc2) = (va.y >> 16) | (vb.y & 0xffff0000u); \
         *(LAS unsigned*)(vd_ + ((CH) * 8 + 4) * 136 + kc2) = (va.z & 0xffffu) | (vb.z << 16); \
         *(LAS unsigned*)(vd_ + ((CH) * 8 + 5) * 136 + kc2) = (va.z >> 16) | (vb.z & 0xffff0000u); \
         *(LAS unsigned*)(vd_ + ((CH) * 8 + 6) * 136 + kc2) = (va.w & 0xffffu) | (vb.w << 16); \
         *(LAS unsigned*)(vd_ + ((CH) * 8 + 7) * 136 + kc2) = (va.w >> 16) | (vb.w & 0xffff0000u); } } while (0)
    __syncthreads();
    bf16x8 qf[4];
#pragma unroll
    for (int ks = 0; ks < 4; ++ks) { const int c0 = 32 * ks + 8 * quad; float o[8]; conv_silu8(qp_[ks], qc[ks], qn[ks], cwq + c0, cwq + 128 + c0, cwq + 256 + c0, 1.0f, o);
        qf[ks] = __builtin_bit_cast(bf16x8, pack8(o)); }
    __builtin_amdgcn_sched_barrier(0);
    P2_KV_LOAD(0);
    __builtin_amdgcn_sched_barrier(0);
    const bf16x8 ones = {(short)0x3f80, (short)0x3f80, (short)0x3f80, (short)0x3f80, (short)0x3f80, (short)0x3f80, (short)0x3f80, (short)0x3f80};
    const bf16x8 zeros = {0, 0, 0, 0, 0, 0, 0, 0};
    f32x4 accf[9], accb[9];
#pragma unroll
    for (int db = 0; db < 9; ++db) { accf[db] = (f32x4){0.f, 0.f, 0.f, 0.f}; accb[db] = accf[db]; }
    if (carried) { const float ef = __expf(cf[t]), eb = __expf(cb[t]);
#pragma unroll
        for (int db = 0; db < 9; ++db) { f32x4 a = {0.f, 0.f, 0.f, 0.f}, c = {0.f, 0.f, 0.f, 0.f};
#pragma unroll
            for (int ks = 0; ks < 4; ++ks) { bf16x8 xf, xb;
                if (db < 8) { xf = *(const LAS bf16x8*)(CTf + (16 * db + r) * 136 + 32 * ks + 8 * quad); xb = *(const LAS bf16x8*)(CTb + (16 * db + r) * 136 + 32 * ks + 8 * quad); }
                else { xf = zeros; xb = zeros; if (r == 0) { xf = *(const LAS bf16x8*)(CTf + 128 * 136 + 32 * ks + 8 * quad); xb = *(const LAS bf16x8*)(CTb + 128 * 136 + 32 * ks + 8 * quad); } }
                a = MFMA16(xf, qf[ks], a); c = MFMA16(xb, qf[ks], c); }
            accf[db] = a * ef; accb[db] = c * eb; } }
    const float cft = cf[t], cbt = cb[t];
    P2_V_LOAD(0);
    P2_KV_STORE(Kh, Vt);
    __syncthreads();
    P2_KV_LOAD(1); P2_V_LOAD(1);
    P2_KV_STORE(CTf, CTf + 128 * 136);
    __syncthreads();
#pragma unroll 1
    for (int kh = 0; kh < 2; ++kh) {
        const LAS bf16_t* Kc = kh == 0 ? Kh : CTf; const LAS bf16_t* Vc = kh == 0 ? Vt : CTf + 128 * 136;
#pragma unroll
        for (int dir = 0; dir < 2; ++dir) {
            int s0, s1;
            if (dir == 0) { if (kh > qh) continue; s0 = 0; s1 = (kh < qh) ? 4 : (w >> 1) + 1; }
            else { if (kh < qh) continue; s1 = 4; s0 = (kh > qh) ? 0 : (w >> 1); }
            const LAS float* cs = dir == 0 ? cf : cb; const LAS float* gs = dir == 0 ? igf : igb; const float ct = dir == 0 ? cft : cbt;
#pragma unroll 1
            for (int st = s0; st < s1; ++st) {
                f32x4 T0 = {0.f, 0.f, 0.f, 0.f}, T1 = {0.f, 0.f, 0.f, 0.f};
#pragma unroll
                for (int ks = 0; ks < 4; ++ks) { const bf16x8 k0 = *(const LAS bf16x8*)(Kc + (32 * st + r) * 136 + 32 * ks + 8 * quad), k1 = *(const LAS bf16x8*)(Kc + (32 * st + 16 + r) * 136 + 32 * ks + 8 * quad);
                    T0 = MFMA16(k0, qf[ks], T0); T1 = MFMA16(k1, qf[ks], T1); }
                const int sg0 = 128 * kh + 32 * st + 4 * quad;
                const f32x4 c0 = *(const LAS f32x4*)(cs + sg0), c1 = *(const LAS f32x4*)(cs + sg0 + 16), e0 = *(const LAS f32x4*)(gs + sg0), e1 = *(const LAS f32x4*)(gs + sg0 + 16);
                float p[8];
#pragma unroll
                for (int j = 0; j < 4; ++j) { const int sa = sg0 + j, sb = sg0 + 16 + j;
                    const bool va = dir == 0 ? (sa <= t) : (sa >= t), vb = dir == 0 ? (sb <= t) : (sb >= t);
                    const float da = __expf(ct - c0[j] + e0[j]), dbb = __expf(ct - c1[j] + e1[j]);
                    p[j] = va ? T0[j] * da : 0.f; p[4 + j] = vb ? T1[j] * dbb : 0.f; }
                const bf16x8 pf = __builtin_bit_cast(bf16x8, pack8(p));
#pragma unroll
                for (int db = 0; db < 9; ++db) { bf16x8 vf;
                    if (db < 8) { const s16x4 lo = *(const LAS s16x4*)(Vc + (16 * db + r) * 136 + 32 * st + 4 * quad), hi = *(const LAS s16x4*)(Vc + (16 * db + r) * 136 + 32 * st + 16 + 4 * quad);
                        vf = __builtin_shufflevector(lo, hi, 0, 1, 2, 3, 4, 5, 6, 7); }
                    else vf = (r == 0) ? ones : zeros;
                    if (dir == 0) accf[db] = MFMA16(vf, pf, accf[db]); else accb[db] = MFMA16(vf, pf, accb[db]); }
            }
        }
    }
#undef P2_KV_LOAD
#undef P2_V_LOAD
#undef P2_KV_STORE
#pragma unroll
    for (int db = 0; db < 8; ++db) og[db] = *(const u32x2*)(PL + (size_t)qrow * NLSTM + 1536 + h * 128 + 16 * db + 4 * quad);
    const float denf = lshfl(accf[8][0], r), denb = lshfl(accb[8][0], r);
    const float invf = __builtin_amdgcn_rcpf(fmaxf(fabsf(denf), 1.0f)), invb = __builtin_amdgcn_rcpf(fmaxf(fabsf(denb), 1.0f));
    bf16_t* ya = (bf16_t*)(V.big + B_YSA);
#pragma unroll
    for (int db = 0; db < 8; ++db) { const int dv = 16 * db + 4 * quad; const u32x2 ov = og[db];
        const float o0 = lo16(ov.x), o1 = hi16(ov.x), o2 = lo16(ov.y), o3 = hi16(ov.y);
        const f32x4 hv = accf[db] * invf + accb[db] * invb;
        u32x2 wv; wv.x = pk2(sigmoidf_(o0) * hv[0], sigmoidf_(o1) * hv[1]); wv.y = pk2(sigmoidf_(o2) * hv[2], sigmoidf_(o3) * hv[3]);
        *(u32x2*)(ya + (size_t)qrow * 512 + h * 128 + dv) = wv; }
}

__device__ __forceinline__ void attn_unit(const Frame& F, const PView& V, int l, bool isctx, int b, int g, int qs) {
    const int tid = F.tid, lane = F.lane, w = F.wave, r = lane & 15, quad = lane >> 4;
    const bf16_t* PR = (const bf16_t*)(V.big + B_PREST); const LAS float* ropel = (const LAS float*)(F.lds + 36864);
    LAS bf16_t* Ks = (LAS bf16_t*)F.lds;
    LAS bf16_t* Vt = (LAS bf16_t*)(F.lds + 18432);
    const int head = g * 4 + (w >> 1), qhalf = w & 1;
    const int qrow0 = isctx ? ML + b * 256 + qs * 64 : b * SEQ + qs * 64;
    const float sink = V.in(12)[l * 8 + head];
    bf16x8 qf[2][2];
#pragma unroll
    for (int qk = 0; qk < 2; ++qk) { const int qi = qhalf * 32 + qk * 16 + r, tpos = qs * 64 + qi; const bf16_t* qp = PR + (size_t)(qrow0 + qi) * NREST + PR_AQ + head * 64;
#pragma unroll
        for (int ks = 0; ks < 2; ++ks) { const int d0 = 32 * ks + 8 * quad; float own[8], par[8], o[8]; unpack8(ldg16(qp + d0), own); unpack8(ldg16(qp + (d0 ^ 16)), par);
            if (!isctx) { const int pos = ks == 0 ? (tpos >> 6) : (tpos & 63); const LAS float* rp = ropel + (pos * 16 + 8 * (quad & 1)) * 2;
#pragma unroll
                for (int j = 0; j < 8; ++j) { const float c = rp[2 * j], sn = rp[2 * j + 1]; o[j] = (quad < 2) ? own[j] * c - par[j] * sn : par[j] * sn + own[j] * c; } }
            else {
#pragma unroll
                for (int j = 0; j < 8; ++j) o[j] = own[j]; }
#pragma unroll
            for (int j = 0; j < 8; ++j) o[j] *= 0.18033688011112042f;
            qf[qk][ks] = __builtin_bit_cast(bf16x8, pack8(o)); } }
    float mrun[2], lsum[2]; f32x4 acc[2][4];
    const float sinkl = sink * 1.4426950408889634f;
#pragma unroll
    for (int qk = 0; qk < 2; ++qk) { mrun[qk] = sinkl; lsum[qk] = 0.f;
#pragma unroll
        for (int db = 0; db < 4; ++db) acc[qk][db] = (f32x4){0.f, 0.f, 0.f, 0.f}; }
    const int ntile = isctx ? 2 : 5; const int ltm = 4 * quad - r - 32 * qhalf; const int qb = qs >> 1;
    const unsigned vmask = isctx ? 3u : (3u | (qb >= 1 ? 4u : 0u) | 8u | (qb <= 62 ? 16u : 0u));
    const int skey = tid >> 2, sa = (tid >> 1) & 1, sfh = tid & 1;
    u32x4 pk1, pk2v, pv0, pv1;
#define ATT_LOAD(tl) do { const int _kr = (tl) < 2 ? ML + b * 256 + (tl) * 128 : b * SEQ + (qb + (tl) - 3) * 128; \
        const bf16_t* _kp = PR + (size_t)(_kr + skey) * NREST + PR_AK + g * 64 + sa * 32 + sfh * 8; pk1 = ldg16(_kp); pk2v = ldg16(_kp + 16); \
        const bf16_t* _vp = PR + (size_t)(_kr + 2 * (tid & 63)) * NREST + PR_AV + g * 64 + (tid >> 6) * 8; pv0 = ldg16(_vp); pv1 = ldg16(_vp + NREST); } while (0)
    ATT_LOAD(0);
#pragma unroll 1
    for (int tile = 0; tile < ntile; ++tile) {
        if (!((vmask >> tile) & 1u)) continue;
        int kb = 0, base = 0; bool band = false;
        if (tile >= 2) { kb = qb + tile - 3; band = true; base = 128 * kb - 64 * qs; }
        __syncthreads();
        { float x1[8], x2[8], o1[8], o2[8]; unpack8(pk1, x1); unpack8(pk2v, x2);
            if (band) { const int kpos = kb * 128 + skey, pos = sa == 0 ? (kpos >> 6) : (kpos & 63); const LAS float* rp = ropel + (pos * 16 + sfh * 8) * 2;
#pragma unroll
                for (int j = 0; j < 8; ++j) { const float c = rp[2 * j], sn = rp[2 * j + 1]; o1[j] = x1[j] * c - x2[j] * sn; o2[j] = x1[j] * sn + x2[j] * c; } }
            else {
#pragma unroll
                for (int j = 0; j < 8; ++j) { o1[j] = x1[j]; o2[j] = x2[j]; } }
            *(LAS u32x4*)(Ks + skey * 72 + sa * 32 + sfh * 8) = pack8(o1); *(LAS u32x4*)(Ks + skey * 72 + sa * 32 + 16 + sfh * 8) = pack8(o2); }
        { const int CH = tid >> 6, kc2 = 2 * (tid & 63); *(LAS unsigned*)(Vt + ((CH) * 8 + 0) * 136 + kc2) = (pv0.x & 0xffffu) | (pv1.x << 16); *(LAS unsigned*)(Vt + ((CH) * 8 + 1) * 136 + kc2) = (pv0.x >> 16) | (pv1.x & 0xffff0000u); *(LAS unsigned*)(Vt + ((CH) * 8 + 2) * 136 + kc2) = (pv0.y & 0xffffu) | (pv1.y << 16); *(LAS unsigned*)(Vt + ((CH) * 8 + 3) * 136 + kc2) = (pv0.y >> 16) | (pv1.y & 0xffff0000u); *(LAS unsigned*)(Vt + ((CH) * 8 + 4) * 136 + kc2) = (pv0.z & 0xffffu) | (pv1.z << 16); *(LAS unsigned*)(Vt + ((CH) * 8 + 5) * 136 + kc2) = (pv0.z >> 16) | (pv1.z & 0xffff0000u); *(LAS unsigned*)(Vt + ((CH) * 8 + 6) * 136 + kc2) = (pv0.w & 0xffffu) | (pv1.w << 16); *(LAS unsigned*)(Vt + ((CH) * 8 + 7) * 136 + kc2) = (pv0.w >> 16) | (pv1.w & 0xffff0000u); }
        __syncthreads();
        { int nx = tile + 1; while (nx < ntile && !((vmask >> nx) & 1u)) ++nx; if (nx < ntile) ATT_LOAD(nx); }
        const bool domask = band && base != 0 && base != -64;
        f32x4 T[2][8];
#pragma unroll
        for (int kt = 0; kt < 8; ++kt) { f32x4 a0 = {0.f, 0.f, 0.f, 0.f}, a1 = {0.f, 0.f, 0.f, 0.f};
#pragma unroll
            for (int ks = 0; ks < 2; ++ks) { const bf16x8 kf = *(const LAS bf16x8*)(Ks + (16 * kt + r) * 72 + 32 * ks + 8 * quad); a0 = MFMA16(kf, qf[0][ks], a0); a1 = MFMA16(kf, qf[1][ks], a1); }
            T[0][kt] = a0; T[1][kt] = a1; }
        bf16x8 pf[2][4];
#pragma unroll
        for (int qk = 0; qk < 2; ++qk) {
            if (domask) {
#pragma unroll
                for (int kt = 0; kt < 8; ++kt)
#pragma unroll
                    for (int j = 0; j < 4; ++j) { const int dlt = base + (16 * kt + j - 16 * qk) + ltm; if (dlt > 128 || dlt < -128) T[qk][kt][j] = -8e30f; }
            }
            float tmax = -1e30f;
#pragma unroll
            for (int kt = 0; kt < 8; ++kt)
#pragma unroll
                for (int j = 0; j < 4; ++j) tmax = fmaxf(tmax, T[qk][kt][j]);
            tmax = fmaxf(tmax, lshfl(tmax, lane ^ 16)); tmax = fmaxf(tmax, lshfl(tmax, lane ^ 32));
            const float mnew = fmaxf(mrun[qk], tmax), alpha = __builtin_amdgcn_exp2f(mrun[qk] - mnew); mrun[qk] = mnew;
            float psum = 0.f;
#pragma unroll
            for (int kt = 0; kt < 8; ++kt)
#pragma unroll
                for (int j = 0; j < 4; ++j) { const float pv = __builtin_amdgcn_exp2f(T[qk][kt][j] - mnew); T[qk][kt][j] = pv; psum += pv; }
            lsum[qk] = lsum[qk] * alpha + psum;
#pragma unroll
            for (int db = 0; db < 4; ++db) acc[qk][db] = acc[qk][db] * alpha;
#pragma unroll
            for (int st = 0; st < 4; ++st) { float p[8];
#pragma unroll
                for (int j = 0; j < 4; ++j) { p[j] = T[qk][2 * st][j]; p[4 + j] = T[qk][2 * st + 1][j]; }
                pf[qk][st] = __builtin_bit_cast(bf16x8, pack8(p)); }
        }
#pragma unroll
        for (int st = 0; st < 4; ++st)
#pragma unroll
            for (int db = 0; db < 4; ++db) { const s16x4 lo = *(const LAS s16x4*)(Vt + (16 * db + r) * 136 + 32 * st + 4 * quad), hi = *(const LAS s16x4*)(Vt + (16 * db + r) * 136 + 32 * st + 16 + 4 * quad);
                const bf16x8 vf = __builtin_shufflevector(lo, hi, 0, 1, 2, 3, 4, 5, 6, 7);
                acc[0][db] = MFMA16(vf, pf[0][st], acc[0][db]); acc[1][db] = MFMA16(vf, pf[1][st], acc[1][db]); }
    }
    bf16_t* yc = (bf16_t*)(V.big + B_YSB + 1 * YS_STRIDE);
#pragma unroll
    for (int qk = 0; qk < 2; ++qk) { const int qi = qhalf * 32 + qk * 16 + r; float lt = lsum[qk]; lt += lshfl(lt, lane ^ 16); lt += lshfl(lt, lane ^ 32); lt += __builtin_amdgcn_exp2f(sinkl - mrun[qk]);
        const float inv = __builtin_amdgcn_rcpf(lt);
#pragma unroll
        for (int db = 0; db < 4; ++db) { const f32x4 o = acc[qk][db] * inv; u32x2 wv; wv.x = pk2(o[0], o[1]); wv.y = pk2(o[2], o[3]);
            *(u32x2*)(yc + (size_t)(qrow0 + qi) * 512 + head * 64 + 16 * db + 4 * quad) = wv; } }
#undef ATT_LOAD
}
__device__ __forceinline__ void seq_of_row(int row0, int& seqbase, int& T) { seqbase = row0 < ML ? (row0 & ~(SEQ - 1)) : ML + ((row0 - ML) & ~(CTX - 1)); T = row0 < ML ? SEQ : CTX; }
__device__ __forceinline__ void pool_tasks(const Frame& F, const PView& V, int Mrows) {
    const bf16_t* PR = (const bf16_t*)(V.big + B_PREST); bf16_t* yb = (bf16_t*)(V.big + B_YSB + 0 * YS_STRIDE);
    const int ntask = (Mrows / 8) * 64;
#pragma unroll 1
    for (int t = F.bid * 512 + F.tid; t < ntask; t += F.G * 512) {
        const int cg = t & 15, rbl = (t >> 4) & 3, g = (t >> 6) & 3, rb = ((t >> 8) << 2) + rbl, half = 1 << g;
        const int row0 = rb * 8; int seqbase, T; seq_of_row(row0, seqbase, T); const int t0 = row0 - seqbase;
        const bf16_t* base = PR + (size_t)row0 * NREST + PR_POOL + (g * 16 + cg) * 8;
        u32x4 rw[24];
#pragma unroll
        for (int i = 0; i < 24; ++i) { const int tt = t0 - half + i; rw[i] = (u32x4){0u, 0u, 0u, 0u};
            if (i < 8 + 2 * half && tt >= 0 && tt < T) rw[i] = ldg16(base + (ptrdiff_t)(i - half) * NREST); }
        float sum[8];
#pragma unroll
        for (int j = 0; j < 8; ++j) sum[j] = 0.f;
#pragma unroll
        for (int i = 0; i < 16; ++i) if (i < 2 * half) { float f[8]; unpack8(rw[i], f);
#pragma unroll
            for (int j = 0; j < 8; ++j) sum[j] += f[j]; }
#pragma unroll
        for (int i = 0; i < 8; ++i) {
            const int tc = t0 + i, lo = tc - half < 0 ? 0 : tc - half, hi = tc + half > T ? T : tc + half; const float inv = __builtin_amdgcn_rcpf((float)(hi - lo));
            float c[8], o[8];
            if (g == 0) unpack8(rw[i + 1], c); else if (g == 1) unpack8(rw[i + 2], c); else if (g == 2) unpack8(rw[i + 4], c); else unpack8(rw[i + 8], c);
#pragma unroll
            for (int j = 0; j < 8; ++j) o[j] = sum[j] * inv - c[j];
            *(u32x4*)(yb + (size_t)(row0 + i) * 512 + (g * 16 + cg) * 8) = pack8(o);
            if (i < 7) { float fa[8], fs[8]; unpack8(rw[i], fs);
                if (g == 0) unpack8(rw[i + 2], fa); else if (g == 1) unpack8(rw[i + 4], fa); else if (g == 2) unpack8(rw[i + 8], fa); else unpack8(rw[i + 16], fa);
#pragma unroll
                for (int j = 0; j < 8; ++j) sum[j] += fa[j] - fs[j]; }
        }
    }
}
__device__ __forceinline__ void sconv_tasks(const Frame& F, const PView& V, int l, int Mrows) {
    const bf16_t* PR = (const bf16_t*)(V.big + B_PREST); bf16_t* yd = (bf16_t*)(V.big + B_YSB + 2 * YS_STRIDE);
    const int ntask = (Mrows / 8) * 64;
#pragma unroll 1
    for (int t = F.bid * 512 + F.tid; t < ntask; t += F.G * 512) {
        const int chunk = t & 63, rb = t >> 6; const int row0 = rb * 8; int seqbase, T; seq_of_row(row0, seqbase, T); const int t0 = row0 - seqbase;
        const float* cw = V.in(13) + (size_t)l * 1536 + chunk * 8;
        const bf16_t* base = PR + (size_t)row0 * NREST + chunk * 8;
        u32x4 cr[10], xr[10], br[8];
#pragma unroll
        for (int i = 0; i < 10; ++i) { const int tt = t0 - 1 + i; cr[i] = (u32x4){0u, 0u, 0u, 0u}; xr[i] = cr[i];
            if (tt >= 0 && tt < T) { cr[i] = ldg16(base + (ptrdiff_t)(i - 1) * NREST + PR_SC); xr[i] = ldg16(base + (ptrdiff_t)(i - 1) * NREST + PR_SX); } }
#pragma unroll
        for (int i = 0; i < 8; ++i) br[i] = ldg16(base + (size_t)i * NREST + PR_SB);
        float w0[8], w1[8], w2[8];
#pragma unroll
        for (int j = 0; j < 8; ++j) { w0[j] = cw[j]; w1[j] = cw[512 + j]; w2[j] = cw[1024 + j]; }
        float pa[8], pb[8], pc[8], c[8], x[8];
        unpack8(cr[0], c); unpack8(xr[0], x);
#pragma unroll
        for (int j = 0; j < 8; ++j) pa[j] = c[j] * x[j];
        unpack8(cr[1], c); unpack8(xr[1], x);
#pragma unroll
        for (int j = 0; j < 8; ++j) pb[j] = c[j] * x[j];
#pragma unroll
        for (int i = 0; i < 8; ++i) { unpack8(cr[i + 2], c); unpack8(xr[i + 2], x); float bv[8], o[8]; unpack8(br[i], bv);
#pragma unroll
            for (int j = 0; j < 8; ++j) { pc[j] = c[j] * x[j]; o[j] = bv[j] * (w0[j] * pa[j] + w1[j] * pb[j] + w2[j] * pc[j]); pa[j] = pb[j]; pb[j] = pc[j]; }
            *(u32x4*)(yd + (size_t)(row0 + i) * 512 + chunk * 8) = pack8(o); }
    }
}
constexpr int PH_PER_LAYER = 15, N_PHASES = 2 + DEPTH * PH_PER_LAYER - 1;
constexpr int F3C_WGS = ((MT - ML) / 256) * 4;
__device__ __forceinline__ void ph_prologue(Frame F0) { const Frame F = uniform_frame(F0); const PView V = pview(F);
    for (int u = F.bid; u < DEPTH * 96; u += F.G) mod_unit(F, V, u / 96, u % 96);
    if (F.bid == F.G - 1) rope_table(F, V);
    prep_weights(F, V, 0, 0, PREP_NT, F.bid, F.G, true);
}
__device__ __forceinline__ void ph_rows(Frame F0, int kind, int l) { const Frame F = uniform_frame(F0); const PView V = pview(F); kind = RFL(kind); l = RFL(l);
    const float* modall = (const float*)(V.ws + WS_MOD); const float* modl = modall + (size_t)l * 5 * 6144; const float* ng = V.in(6) + (size_t)l * 4 * 1024;
    bf16_t* U = (bf16_t*)V.out; bf16_t* X = (bf16_t*)(V.ws + WS_X); float* H = (float*)(V.ws + WS_H); const bool ctx_out = l < DEPTH - 1;
    if (kind == 0) rows_phase(F, V, MT, V.in(0), true, V.in(2), X, false, H, nullptr, nullptr, nullptr, 0, true, ng, modl, 0, 1, U, F.bid, F.G, 0, 2);
    else if (kind == 1) { const int skip = ctx_out ? F3C_WGS : 0;
        if (F.bid >= skip) rows_phase(F, V, ML, X, false, H, X, false, H, (const bf16_t*)(V.big + B_MX), ng + 1024, modl, 2, true, ng + 2048, modl, 3, 4, U, F.bid - skip, F.G - skip, 0, 1); }
    else if (kind == 4) rows_phase(F, V, MT, X, false, H, X, false, H, (const bf16_t*)(V.big + B_MX), ng + 1024, modl, 2, true, ng + 2048, modl, 3, 4, U, F.bid, F.G, 1, 2);
    else if (kind == 2) { const int skip = ctx_out ? F3C_WGS : 0;
        if (F.bid >= skip) rows_phase(F, V, ML, X, false, H, ctx_out ? (void*)X : (void*)V.out, !ctx_out, H, (const bf16_t*)(V.big + B_FX), ng + 3072, modl, 5, ctx_out, ng + 4096, modl + 5 * 6144, 0, 1, U, F.bid - skip, F.G - skip, 0, 1); }
    else rows_phase(F, V, MT, X, false, H, X, false, H, (const bf16_t*)(V.big + B_FX), ng + 3072, modl, 5, true, ng + 4096, modl + 5 * 6144, 0, 1, U, F.bid, F.G, 1, 2);
}
__device__ __forceinline__ void ph_gemm_store(Frame F0, int which, int l) { const Frame F = uniform_frame(F0); const PView V = pview(F); which = RFL(which); l = RFL(l);
    unsigned char* ws = V.ws; unsigned char* big = V.big; const char* U = (const char*)V.out; const int nMr = (l < DEPTH - 1 ? MT : ML) / 256;
    pg8::Sched S; pg8::EpiStore E; int K = 1024;
    S.A0 = U; S.A1 = U; S.A2 = U; S.A3 = U; S.lda = 1024; S.ldb = 1024; S.G = F.G; S.c = F.bid;
    if (which == 0) { S.B = (const char*)(ws + W_LSTM); S.nM = MT / 256; S.nN = NLSTM / 256; S.grp = S.nN; E.O = (bf16_t*)(big + B_PLSTM); E.ldc = NLSTM; }
    else if (which == 1) { S.B = (const char*)(ws + W_REST); S.nM = MT / 256; S.nN = NREST / 256; S.grp = S.nN; E.O = (bf16_t*)(big + B_PREST); E.ldc = NREST; }
    else if (which == 2) { const char* ys = (const char*)(big + B_YSB); S.A0 = (const char*)(big + B_YSA); S.A1 = ys; S.A2 = ys + YS_STRIDE; S.A3 = ys + 2 * YS_STRIDE; S.B = (const char*)(ws + W_B); S.lda = 512; S.ldb = 512;
        S.nM = nMr; S.nN = 16; S.grp = 4; E.O = (bf16_t*)(big + B_PROJ); E.ldc = PROJ_LD; K = 512; }
    else if (which == 3 || which == 8) { const size_t p0 = which == 8 ? (size_t)ML : 0;
        const char* a = (const char*)(big + B_MERGED) + p0 * 1024 * 2; S.A0 = a; S.A1 = a; S.A2 = a; S.A3 = a; S.B = (const char*)(ws + W_O); S.nM = which == 8 ? (MT - ML) / 256 : ML / 256; S.nN = 4; S.grp = 4; E.O = (bf16_t*)(big + B_MX) + p0 * 1024; E.ldc = 1024; }
    else { const size_t p0 = which == 7 ? (size_t)ML : 0;
        const char* a = (const char*)(big + B_ACT) + p0 * DFF * 2; S.A0 = a; S.A1 = a; S.A2 = a; S.A3 = a; S.B = (const char*)(ws + W_DN); S.lda = DFF; S.ldb = DFF; S.nM = which == 7 ? (MT - ML) / 256 : ML / 256; S.nN = 4; S.grp = 4;
        E.O = (bf16_t*)(big + B_FX) + p0 * 1024; E.ldc = 1024; K = DFF; }
    pg8::gemm_phase(F.lds, F.tid, K, S, E);
    if (l > 0 && which == 2) tail_prep(uniform_frame(F0), V, l, S.nM * S.nN, PREP_T4, PREP_T5, 0, 0, false);
}
__device__ __forceinline__ void ph_gemm_ffn(Frame F0, int l) { const Frame F = uniform_frame(F0); const PView V = pview(F); l = RFL(l);
    const char* U = (const char*)V.out; const int nMr = (l < DEPTH - 1 ? MT : ML) / 256;
    pg8::Sched S{U, U, U, U, (const char*)(V.ws + W_UP), 1024, 1024, nMr, 22, 22, F.G, F.bid};
    pg8::EpiFfn E{(bf16_t*)(V.big + B_ACT), (float*)(V.big + B_HB), V.in(17) + (size_t)l * 3 * 5632, (LAS float*)(F.lds + 132096)};
    pg8::gemm_phase(F.lds, F.tid, 1024, S, E);
    if (l > 0) tail_prep(uniform_frame(F0), V, l, S.nM * S.nN, PREP_T5, PREP_NT, 0, 0, false);
    if (l < DEPTH - 1) tail_prep(uniform_frame(F0), V, l + 1, S.nM * S.nN, PREP_T1, PREP_T2, PREP_T3, PREP_T4, false);
}
__device__ __forceinline__ void ph_ffn_fix(Frame F0, int l) { const Frame F = uniform_frame(F0); const PView V = pview(F); l = RFL(l);
    const int nMr = (l < DEPTH - 1 ? MT : ML) / 256; const float* HB = (const float*)(V.big + B_HB); bf16_t* act = (bf16_t*)(V.big + B_ACT); const float* cw = V.in(17) + (size_t)l * 3 * 5632;
    const int ntask = nMr * 2 * 352;
#pragma unroll 1
    for (int t = F.bid * 512 + F.tid; t < ntask; t += F.G * 512) { const int chunk = t % 352, q = t / 352, which = q & 1, pm = q >> 1, c0 = chunk * 8;
        const bool first = pm >= 128 || (pm & 31) == 0, last = pm >= 128 || (pm & 31) == 31;
        const float* hp = HB + (size_t)pm * 4 * 5632;
        const float* rp = which == 0 ? (first ? nullptr : hp - 5632) : hp + 2 * 5632;
        const float* rc = which == 0 ? hp : hp + 3 * 5632;
        const float* rn = which == 0 ? hp + 5632 : (last ? nullptr : hp + 4 * 5632);
        float o[8];
#pragma unroll
        for (int half = 0; half < 2; ++half) { float res[2][4];
#pragma unroll
            for (int bj = 0; bj < 2; ++bj) { const int col = bj * 2816 + c0 + 4 * half; const f32x4 z = {0.f, 0.f, 0.f, 0.f};
                const f32x4 p = rp ? *(const f32x4*)(rp + col) : z, c = *(const f32x4*)(rc + col), n = rn ? *(const f32x4*)(rn + col) : z;
                const f32x4 w0 = *(const f32x4*)(cw + col), w1 = *(const f32x4*)(cw + 5632 + col), w2 = *(const f32x4*)(cw + 2 * 5632 + col);
#pragma unroll
                for (int j = 0; j < 4; ++j) res[bj][j] = w0[j] * p[j] + w1[j] * c[j] + w2[j] * n[j]; }
#pragma unroll
            for (int j = 0; j < 4; ++j) o[4 * half + j] = siluf_(res[0][j]) * res[1][j]; }
        *(u32x4*)(act + (size_t)(pm * 256 + (which ? 255 : 0)) * DFF + c0) = pack8(o); }
}
__device__ __forceinline__ void ph_gemm_merge(Frame F0, int l) { const Frame F = uniform_frame(F0); const PView V = pview(F); l = RFL(l);
    const char* U = (const char*)V.out; const int nMr = (l < DEPTH - 1 ? MT : ML) / 256;
    pg8::Sched S{U, U, U, U, (const char*)(V.ws + W_GATE), 1024, 1024, nMr, 16, 16, F.G, F.bid};
    pg8::EpiMerge E{(const bf16_t*)(V.big + B_PROJ), (bf16_t*)(V.big + B_MERGED)}; pg8::gemm_phase(F.lds, F.tid, 1024, S, E);
    if (l < DEPTH - 1) tail_prep(uniform_frame(F0), V, l + 1, S.nM * S.nN, 0, PREP_T1, PREP_T2, PREP_T3, true);
}
__device__ __forceinline__ void ph_pass1(Frame F0, int l) { const Frame F = uniform_frame(F0); const PView V = pview(F); l = RFL(l);
    for (int u = F.G - 1 - F.bid; u < NCHAIN_UNITS / 2; u += F.G) lstm_pass1_unit(unit_frame(F), V, l, u); }
__device__ __forceinline__ void ph_scan(Frame F0) { const Frame F = uniform_frame(F0); const PView V = pview(F); lstm_scan(F, V); }
__device__ __forceinline__ void ph_pass2(Frame F0, int l) { const Frame F = uniform_frame(F0); const PView V = pview(F); l = RFL(l);
    const int nlat = NB * 4 * 32 * 2, nu = nlat + ((l < DEPTH - 1) ? NB * 4 * 2 : 0);
    for (int u = F.bid; u < nu; u += F.G) { const int qh = u & 1; int blk, bh;
        if (u < nlat) { const int r = u >> 1; blk = 1 + (r & 31); bh = r >> 5; } else { blk = 0; bh = (u - nlat) >> 1; }
        lstm_pass2_unit(unit_frame(F), V, l, bh >> 2, bh & 3, blk, qh); } }
__device__ __forceinline__ void ph_attn(Frame F0, int l) { const Frame F = uniform_frame(F0); const PView V = pview(F); l = RFL(l);
    { const f32x4* rt = (const f32x4*)(V.ws + WS_ROPE); LAS f32x4* rl = (LAS f32x4*)(F.lds + 36864); __syncthreads(); rl[F.tid] = rt[F.tid]; rl[512 + F.tid] = rt[512 + F.tid]; __syncthreads(); }
    const int nlat = NB * 2 * 128, nctx = (l < DEPTH - 1) ? NB * 2 * 4 : 0;
    for (int u = F.bid; u < nlat; u += F.G) attn_unit(unit_frame(F), V, l, false, u >> 8, (u >> 7) & 1, u & 127);
    for (int q = F.G - 1 - F.bid; q < nctx; q += F.G) attn_unit(unit_frame(F), V, l, true, q >> 3, (q >> 2) & 1, q & 3); }
__device__ __forceinline__ void ph_poolconv(Frame F0, int l) { const Frame F = uniform_frame(F0); const PView V = pview(F); l = RFL(l);
    const int Mrows = (l < DEPTH - 1) ? MT : ML; pool_tasks(F, V, Mrows); sconv_tasks(F, V, l, Mrows); }

__global__ void __launch_bounds__(512, 2) fwd(Params P) {
    extern __shared__ __attribute__((aligned(16))) unsigned char lds_raw[];
    Frame F; F.lds = (LAS unsigned char*)lds_raw; F.wave = __builtin_amdgcn_readfirstlane((int)threadIdx.x >> 6); F.tid = 0; F.lane = 0; F.G = gridDim.x; F.bid = blockIdx.x; F.P = &P;
    volatile LAS unsigned* ctlw = (volatile LAS unsigned*)(F.lds + LDS_WORK);
    { const int t0 = F.wave * 64 + hw_lane(); if (t0 < 16) ctlw[t0] = 0u; }
    __syncthreads();
    const size_t bar_off = WS_CTL + (size_t)P.bar_region * 16384;
    XcdBarrier bar; bar.bar = (unsigned*)(P.ws + bar_off); bar.x = 0; bar.st = ctlw;
    const int lo = P.ph_lo, hi = P.ph_hi;
    if (hi - lo > 1) bar = xcd_barrier_post((unsigned*)(P.ws + bar_off), ctlw, F.wave == 0 && hw_lane() == 0);
#define IN(k) (lo <= (k) && (k) < hi)
#pragma unroll 1
    for (int step = lo; step < hi; ++step) {
        const int l = step < 2 ? 0 : (step - 2) / PH_PER_LAYER, k = step < 2 ? step - 2 : (step - 2) % PH_PER_LAYER;
        if (l == DEPTH - 1 && k == 9) continue;
        switch (k) {
            case -2: if (KON(0)) ph_prologue(F); break;
            case -1: if (KON(1)) ph_rows(F, 0, 0); break;
            case 0: case 1: case 5: case 7: case 8: case 12: case 13:
                if (k == 1 && KON(3)) ph_pass1(F, l);
                if (KON(2) && !((k == 8 || k == 13) && l == DEPTH - 1)) ph_gemm_store(F, k == 0 ? 0 : (k == 1 ? 1 : (k == 5 ? 2 : (k == 7 ? 3 : (k == 8 ? 8 : (k == 12 ? 6 : 7))))), l);
                if ((k == 8 || k == 13) && KON(1)) ph_rows(F, k == 8 ? 1 : 2, l);
                break;
            case 10: if (KON(8)) ph_gemm_ffn(F, l); break;
            case 11: if (KON(8)) ph_ffn_fix(F, l); break;
            case 2: if (KON(4)) ph_scan(F); break;
            case 3: if (KON(5)) ph_pass2(F, l); break;
            case 4: if (KON(6)) ph_attn(F, l); if (KON(9)) ph_poolconv(F, l); break;
            case 6: if (KON(7)) ph_gemm_merge(F, l); break;
            default: if (KON(1)) ph_rows(F, k == 9 ? 4 : 3, l); break;
        }
        if (step + 1 < hi) { unsigned long long bp = (unsigned long long)(P.ws + bar_off); asm volatile("" : "+v"(bp)); bar.bar = (unsigned*)bp; xcd_barrier(bar, F.wave == 0 && hw_lane() == 0); }
    }
#undef IN
}

extern "C" void kernel_launch(void* const* d_in, const int* in_sizes, int n_in, void* d_out, int out_size, void* d_ws, size_t ws_size, hipStream_t stream) {
    static int grid = 0;
    if (grid == 0) {
        if (n_in != 19 || out_size != ML * D || ws_size < WS_END) { fprintf(stderr, "kernel_launch: need 19 inputs, out %d, ws >= %zu; got %d, %d, %zu\n", ML * D, (size_t)WS_END, n_in, out_size, ws_size); grid = -1; return; }
        int dev = 0, cus = 0, per_cu = 0;
        if (hipGetDevice(&dev) != hipSuccess || hipDeviceGetAttribute(&cus, hipDeviceAttributeMultiprocessorCount, dev) != hipSuccess) { grid = -1; return; }
        if (hipFuncSetAttribute((const void*)fwd, hipFuncAttributeMaxDynamicSharedMemorySize, LDS_BYTES) != hipSuccess) { fprintf(stderr, "kernel_launch: hipFuncSetAttribute failed\n"); grid = -1; return; }
        if (hipOccupancyMaxActiveBlocksPerMultiprocessor(&per_cu, (const void*)fwd, 512, LDS_BYTES) != hipSuccess || per_cu < 1) { fprintf(stderr, "kernel_launch: occupancy query says %d\n", per_cu); (void)hipGetLastError(); }
        grid = cus;
    }
    if (grid < 0) return;
    (void)hipMemsetAsync((char*)d_ws + WS_CTL, 0, 131072, stream);
    Params p{};
    for (int i = 0; i < 19; ++i) p.in[i] = (const float*)d_in[i];
    p.out = (float*)d_out; p.ws = (unsigned char*)d_ws;
#if MK_PER_PHASE
    for (int k = 0; k < N_PHASES; ++k) { p.ph_lo = k; p.ph_hi = k + 1; hipLaunchKernelGGL(fwd, dim3(grid), dim3(512), LDS_BYTES, stream, p); }
#elif defined(PROBE_K)
    { int lo = 0, reg = 0;
      for (int l = 0; l < DEPTH; ++l) { const int st = (PROBE_K < 0) ? PROBE_K + 2 : 2 + l * PH_PER_LAYER + PROBE_K; if (PROBE_K < 0 && l > 0) break;
          p.ph_lo = lo; p.ph_hi = st + 1; p.bar_region = reg++; hipLaunchKernelGGL(fwd, dim3(grid), dim3(512), LDS_BYTES, stream, p);
          for (int r = 0; r < PROBE_R; ++r) { p.ph_lo = st; p.ph_hi = st + 1; p.bar_region = 7; hipLaunchKernelGGL(fwd, dim3(grid), dim3(512), LDS_BYTES, stream, p); }
          lo = st + 1; }
      if (lo < N_PHASES) { p.ph_lo = lo; p.ph_hi = N_PHASES; p.bar_region = reg++; hipLaunchKernelGGL(fwd, dim3(grid), dim3(512), LDS_BYTES, stream, p); } }
#else
    p.ph_lo = 0; p.ph_hi = N_PHASES; p.bar_region = 0;
    hipLaunchKernelGGL(fwd, dim3(grid), dim3(512), LDS_BYTES, stream, p);
#endif
}
```

```cpp
#include <hip/hip_runtime.h>
#include <cstdio>
#include <cstdint>

#ifndef MK_PER_PHASE
#define MK_PER_PHASE 0
#endif

#ifndef MK_ONLY
#define MK_ONLY -1
#endif
#define KON(k) (MK_ONLY < 0 || MK_ONLY == (k))
#define LAS __attribute__((address_space(3)))
typedef unsigned short bf16_t;
typedef short bf16x8 __attribute__((ext_vector_type(8)));
typedef short s16x4 __attribute__((ext_vector_type(4)));
typedef float f32x4 __attribute__((ext_vector_type(4)));
typedef int i32x4 __attribute__((ext_vector_type(4)));
typedef int i32x8 __attribute__((ext_vector_type(8)));
constexpr int FP8_WSCALE = 0x7a7a7a7a;
typedef float f32x2 __attribute__((ext_vector_type(2)));
typedef unsigned u32x4 __attribute__((ext_vector_type(4)));
typedef unsigned u32x2 __attribute__((ext_vector_type(2)));
typedef __bf16 bf16v2 __attribute__((ext_vector_type(2)));

constexpr int D = 1024, NB = 4, SEQ = 8192, CTX = 256, DEPTH = 4;
constexpr int ML = NB * SEQ, MC = NB * CTX, MT = ML + MC;
constexpr int INW = 8976;
constexpr int NLSTM = 2304, NREST = 2816, NGATE = 4096, DFF = 2816, NUPH = 2816;
constexpr int PROJ_LD = 4160;
constexpr int NBLK = 33;
constexpr int NCHAIN_UNITS = NB * 4 * 2 * NBLK;
constexpr int ST_ELEMS = 129 * 128;
constexpr float EPS = 1e-6f;
constexpr int PR_POOL = 0, PR_AQ = 512, PR_AK = 1024, PR_AV = 1152, PR_SB = 1280, PR_SC = 1792, PR_SX = 2304;

constexpr size_t WS_CTL = 0;
constexpr size_t WS_MOD = 131072;
constexpr size_t WS_ROPE = WS_MOD + (size_t)DEPTH * 5 * 6144 * 4;
constexpr size_t WS_DEC = WS_ROPE + 128 * 16 * 2 * 4;
constexpr size_t WS_W = 1048576;
constexpr size_t W_LSTM = WS_W;
constexpr size_t W_REST = W_LSTM + (size_t)NLSTM * 1024 * 2;
constexpr size_t W_GATE = W_REST + (size_t)NREST * 1024 * 2;
constexpr size_t W_B = W_GATE + (size_t)NGATE * 1024 * 2;
constexpr size_t W_O = W_B + (size_t)4 * 1024 * 512 * 2;
constexpr size_t W_UP = W_O + (size_t)1024 * 1024 * 2;
constexpr size_t W_DN = W_UP + (size_t)2 * NUPH * 1024 * 2;
constexpr size_t WS_H = W_DN + (size_t)1024 * DFF * 2;
constexpr size_t WS_X = WS_H + (size_t)MC * 1024 * 4, WS_U = WS_X;
constexpr size_t WS_BIG = WS_U + (size_t)MT * 1024 * 2;
constexpr size_t YS_STRIDE = (size_t)MT * 512 * 2;
constexpr size_t B_PLSTM = 0;
constexpr size_t B_ST = (size_t)MT * NLSTM * 2;
constexpr size_t B_PREST = B_ST + (size_t)NCHAIN_UNITS * ST_ELEMS * 2;
constexpr size_t OUT_U8 = (size_t)MT * 1024 * 2;
static_assert(OUT_U8 + (size_t)MT * 1024 <= (size_t)ML * 1024 * 4, "d_out scratch");
constexpr size_t B_YSB = 0;
constexpr size_t B_PROJ = 3 * YS_STRIDE;
constexpr size_t B_YSA = B_PROJ + (size_t)MT * PROJ_LD * 2;
constexpr size_t B_MERGED = 0, B_MX = B_PROJ, B_ACT = (size_t)MT * NUPH * 2, B_FX = 0;
constexpr size_t B_HB = B_ACT + (size_t)MT * DFF * 2;
constexpr size_t B_GT = B_HB + 1048576;
constexpr size_t BIG_BYTES = B_YSA + YS_STRIDE;
constexpr size_t WS_END = WS_BIG + BIG_BYTES;
static_assert(B_PREST + (size_t)MT * NREST * 2 <= B_YSA && B_PREST % 256 == 0 && B_PROJ % 256 == 0 && B_YSA % 256 == 0, "layout");
static_assert(B_HB + (size_t)(MT / 256) * 4 * 5632 * 4 <= BIG_BYTES && B_GT >= B_PREST + (size_t)MT * NREST * 2 && B_GT + (size_t)NCHAIN_UNITS * 512 * 4 <= B_YSA, "act + halo rows overflow / gate table placement");
static_assert(W_LSTM % 256 == 0 && WS_U % 256 == 0 && WS_BIG % 256 == 0, "alignment");

constexpr int LDS_WORK = 155648;
constexpr int LDS_BYTES = LDS_WORK + 256;

struct Params { const float* in[19]; float* out; unsigned char* ws; int ph_lo, ph_hi, bar_region, pad; };

__device__ __forceinline__ float bf2f(bf16_t b) { return __uint_as_float(((unsigned)b) << 16); }
__device__ __forceinline__ u32x4 widen16(u32x2 a, u32x2 b) {
    const auto rx = __builtin_amdgcn_permlane16_swap(a.x, b.x, false, false), ry = __builtin_amdgcn_permlane16_swap(a.y, b.y, false, false);
    return (u32x4){rx[0], ry[0], rx[1], ry[1]}; }
__device__ __forceinline__ u32x2 pack8_fp8(const float (&f)[8]) {
    int d0 = __builtin_amdgcn_cvt_pk_fp8_f32(f[0], f[1], 0, false); d0 = __builtin_amdgcn_cvt_pk_fp8_f32(f[2], f[3], d0, true);
    int d1 = __builtin_amdgcn_cvt_pk_fp8_f32(f[4], f[5], 0, false); d1 = __builtin_amdgcn_cvt_pk_fp8_f32(f[6], f[7], d1, true);
    u32x2 r; r.x = (unsigned)d0; r.y = (unsigned)d1; return r; }
__device__ __forceinline__ unsigned pk2(float lo, float hi) { f32x2 v = {lo, hi}; bf16v2 r = __builtin_convertvector(v, bf16v2); return __builtin_bit_cast(unsigned, r); }
__device__ __forceinline__ bf16_t f2bf(float f) { return (bf16_t)(pk2(f, 0.f) & 0xffffu); }
__device__ __forceinline__ float lo16(unsigned w) { return __uint_as_float(w << 16); }
__device__ __forceinline__ float hi16(unsigned w) { return __uint_as_float(w & 0xffff0000u); }
__device__ __forceinline__ void unpack8(const u32x4 v, float (&f)[8]) { f[0] = lo16(v.x); f[1] = hi16(v.x); f[2] = lo16(v.y); f[3] = hi16(v.y); f[4] = lo16(v.z); f[5] = hi16(v.z); f[6] = lo16(v.w); f[7] = hi16(v.w); }
__device__ __forceinline__ u32x4 pack8(const float (&f)[8]) { u32x4 r; r.x = pk2(f[0], f[1]); r.y = pk2(f[2], f[3]); r.z = pk2(f[4], f[5]); r.w = pk2(f[6], f[7]); return r; }
__device__ __forceinline__ float sigmoidf_(float x) { return __builtin_amdgcn_rcpf(1.0f + __builtin_amdgcn_exp2f(x * -1.4426950408889634f)); }
__device__ __forceinline__ float siluf_(float x) { return x * __builtin_amdgcn_rcpf(1.0f + __builtin_amdgcn_exp2f(x * -1.4426950408889634f)); }
__device__ __forceinline__ float logsigmoidf_(float x) { return fminf(x, 0.f) - __logf(1.0f + __expf(-fabsf(x))); }
__device__ __forceinline__ float lshfl(float v, int src) { return __int_as_float(__builtin_amdgcn_ds_bpermute(src << 2, __float_as_int(v))); }
__device__ __forceinline__ float wave_sum(float v, int lane) {
#pragma unroll
    for (int o = 32; o >= 1; o >>= 1) v += lshfl(v, lane ^ o);
    return v; }
__device__ __forceinline__ u32x4 ldg16(const bf16_t* p) { return *(const u32x4*)p; }
#define MFMA16(a, b, c) __builtin_amdgcn_mfma_f32_16x16x32_bf16((a), (b), (c), 0, 0, 0)

__device__ __forceinline__ int hw_lane() { int l; asm volatile("v_mbcnt_lo_u32_b32 %0, -1, 0\n\tv_mbcnt_hi_u32_b32 %0, -1, %0" : "=v"(l)); return l; }
#define XB_TMO      128
#define XB_XCNT(j)  (256  + 64 * (j))
#define XB_XSUB(j)  (1280 + 64 * (j))
#define XB_XGEN(j)  (2304 + 64 * (j))
#define XB_TOP      3328
#define XB_TOPGEN   3392
#define XCD_BAR_WORDS 3456
#define XB_SPIN_CAP (1u << 22)
__device__ __forceinline__ unsigned xb_ld(unsigned* p)              { return __hip_atomic_load(p, __ATOMIC_RELAXED, __HIP_MEMORY_SCOPE_AGENT); }
__device__ __forceinline__ unsigned xb_add(unsigned* p, unsigned v) { return __hip_atomic_fetch_add(p, v, __ATOMIC_RELAXED, __HIP_MEMORY_SCOPE_AGENT); }
__device__ __forceinline__ unsigned xb_xcc_id() { return (unsigned)__builtin_amdgcn_s_getreg((3 << 11) | 20) & 0xFu; }
#define XB_SPIN(cond, bar) do { unsigned _sp = 0; while (cond) { __builtin_amdgcn_s_sleep(1); \
    if ((++_sp & 255u) == 0u) { if (xb_ld(&(bar)[XB_TMO])) break; if (_sp > XB_SPIN_CAP) { atomicAdd(&(bar)[XB_TMO], 1u); break; } } } } while (0)
struct XcdBarrier { unsigned* bar; unsigned x; volatile LAS unsigned* st; };
__device__ __forceinline__ XcdBarrier xcd_barrier_post(unsigned* bar, volatile LAS unsigned* st, bool leader) {
    XcdBarrier b; b.bar = bar; b.x = xb_xcc_id(); b.st = st;
    if (leader) (void)xb_add(&bar[XB_XCNT(b.x)], 1u);
    return b;
}
__device__ __forceinline__ void xcd_barrier_complete(unsigned* bar, unsigned x, unsigned& nloc, unsigned& nx) {
    const unsigned G = gridDim.x * gridDim.y * gridDim.z;
    unsigned sum, cnt, mine, sp = 0u;
    for (;;) {
        sum = 0u; cnt = 0u; mine = 0u;
#pragma unroll
        for (unsigned j = 0; j < 16; ++j) { const unsigned c = xb_ld(&bar[XB_XCNT(j)]); sum += c; cnt += (c > 0u) ? 1u : 0u; }
        mine = xb_ld(&bar[XB_XCNT(x)]);
        if (sum == G) break;
        __builtin_amdgcn_s_sleep(1);
        if ((++sp & 255u) == 0u) { if (xb_ld(&bar[XB_TMO])) break; if (sp > XB_SPIN_CAP) { atomicAdd(&bar[XB_TMO], 1u); break; } }
    }
    nloc = mine > 0u ? mine : 1u; nx = cnt > 0u ? cnt : 1u;
}
__device__ __forceinline__ void xcd_barrier(const XcdBarrier& b, bool leader) {
    asm volatile("s_waitcnt vmcnt(0)" ::: "memory");
    __syncthreads();
    if (leader) {
        unsigned* bar = b.bar;
        __builtin_amdgcn_s_waitcnt(0);
        unsigned nloc = b.st[0], nx = b.st[1];
        if (nloc == 0u) { xcd_barrier_complete(bar, b.x, nloc, nx); b.st[0] = nloc; b.st[1] = nx; }
        const unsigned old = xb_add(&bar[XB_XSUB(b.x)], 1u);
        const unsigned gen = old / nloc;
        if (old + 1u == (gen + 1u) * nloc) {
            __builtin_amdgcn_fence(__ATOMIC_RELEASE, "agent");
            asm volatile("s_waitcnt vmcnt(0)" ::: "memory");
            const unsigned og = xb_add(&bar[XB_TOP], 1u);
            const unsigned tg = og / nx;
            if (og + 1u == (tg + 1u) * nx) xb_add(&bar[XB_TOPGEN], 1u);
            else XB_SPIN(xb_ld(&bar[XB_TOPGEN]) == tg, bar);
            __builtin_amdgcn_fence(__ATOMIC_ACQUIRE, "agent");
            xb_add(&bar[XB_XGEN(b.x)], 1u);
            asm volatile("s_waitcnt vmcnt(0)" ::: "memory");
        } else {
            XB_SPIN(xb_ld(&bar[XB_XGEN(b.x)]) == gen, bar);
            __builtin_amdgcn_fence(__ATOMIC_ACQUIRE, "agent");
            asm volatile("s_waitcnt vmcnt(0)" ::: "memory");
        }
    }
    __syncthreads();
}

namespace pg8 {
constexpr int BM = 256, BK = 64, HALF = 128, HTB = HALF * BK * 2, STAGE_BYTES = 8 * HTB, NXCD = 8, WGM = 8;
__device__ __forceinline__ int lds_byte(int r, int c) { const int st = (r >> 4) * 2 + (c >> 5), rr = r & 15, cc = c & 31, ob = rr * 64 + cc * 2; return st * 1024 + (ob ^ (((ob >> 9) & 1) << 5)); }
__device__ __forceinline__ void stage_rc(int b, int& R, int& C) { const int st = b / 1024, sb = b % 1024, swz = sb ^ (((sb >> 9) & 1) << 5); R = (st >> 1) * 16 + swz / 64; C = (st & 1) * 32 + (swz % 64) / 2; }
__device__ __forceinline__ int perm32(int rho) { const int n = rho >> 4, i = rho & 15; return 8 * (i >> 2) + 4 * n + (i & 3); }
struct Unit { const char* a; const char* b; int orow, ocol; };
struct Sched {
    const char* A0; const char* A1; const char* A2; const char* A3; const char* B;
    int lda, ldb, nM, nN, grp, G, c;
    __device__ __forceinline__ bool next(int i, Unit& u) const {
        const int nwg = nM * nN; const int L = i * G + c; if (L >= nwg) return false;
        int wgid = L; { const int q = nwg / NXCD, r = nwg % NXCD, xcd = wgid % NXCD, off = wgid / NXCD; wgid = (xcd < r ? xcd * (q + 1) : r * (q + 1) + (xcd - r) * q) + off; }
        const int nig = WGM * nN, gid = wgid / nig, fm = gid * WGM, gsz = (nM - fm) < WGM ? (nM - fm) : WGM;
        const int pm = fm + ((wgid % nig) % gsz), pn = (wgid % nig) / gsz;
        const int ag = pn / grp; const char* ab = ag == 0 ? A0 : (ag == 1 ? A1 : (ag == 2 ? A2 : A3));
        u.a = ab + (size_t)pm * BM * lda * 2; u.b = B + (size_t)pn * BM * ldb * 2; u.orow = pm * BM; u.ocol = pn * BM; return true;
    }
};
struct EpiStore {
    static constexpr bool PERM = true, QUAD = true, FP8 = false;
    template <int AI, int BJ> __device__ __forceinline__ void quad(const f32x4 (&acc)[2][2][4][2], const Unit& u, int wr, int wc, int fr, int fq) const {
        const int row0 = u.orow + wr * 64 + fr + AI * HALF, col0 = u.ocol + wc * 32 + 8 * fq + BJ * HALF;
#pragma unroll
        for (int m = 0; m < 4; ++m) { const f32x4 v0 = acc[AI][BJ][m][0], v1 = acc[AI][BJ][m][1];
            u32x4 w; w.x = pk2(v0[0], v0[1]); w.y = pk2(v0[2], v0[3]); w.z = pk2(v1[0], v1[1]); w.w = pk2(v1[2], v1[3]);
            *(u32x4*)(O + (size_t)(row0 + m * 16) * ldc + col0) = w; }
    }
    bf16_t* O; int ldc;
    __device__ __forceinline__ void operator()(const f32x4 (&acc)[2][2][4][2], const Unit& u, int wr, int wc, int fr, int fq) const {
        const int row0 = u.orow + wr * 64 + fr, col0 = u.ocol + wc * 32 + 8 * fq;
#pragma unroll
        for (int ai = 0; ai < 2; ++ai)
#pragma unroll
            for (int m = 0; m < 4; ++m) { bf16_t* rowp = O + (size_t)(row0 + ai * HALF + m * 16) * ldc + col0;
#pragma unroll
                for (int bj = 0; bj < 2; ++bj) { const f32x4 v0 = acc[ai][bj][m][0], v1 = acc[ai][bj][m][1];
                    u32x4 w; w.x = pk2(v0[0], v0[1]); w.y = pk2(v0[2], v0[3]); w.z = pk2(v1[0], v1[1]); w.w = pk2(v1[2], v1[3]);
                    *(u32x4*)(rowp + bj * HALF) = w; } }
    }
};
struct EpiMerge {
    static constexpr bool PERM = false, QUAD = false, FP8 = true;
    const bf16_t* PROJ; bf16_t* O;
    __device__ __forceinline__ void operator()(f32x4 (&acc)[2][2][4][2], const Unit& u, int wr, int wc, int fr, int fq) const {
        asm volatile("" : "+v"(fr), "+v"(fq) :: "memory"); __builtin_amdgcn_sched_barrier(0);
        const int row0 = u.orow + wr * 64 + fr, d0 = (u.ocol >> 8) * 64 + wc * 16 + 4 * fq;
        u32x2 pv[2][4][4];
#pragma unroll
        for (int ai = 0; ai < 2; ++ai)
#pragma unroll
            for (int m = 0; m < 4; ++m) { const bf16_t* pp = PROJ + (size_t)(row0 + ai * HALF + m * 16) * PROJ_LD + d0;
#pragma unroll
                for (int nb = 0; nb < 4; ++nb) pv[ai][m][nb] = *(const u32x2*)(pp + nb * 1024); }
        __builtin_amdgcn_sched_barrier(0);
#pragma unroll
        for (int ai = 0; ai < 2; ++ai)
#pragma unroll
            for (int bj = 0; bj < 2; ++bj)
#pragma unroll
                for (int m = 0; m < 4; ++m)
#pragma unroll
                    for (int n = 0; n < 2; ++n) { f32x4 a = acc[ai][bj][m][n];
#pragma unroll
                        for (int j = 0; j < 4; ++j) a[j] = __builtin_amdgcn_rcpf(1.0f + __builtin_amdgcn_exp2f(a[j]));
                        acc[ai][bj][m][n] = a; }
        __builtin_amdgcn_sched_barrier(0);
        u32x2 we = {0u, 0u};
#pragma unroll
        for (int ai = 0; ai < 2; ++ai)
#pragma unroll
            for (int m = 0; m < 4; ++m) { f32x4 s = {0.f, 0.f, 0.f, 0.f};
#pragma unroll
                for (int bj = 0; bj < 2; ++bj)
#pragma unroll
                    for (int n = 0; n < 2; ++n) { const u32x2 p2 = pv[ai][m][2 * bj + n]; const f32x4 a = acc[ai][bj][m][n];
                        s[0] += a[0] * lo16(p2.x); s[1] += a[1] * hi16(p2.x); s[2] += a[2] * lo16(p2.y); s[3] += a[3] * hi16(p2.y); }
                u32x2 w; w.x = pk2(s[0], s[1]); w.y = pk2(s[2], s[3]);
                if ((m & 1) == 0) we = w;
                else { const u32x4 wq = widen16(we, w); const int odd = fq & 1;
                    *(u32x4*)(O + (size_t)(row0 + ai * HALF + (m - 1 + odd) * 16) * 1024 + d0 - 4 * odd) = wq; } }
    }
};

__device__ __forceinline__ float dpp_prev_keep(float edge, float cur) { return __int_as_float(__builtin_amdgcn_update_dpp(__float_as_int(edge), __float_as_int(cur), 0x111, 0xf, 0xf, false)); }
__device__ __forceinline__ float dpp_next_keep(float edge, float cur) { return __int_as_float(__builtin_amdgcn_update_dpp(__float_as_int(edge), __float_as_int(cur), 0x101, 0xf, 0xf, false)); }
__device__ __forceinline__ float dpp_shr1_zero(float v) { return __int_as_float(__builtin_amdgcn_update_dpp(0, __float_as_int(v), 0x111, 0xf, 0xf, true)); }
__device__ __forceinline__ float dpp_shl1_zero(float v) { return __int_as_float(__builtin_amdgcn_update_dpp(0, __float_as_int(v), 0x101, 0xf, 0xf, true)); }
__device__ __forceinline__ float dpp_ror1(float v) { return __int_as_float(__builtin_amdgcn_update_dpp(0, __float_as_int(v), 0x121, 0xf, 0xf, true)); }
__device__ __forceinline__ float dpp_ror15(float v) { return __int_as_float(__builtin_amdgcn_update_dpp(0, __float_as_int(v), 0x12f, 0xf, 0xf, true)); }
template <bool PE_DPP, bool NE_DPP>
__device__ __forceinline__ float conv3_dpp(float c, float pe, float ne, float w0, float w1, float w2, float w0m, float w2m) {
    float r;
    if constexpr (PE_DPP && NE_DPP)
        asm("s_nop 0\n\tv_mul_f32 %0, %1, %2\n\tv_fmac_f32_dpp %0, %2, %3 row_shr:1 row_mask:0xf bank_mask:0xf bound_ctrl:1\n\tv_fmac_f32_dpp %0, %2, %4 row_shl:1 row_mask:0xf bank_mask:0xf bound_ctrl:1\n\t"
            "v_fmac_f32_dpp %0, %6, %5 row_ror:1 row_mask:0xf bank_mask:0xf\n\tv_fmac_f32_dpp %0, %8, %7 row_ror:15 row_mask:0xf bank_mask:0xf"
            : "=&v"(r) : "v"(w1), "v"(c), "v"(w0), "v"(w2), "v"(w0m), "v"(pe), "v"(w2m), "v"(ne));
    else if constexpr (PE_DPP)
        asm("s_nop 0\n\tv_mul_f32 %0, %1, %2\n\tv_fmac_f32_dpp %0, %2, %3 row_shr:1 row_mask:0xf bank_mask:0xf bound_ctrl:1\n\tv_fmac_f32_dpp %0, %2, %4 row_shl:1 row_mask:0xf bank_mask:0xf bound_ctrl:1\n\t"
            "v_fmac_f32_dpp %0, %6, %5 row_ror:1 row_mask:0xf bank_mask:0xf\n\tv_fmac_f32 %0, %8, %7"
            : "=&v"(r) : "v"(w1), "v"(c), "v"(w0), "v"(w2), "v"(w0m), "v"(pe), "v"(w2m), "v"(ne));
    else
        asm("s_nop 0\n\tv_mul_f32 %0, %1, %2\n\tv_fmac_f32_dpp %0, %2, %3 row_shr:1 row_mask:0xf bank_mask:0xf bound_ctrl:1\n\tv_fmac_f32_dpp %0, %2, %4 row_shl:1 row_mask:0xf bank_mask:0xf bound_ctrl:1\n\t"
            "v_fmac_f32 %0, %6, %5\n\tv_fmac_f32_dpp %0, %8, %7 row_ror:15 row_mask:0xf bank_mask:0xf"
            : "=&v"(r) : "v"(w1), "v"(c), "v"(w0), "v"(w2), "v"(w0m), "v"(pe), "v"(w2m), "v"(ne));
    return r;
}
struct EpiFfn {
    static constexpr bool PERM = true, QUAD = false, FP8 = false;
    bf16_t* act; float* HB; const float* cw; LAS float* XB;
    __device__ __forceinline__ void operator()(f32x4 (&acc)[2][2][4][2], const Unit& u, int wr, int wc, int fr, int fq) const {
        asm volatile("" : "+v"(fr), "+v"(fq));
        const int pm = u.orow >> 8, pt = u.ocol >> 8, ch0 = pt * 128 + wc * 32 + 8 * fq, wv = wr * 4 + wc;
        LAS float* CW = XB + 2048; const int tid_ = wv * 64 + fq * 16 + fr; f32x4 cwv = {0.f, 0.f, 0.f, 0.f};
        if (tid_ < 192) { const int i = tid_ * 4; cwv = *(const f32x4*)(cw + (i >> 8) * 5632 + ((i >> 7) & 1) * 2816 + pt * 128 + (i & 127)); }
#pragma unroll
        for (int ai = 0; ai < 2; ++ai) {
            if (fr == 0) { LAS f32x4* d = (LAS f32x4*)(XB + (((wv * 4) + ai * 2 + 0) * 4 + fq) * 16); d[0] = acc[ai][0][0][0]; d[1] = acc[ai][0][0][1]; d[2] = acc[ai][1][0][0]; d[3] = acc[ai][1][0][1]; }
            if (fr == 15) { LAS f32x4* d = (LAS f32x4*)(XB + (((wv * 4) + ai * 2 + 1) * 4 + fq) * 16); d[0] = acc[ai][0][3][0]; d[1] = acc[ai][0][3][1]; d[2] = acc[ai][1][3][0]; d[3] = acc[ai][1][3][1]; } }
        if (wr == 0 && fr < 2) { float* h = HB + ((size_t)pm * 4 + fr) * 5632 + ch0;
            *(f32x4*)h = acc[0][0][0][0]; *(f32x4*)(h + 4) = acc[0][0][0][1]; *(f32x4*)(h + 2816) = acc[0][1][0][0]; *(f32x4*)(h + 2820) = acc[0][1][0][1]; }
        if (wr == 1 && fr >= 14) { float* h = HB + ((size_t)pm * 4 + (fr - 12)) * 5632 + ch0;
            *(f32x4*)h = acc[1][0][3][0]; *(f32x4*)(h + 4) = acc[1][0][3][1]; *(f32x4*)(h + 2816) = acc[1][1][3][0]; *(f32x4*)(h + 2820) = acc[1][1][3][1]; }
        if (tid_ < 192) *(LAS f32x4*)(CW + tid_ * 4) = cwv;
        asm volatile("s_waitcnt lgkmcnt(0)" ::: "memory"); __builtin_amdgcn_s_barrier(); asm volatile("" ::: "memory");
        __builtin_amdgcn_s_barrier(); asm volatile("" ::: "memory");
#pragma unroll
        for (int bj = 0; bj < 2; ++bj)
#pragma unroll
            for (int nn = 0; nn < 2; ++nn) {
                const int cl = bj * 128 + wc * 32 + 8 * fq + 4 * nn;
                const f32x4 w0 = *(const LAS f32x4*)(CW + cl), w1 = *(const LAS f32x4*)(CW + 256 + cl), w2 = *(const LAS f32x4*)(CW + 512 + cl);
                f32x4 w0m, w2m;
#pragma unroll
                for (int j = 0; j < 4; ++j) { w0m[j] = fr == 0 ? w0[j] : 0.f; w2m[j] = fr == 15 ? w2[j] : 0.f; }
#pragma unroll
                for (int ai = 0; ai < 2; ++ai) {
                    f32x4 xp = {0.f, 0.f, 0.f, 0.f}, xn = xp;
                    if (wr == 1 || ai == 1) { const int swv = wr == 1 ? wc : 4 + wc, sslot = wr == 1 ? ai * 2 + 1 : 1; xp = *(const LAS f32x4*)(XB + (((swv * 4) + sslot) * 4 + fq) * 16 + bj * 8 + nn * 4); }
                    if (wr == 0 || ai == 0) { const int swv = wr == 0 ? 4 + wc : wc, sslot = wr == 0 ? ai * 2 : 2; xn = *(const LAS f32x4*)(XB + (((swv * 4) + sslot) * 4 + fq) * 16 + bj * 8 + nn * 4); }
                    f32x4 po = xp;
#pragma unroll
                    for (int m = 0; m < 4; ++m) { const f32x4 c = acc[ai][bj][m][nn]; const f32x4 nx = acc[ai][bj][m < 3 ? m + 1 : 3][nn]; f32x4 rr;
#pragma unroll
                        for (int j = 0; j < 4; ++j) rr[j] = m == 0 ? conv3_dpp<false, true>(c[j], xp[j], nx[j], w0[j], w1[j], w2[j], w0m[j], w2m[j]) : (m == 3 ? conv3_dpp<true, false>(c[j], po[j], xn[j], w0[j], w1[j], w2[j], w0m[j], w2m[j]) : conv3_dpp<true, true>(c[j], po[j], nx[j], w0[j], w1[j], w2[j], w0m[j], w2m[j]));
                        asm volatile("" : "+v"(rr[0]), "+v"(rr[1]), "+v"(rr[2]), "+v"(rr[3]));
                        po = c; acc[ai][bj][m][nn] = rr; }
                    __builtin_amdgcn_sched_barrier(0);
                }
            }
        const int row0 = u.orow + wr * 64 + fr;
#pragma unroll
        for (int ai = 0; ai < 2; ++ai)
#pragma unroll
            for (int m = 0; m < 4; ++m) { const f32x4 g0 = acc[ai][0][m][0], g1 = acc[ai][0][m][1], v0 = acc[ai][1][m][0], v1 = acc[ai][1][m][1];
                u32x4 o; o.x = pk2(siluf_(g0[0]) * v0[0], siluf_(g0[1]) * v0[1]); o.y = pk2(siluf_(g0[2]) * v0[2], siluf_(g0[3]) * v0[3]);
                o.z = pk2(siluf_(g1[0]) * v1[0], siluf_(g1[1]) * v1[1]); o.w = pk2(siluf_(g1[2]) * v1[2], siluf_(g1[3]) * v1[3]);
                *(u32x4*)(act + (size_t)(row0 + ai * HALF + m * 16) * DFF + ch0) = o; __builtin_amdgcn_sched_barrier(0); }
    }
};

template <class Epi>
__device__ __forceinline__ void gemm_phase(LAS unsigned char* lds, const int tid, const int K, const Sched& S, const Epi& E) {
    const int wid = __builtin_amdgcn_readfirstlane(tid >> 6), lane = tid & 63, wr = wid >> 2, wc = wid & 3, fr = lane & 15, fq = lane >> 4;
    const int nt = K / BK; const int lda = S.lda, ldb = S.ldb;
    unsigned voffA, voffB; { int R, C; stage_rc(tid * 16, R, C); const int Rb = Epi::PERM ? ((R & ~31) + perm32(R & 31)) : R;
        voffA = (unsigned)(R * lda + C) * 2u; voffB = (unsigned)(Rb * ldb + C) * 2u; }
    const unsigned skipoffA = (unsigned)(64 * lda * 2), skipoffB = (unsigned)(64 * ldb * 2);
    constexpr unsigned kstep = BK * 2;
    const unsigned hstepA = (unsigned)(HALF * lda * 2), hstepB = (unsigned)(HALF * ldb * 2);
    const unsigned ldsw = (unsigned)wid * 1024u;
    const int aoff = lds_byte(wr * 64 + fr, Epi::FP8 ? fq * 16 : fq * 8), boff = lds_byte(wc * 32 + fr, Epi::FP8 ? fq * 16 : fq * 8);
#define PG8_SA(b, h) (((b) * 2 + (h)) * HTB)
#define PG8_SB(b, h) ((4 + (b) * 2 + (h)) * HTB)
#define PG8_STAGE(bufoff, gbase, voff) do { _Pragma("unroll") for (int _i = 0; _i < 2; ++_i) \
        __builtin_amdgcn_global_load_lds((const unsigned*)((const char*)(gbase) + (_i ? skip##voff : 0u) + (v##voff)), (LAS unsigned*)(lds + (bufoff) + ldsw + _i * 8192), 16, 0, 0); } while (0)
#define PG8_LDA(dst, b, h) do { if constexpr (Epi::FP8) { _Pragma("unroll") for (int m = 0; m < 4; ++m) { const LAS i32x4* p_ = (const LAS i32x4*)(lds + PG8_SA(b, h) + aoff + m * 2048); dst##8[m] = __builtin_shufflevector(p_[0], p_[1], 0, 1, 2, 3, 4, 5, 6, 7); } } \
        else { _Pragma("unroll") for (int m = 0; m < 4; ++m) _Pragma("unroll") for (int k = 0; k < 2; ++k) dst[m][k] = *(const LAS bf16x8*)(lds + PG8_SA(b, h) + aoff + m * 2048 + k * 1024); } } while (0)
#define PG8_LDB(dst, b, h) do { if constexpr (Epi::FP8) { _Pragma("unroll") for (int n = 0; n < 2; ++n) { const LAS i32x4* p_ = (const LAS i32x4*)(lds + PG8_SB(b, h) + boff + n * 2048); dst##8[n] = __builtin_shufflevector(p_[0], p_[1], 0, 1, 2, 3, 4, 5, 6, 7); } } \
        else { _Pragma("unroll") for (int n = 0; n < 2; ++n) _Pragma("unroll") for (int k = 0; k < 2; ++k) dst[n][k] = *(const LAS bf16x8*)(lds + PG8_SB(b, h) + boff + n * 2048 + k * 1024); } } while (0)
#define PG8_MMA(ai, bj, At, Bt) PG8_MMAZ(false, ai, bj, At, Bt)
#define PG8_WAIT_V(n) asm volatile("s_waitcnt vmcnt(" #n ")" ::: "memory")
#define PG8_WAIT_L(n) asm volatile("s_waitcnt lgkmcnt(" #n ")" ::: "memory")
#define PG8_BAR __builtin_amdgcn_s_barrier()
#define PG8_SCHED __builtin_amdgcn_sched_barrier(0)
#define PG8_MMAZ(Z, ai, bj, At, Bt) do { __builtin_amdgcn_s_setprio(1); \
        if constexpr (Epi::FP8) { _Pragma("unroll") for (int m = 0; m < 4; ++m) _Pragma("unroll") for (int n = 0; n < 2; ++n) \
            acc[ai][bj][m][n] = __builtin_amdgcn_mfma_scale_f32_16x16x128_f8f6f4(Bt##8[n], At##8[m], (Z) ? (f32x4){0.f, 0.f, 0.f, 0.f} : acc[ai][bj][m][n], 0, 0, 0, FP8_WSCALE, 0, 0x7f7f7f7f); } \
        else { _Pragma("unroll") for (int m = 0; m < 4; ++m) _Pragma("unroll") for (int n = 0; n < 2; ++n) _Pragma("unroll") for (int k = 0; k < 2; ++k) \
            acc[ai][bj][m][n] = __builtin_amdgcn_mfma_f32_16x16x32_bf16(Bt[n][k], At[m][k], ((Z) && k == 0) ? (f32x4){0.f, 0.f, 0.f, 0.f} : acc[ai][bj][m][n], 0, 0, 0); } \
        __builtin_amdgcn_s_setprio(0); } while (0)
#define PG8_TRIP(FIRST, LAST) do { PG8_SCHED; asm volatile("" : "+v"(voffA), "+v"(voffB));     \
        const char* a1 = cur.a + (unsigned)(t + 1) * kstep; \
        const char* a2 = (LAST) ? nA : cur.a + (unsigned)(t + 2) * kstep; const char* b2 = (LAST) ? nB : cur.b + (unsigned)(t + 2) * kstep; \
        const char* a3 = a2 + kstep; const char* b3 = b2 + kstep; \
        PG8_LDB(B0, 0, 0); PG8_SCHED; PG8_LDA(At, 0, 0); PG8_STAGE(PG8_SA(1, 1), a1 + hstepA, offA); \
        PG8_WAIT_L(8); PG8_BAR; PG8_WAIT_L(0); PG8_MMAZ(FIRST, 0, 0, At, B0); PG8_BAR; PG8_SCHED; \
        PG8_LDB(B1, 0, 1); PG8_STAGE(PG8_SB(0, 0), b2, offB); \
        PG8_BAR; PG8_WAIT_L(0); PG8_MMAZ(FIRST, 0, 1, At, B1); PG8_BAR; \
        PG8_LDA(At, 0, 1); PG8_STAGE(PG8_SA(0, 0), a2, offA); \
        PG8_BAR; PG8_WAIT_L(0); PG8_MMAZ(FIRST, 1, 0, At, B0); PG8_BAR; PG8_SCHED; \
        PG8_STAGE(PG8_SB(0, 1), b2 + hstepB, offB); \
        PG8_WAIT_V(6); PG8_BAR; PG8_MMAZ(FIRST, 1, 1, At, B1); PG8_BAR; \
        PG8_LDB(B0, 1, 0); PG8_SCHED; PG8_LDA(At, 1, 0); PG8_STAGE(PG8_SA(0, 1), a2 + hstepA, offA); \
        PG8_WAIT_L(8); PG8_BAR; PG8_WAIT_L(0); PG8_MMA(0, 0, At, B0); PG8_BAR; PG8_SCHED; \
        PG8_LDB(B1, 1, 1); PG8_STAGE(PG8_SB(1, 0), b3, offB); \
        PG8_BAR; PG8_WAIT_L(0); PG8_MMA(0, 1, At, B1); if constexpr (Epi::QUAD && (LAST)) { const int l_ = hw_lane(); E.template quad<0, 0>(acc, cur, wr, wc, l_ & 15, l_ >> 4); }; PG8_BAR; \
        PG8_LDA(At, 1, 1); PG8_STAGE(PG8_SA(1, 0), a3, offA); \
        PG8_BAR; PG8_WAIT_L(0); PG8_MMA(1, 0, At, B0); if constexpr (Epi::QUAD && (LAST)) { const int l_ = hw_lane(); E.template quad<0, 1>(acc, cur, wr, wc, l_ & 15, l_ >> 4); }; PG8_BAR; PG8_SCHED; \
        PG8_STAGE(PG8_SB(1, 1), b3 + hstepB, offB); \
        if constexpr (Epi::QUAD && (LAST)) PG8_WAIT_V(14); else PG8_WAIT_V(6); \
        PG8_BAR; PG8_MMA(1, 1, At, B1); if constexpr (Epi::QUAD && (LAST)) { const int l_ = hw_lane(); E.template quad<1, 0>(acc, cur, wr, wc, l_ & 15, l_ >> 4); }; PG8_BAR; PG8_SCHED; \
    } while (0)
    Unit cur, nxt; int ui = 0;
    if (!S.next(0, cur)) return;
    f32x4 acc[2][2][4][2];
    bf16x8 At[4][2], B0[2][2], B1[2][2];
    i32x8 At8[4], B08[2], B18[2];
    PG8_STAGE(PG8_SB(0, 0), cur.b, offB); PG8_STAGE(PG8_SA(0, 0), cur.a, offA); PG8_STAGE(PG8_SB(0, 1), cur.b + hstepB, offB); PG8_STAGE(PG8_SA(0, 1), cur.a + hstepA, offA);
    if (wr == 1) PG8_BAR;
    PG8_WAIT_V(4); PG8_BAR;
    PG8_STAGE(PG8_SB(1, 0), cur.b + kstep, offB); PG8_STAGE(PG8_SA(1, 0), cur.a + kstep, offA); PG8_STAGE(PG8_SB(1, 1), cur.b + hstepB + kstep, offB);
    PG8_WAIT_V(6); PG8_BAR;
    for (;;) {
        const bool has_next = S.next(ui + 1, nxt);
        const char* nA = has_next ? nxt.a : cur.a; const char* nB = has_next ? nxt.b : cur.b;
        if constexpr (Epi::QUAD) { { const int t = 0; PG8_TRIP(true, false); }
            for (int t = 2; t < nt - 2; t += 2) PG8_TRIP(false, false);
            { const int t = nt - 2; PG8_TRIP(false, true); } }
        else {
#pragma unroll
            for (int i_ = 0; i_ < 32; ++i_) (&acc[0][0][0][0])[i_] = (f32x4){0.f, 0.f, 0.f, 0.f};
#pragma unroll 1
            for (int t = 0; t < nt; t += 2) { const bool last_ = t == nt - 2; PG8_TRIP(false, last_); } }
        { const int l_ = hw_lane(); if constexpr (Epi::QUAD) E.template quad<1, 1>(acc, cur, wr, wc, l_ & 15, l_ >> 4); else E(acc, cur, wr, wc, l_ & 15, l_ >> 4); }
        if (!has_next) break;
        cur = nxt; ++ui;
    }
    PG8_WAIT_V(0);
    if (wr == 0) PG8_BAR;
    PG8_BAR;
#undef PG8_SA
#undef PG8_SB
#undef PG8_STAGE
#undef PG8_LDA
#undef PG8_LDB
#undef PG8_MMA
#undef PG8_MMAZ
#undef PG8_TRIP
#undef PG8_WAIT_V
#undef PG8_WAIT_L
#undef PG8_BAR
#undef PG8_SCHED
}
}

struct Frame { LAS unsigned char* lds; int tid, lane, wave, G, bid; const Params* P; };
struct PView {
    const Params* p; unsigned char* ws; unsigned char* big; float* out;
    __device__ __forceinline__ const float* in(int k) const { return p->in[k]; }
};
__device__ __forceinline__ PView pview(const Frame& F) { PView v; v.p = F.P; v.out = F.P->out; v.ws = F.P->ws; v.big = v.ws + WS_BIG; return v; }
__device__ __forceinline__ Frame uniform_frame(Frame F) {
    int wv = F.wave, g = F.G, b = F.bid; unsigned lb = (unsigned)(size_t)F.lds;
    asm volatile("" : "+s"(wv), "+s"(g), "+s"(b), "+s"(lb));
    int t = wv * 64 + hw_lane(); asm volatile("" : "+v"(t));
    F.tid = t; F.lane = t & 63; F.wave = wv; F.G = g; F.bid = b; F.lds = (LAS unsigned char*)(size_t)lb; return F; }
#define RFL(x) __builtin_amdgcn_readfirstlane(x)
__device__ __forceinline__ Frame unit_frame(Frame F) { int t = F.tid; asm volatile("" : "+v"(t)); F.tid = t; F.lane = t & 63; return F; }

__device__ __forceinline__ void mod_unit(const Frame& F, const PView& V, int l, int nt) {
    LAS float* sc = (LAS float*)F.lds; LAS float* red = sc + 5 * 1024;
    const float* c = V.in(1); const float* cc = V.in(3);
    __syncthreads();
    for (int i = F.tid; i < 5 * 1024; i += 512) { const float v = i < 4096 ? c[i] : cc[i - 4096]; sc[i] = siluf_(v); }
    __syncthreads();
    const int nl = F.tid & 63, kg = F.tid >> 6, n = nt * 64 + nl;
    const float* w = V.in(4) + (size_t)l * 1024 * 6144 + n;
    float a0 = 0.f, a1 = 0.f, a2 = 0.f, a3 = 0.f, a4 = 0.f;
#pragma unroll 1
    for (int k0 = kg * 128; k0 < kg * 128 + 128; k0 += 32) { float wv[32];
#pragma unroll
        for (int i = 0; i < 32; ++i) wv[i] = w[(size_t)(k0 + i) * 6144];
#pragma unroll
        for (int i = 0; i < 32; ++i) { const int k = k0 + i; a0 += sc[k] * wv[i]; a1 += sc[1024 + k] * wv[i]; a2 += sc[2048 + k] * wv[i]; a3 += sc[3072 + k] * wv[i]; a4 += sc[4096 + k] * wv[i]; } }
    red[(kg * 5 + 0) * 64 + nl] = a0; red[(kg * 5 + 1) * 64 + nl] = a1; red[(kg * 5 + 2) * 64 + nl] = a2; red[(kg * 5 + 3) * 64 + nl] = a3; red[(kg * 5 + 4) * 64 + nl] = a4;
    __syncthreads();
    if (F.tid < 320) { const int bi = F.tid >> 6; float s = 0.f;
#pragma unroll
        for (int g = 0; g < 8; ++g) s += red[(g * 5 + bi) * 64 + nl];
        float* mod = (float*)(V.ws + WS_MOD);
        mod[((size_t)l * 5 + bi) * 6144 + n] = s + V.in(5)[(size_t)l * 6144 + n]; }
}
__device__ __forceinline__ void rope_table(const Frame& F, const PView& V) {
    float* rt = (float*)(V.ws + WS_ROPE);
    for (int i = F.tid; i < 128 * 16; i += 512) { const int pos = i >> 4, f = i & 15;
        const float inv = powf(10000.0f, -(float)f / 16.0f); const float ang = (float)pos * inv;
        rt[2 * i] = cosf(ang); rt[2 * i + 1] = sinf(ang); }
}
__device__ __forceinline__ int srcmap(int kind, int n) {
    switch (kind) {
        case 0: return n < 2048 ? n : (n < 2064 ? n : -1);
        case 1: return 2064 + n;
        case 2: { const int dt = n >> 8, c = n & 255, bj = c >> 7, wc = (c >> 5) & 3, nn = (c >> 4) & 1, fq = (c >> 2) & 3, j = c & 3;
                  return 4880 + (2 * bj + nn) * 1024 + dt * 64 + wc * 16 + fq * 4 + j; }
        case 3: return n;
        default: { const int pt = n >> 8, c = n & 255; return (c >> 7) * 2816 + pt * 128 + (c & 127); }
    }
}
struct TileDesc { const float* src; bf16_t* dst; int ldsrc, K, n0, k0, kind; };
__device__ __forceinline__ void convert_tiles4(const Frame& F, const TileDesc (&td)[4], int ntiles) {
    LAS float* tile = (LAS float*)F.lds;
    const int nn = F.tid & 63, kq = F.tid >> 6; float v[4][8];
#pragma unroll
    for (int q = 0; q < 4; ++q) { const int sc = q < ntiles ? srcmap(td[q].kind, td[q].n0 + nn) : -1;
#pragma unroll
        for (int i = 0; i < 8; ++i) { const int kk = kq * 8 + i; v[q][i] = sc >= 0 ? td[q].src[(size_t)(td[q].k0 + kk) * td[q].ldsrc + sc] : 0.f; }
        if (td[q].kind == 2) {
#pragma unroll
            for (int i = 0; i < 8; ++i) v[q][i] *= -1.4426950408889634f * 32.0f; } }
    __syncthreads();
#pragma unroll
    for (int q = 0; q < 4; ++q)
#pragma unroll
        for (int i = 0; i < 8; ++i) tile[q * 4160 + (kq * 8 + i) * 65 + nn] = v[q][i];
    __syncthreads();
    const int n2 = F.tid >> 3, k8 = (F.tid & 7) * 8;
#pragma unroll
    for (int q = 0; q < 4; ++q) if (q < ntiles) { float f[8];
#pragma unroll
        for (int i = 0; i < 8; ++i) f[i] = tile[q * 4160 + (k8 + i) * 65 + n2];
        if (td[q].kind == 2) *(u32x2*)((unsigned char*)td[q].dst + (size_t)(td[q].n0 + n2) * td[q].K + td[q].k0 + k8) = pack8_fp8(f);
        else *(u32x4*)(td[q].dst + (size_t)(td[q].n0 + n2) * td[q].K + td[q].k0 + k8) = pack8(f); }
}
__device__ __forceinline__ void weff_unit(const Frame& F, const PView& V, int l, int g, int et) {
    LAS float* pw = (LAS float*)F.lds; LAS float* sw = pw + 128 * 129;
    const float* poolw = V.in(10) + ((size_t)l * 4 + g) * 128 * 128; const float* scale = V.in(11) + (size_t)l * 512 + g * 128;
    const float* wb1 = V.in(14) + (((size_t)l * 4 + 1) * 512 + g * 128) * 1024 + et * 64;
    __syncthreads();
    for (int i = F.tid; i < 128 * 128; i += 512) pw[(i >> 7) * 129 + (i & 127)] = poolw[i];
    for (int i = F.tid; i < 128 * 64; i += 512) { const int d = i >> 6, e = i & 63; sw[d * 65 + e] = scale[d] * wb1[(size_t)d * 1024 + e]; }
    __syncthreads();
    const int el = F.tid & 63, cg = F.tid >> 6; float acc[16];
#pragma unroll
    for (int i = 0; i < 16; ++i) acc[i] = 0.f;
    for (int d = 0; d < 128; ++d) { const float s = sw[d * 65 + el];
#pragma unroll
        for (int i = 0; i < 16; ++i) acc[i] += pw[(cg * 16 + i) * 129 + d] * s; }
    bf16_t* dst = (bf16_t*)(V.ws + W_B) + ((size_t)1024 + et * 64 + el) * 512 + g * 128 + cg * 16;
    float f0[8], f1[8];
#pragma unroll
    for (int i = 0; i < 8; ++i) { f0[i] = acc[i]; f1[i] = acc[8 + i]; }
    *(u32x4*)dst = pack8(f0); *(u32x4*)(dst + 8) = pack8(f1);
}
__device__ __forceinline__ TileDesc tile_desc(const PView& V, int l, int t) {
    unsigned char* ws = V.ws; const float* w_in = V.in(7) + (size_t)l * 1024 * INW; TileDesc d;
    const int T0 = 36 * 16, T1 = T0 + 44 * 16, T2 = T1 + 64 * 16, T3 = T2 + 3 * 16 * 8, T4 = T3 + 16 * 16, T5 = T4 + 88 * 16;
    if (t < T0) { d.src = w_in; d.ldsrc = INW; d.K = 1024; d.dst = (bf16_t*)(ws + W_LSTM); d.n0 = (t / 16) * 64; d.k0 = (t % 16) * 64; d.kind = 0; }
    else if (t < T1) { const int q = t - T0; d.src = w_in; d.ldsrc = INW; d.K = 1024; d.dst = (bf16_t*)(ws + W_REST); d.n0 = (q / 16) * 64; d.k0 = (q % 16) * 64; d.kind = 1; }
    else if (t < T2) { const int q = t - T1; d.src = w_in; d.ldsrc = INW; d.K = 1024; d.dst = (bf16_t*)(ws + W_GATE); d.n0 = (q / 16) * 64; d.k0 = (q % 16) * 64; d.kind = 2; }
    else if (t < T3) { const int q = t - T2, bi = q / 128, r = q % 128; const int nb = bi == 0 ? 0 : bi + 1;
        d.src = V.in(14) + ((size_t)l * 4 + nb) * 512 * 1024; d.ldsrc = 1024; d.K = 512; d.dst = (bf16_t*)(ws + W_B) + (size_t)nb * 1024 * 512; d.n0 = (r / 8) * 64; d.k0 = (r % 8) * 64; d.kind = 3; }
    else if (t < T4) { const int q = t - T3; d.src = V.in(15) + (size_t)l * 1024 * 1024; d.ldsrc = 1024; d.K = 1024; d.dst = (bf16_t*)(ws + W_O); d.n0 = (q / 16) * 64; d.k0 = (q % 16) * 64; d.kind = 3; }
    else if (t < T5) { const int q = t - T4; d.src = V.in(16) + (size_t)l * 1024 * 5632; d.ldsrc = 5632; d.K = 1024; d.dst = (bf16_t*)(ws + W_UP); d.n0 = (q / 16) * 64; d.k0 = (q % 16) * 64; d.kind = 4; }
    else { const int q = t - T5; d.src = V.in(18) + (size_t)l * DFF * 1024; d.ldsrc = 1024; d.K = DFF; d.dst = (bf16_t*)(ws + W_DN); d.n0 = (q / 44) * 64; d.k0 = (q % 44) * 64; d.kind = 3; }
    return d;
}
__device__ __forceinline__ void prep_weights(const Frame& F, const PView& V, int l, int t0, int t1, int wid, int nw, bool with_weff) {
#pragma unroll 1
    for (int t = t0 + wid; t < t1; t += 4 * nw) { TileDesc td[4]; int nt = 0;
#pragma unroll
        for (int q = 0; q < 4; ++q) { const int tq = t + q * nw; td[q] = tile_desc(V, l, tq < t1 ? tq : t); nt += tq < t1 ? 1 : 0; }
        convert_tiles4(F, td, nt); }
    if (with_weff) for (int q = wid; q < 64; q += nw) weff_unit(F, V, l, q >> 4, q & 15);
}
constexpr int PREP_T0 = 36 * 16, PREP_T1 = PREP_T0 + 44 * 16, PREP_T2 = PREP_T1 + 64 * 16, PREP_T3 = PREP_T2 + 3 * 16 * 8, PREP_T4 = PREP_T3 + 16 * 16, PREP_T5 = PREP_T4 + 88 * 16, PREP_NT = PREP_T5 + 16 * 44;
__device__ __forceinline__ void tail_prep(const Frame& F, const PView& V, int l, int units, int t0, int t1, int u0, int u1, bool with_weff) {
    const int nbusy = units % F.G;
    int wid = F.bid, nw = F.G;
    if (nbusy > 0) { if (F.bid < nbusy) return; wid = F.bid - nbusy; nw = F.G - nbusy; }
    prep_weights(F, V, l, t0, t1, wid, nw, with_weff);
    if (u1 > u0) prep_weights(F, V, l, u0, u1, wid, nw, false);
}

__device__ __forceinline__ void rows_phase(const Frame& F, const PView& V, int Mrows, const void* xsl, bool src_f32, const float* xsc, void* xdl, bool dst_f32, float* xdc, const bf16_t* y, const float* gpost, const float* modcur, int kgate,
                           bool has_next, const float* gpre, const float* modnext, int kshift, int kscale, bf16_t* U, int wg, int nwg, int pass_lo, int pass_hi, const bf16_t* y2 = nullptr, unsigned char* U8 = nullptr) {
    const int lane = F.lane; const int wv = wg * 8 + F.wave, nwv = nwg * 8;
#pragma unroll 1
    for (int pass = pass_lo; pass < pass_hi; ++pass) {
        const int per = nwv >> 2; const int bi = pass == 0 ? wv / per : 4;
        int r = pass == 0 ? bi * SEQ + (wv % per) : ML + wv; const int rstep = pass == 0 ? per : nwv; const int rend = pass == 0 ? (bi + 1) * SEQ : Mrows;
        if (pass == 0 && bi > 3) continue;
        if (r >= rend) continue;
        float cA[16], cB[16], cC[16];
#pragma unroll
        for (int i = 0; i < 2; ++i)
#pragma unroll
            for (int j = 0; j < 8; ++j) { const int c = 512 * i + 8 * lane + j; cA[8 * i + j] = 0.f; cB[8 * i + j] = 0.f; cC[8 * i + j] = 0.f;
                if (y) cA[8 * i + j] = modcur[(size_t)bi * 6144 + kgate * 1024 + c] * gpost[c];
                if (has_next) { cB[8 * i + j] = gpre[c] * (1.0f + modnext[(size_t)bi * 6144 + kscale * 1024 + c]); cC[8 * i + j] = modnext[(size_t)bi * 6144 + kshift * 1024 + c]; } }
        const bool lat = pass == 0, sf = !lat || src_f32, df = !lat || dst_f32;
#define ROWS_LOAD(rr, XR, YR) do { \
            if (sf) { const float* _xs = lat ? (const float*)xsl + (size_t)(rr) * 1024 : xsc + (size_t)((rr) - ML) * 1024; \
                XR[0] = *(const u32x4*)(_xs + 8 * lane); XR[1] = *(const u32x4*)(_xs + 8 * lane + 4); XR[2] = *(const u32x4*)(_xs + 512 + 8 * lane); XR[3] = *(const u32x4*)(_xs + 512 + 8 * lane + 4); } \
            else { const bf16_t* _xs = (const bf16_t*)xsl + (size_t)(rr) * 1024; XR[0] = ldg16(_xs + 8 * lane); XR[1] = ldg16(_xs + 512 + 8 * lane); XR[2] = XR[0]; XR[3] = XR[0]; } \
            if (y) { YR[0] = ldg16(y + (size_t)(rr) * 1024 + 8 * lane); YR[1] = ldg16(y + (size_t)(rr) * 1024 + 512 + 8 * lane); } else { YR[0] = XR[0]; YR[1] = XR[0]; } \
            if (y2 && !lat) { YR[2] = ldg16(y2 + (size_t)((rr) - ML) * 1024 + 8 * lane); YR[3] = ldg16(y2 + (size_t)((rr) - ML) * 1024 + 512 + 8 * lane); } else { YR[2] = YR[0]; YR[3] = YR[0]; } } while (0)
        u32x4 xc[4], yc[4]; ROWS_LOAD(r, xc, yc);
#pragma unroll 1
        for (; r < rend; r += rstep) {
            u32x4 xn[4], yn[4]; { const int rn = r + rstep < rend ? r + rstep : r; ROWS_LOAD(rn, xn, yn); }
            float xv[16];
            if (sf) {
#pragma unroll
                for (int i = 0; i < 4; ++i) { xv[4 * i] = __uint_as_float(xc[i].x); xv[4 * i + 1] = __uint_as_float(xc[i].y); xv[4 * i + 2] = __uint_as_float(xc[i].z); xv[4 * i + 3] = __uint_as_float(xc[i].w); } }
            else {
#pragma unroll
                for (int i = 0; i < 2; ++i) { float f[8]; unpack8(xc[i], f);
#pragma unroll
                    for (int j = 0; j < 8; ++j) xv[8 * i + j] = f[j]; } }
            if (y) {
                float yv[16]; float ss = 0.f;
#pragma unroll
                for (int i = 0; i < 2; ++i) { float f[8]; unpack8(yc[i], f);
                    if (y2 && !lat) { float g[8]; unpack8(yc[2 + i], g);
#pragma unroll
                        for (int j = 0; j < 8; ++j) f[j] += g[j]; }
#pragma unroll
                    for (int j = 0; j < 8; ++j) { yv[8 * i + j] = f[j]; ss += f[j] * f[j]; } }
                ss = wave_sum(ss, lane); const float rs = rsqrtf(ss * (1.0f / 1024.0f) + EPS);
#pragma unroll
                for (int i = 0; i < 16; ++i) xv[i] += cA[i] * (yv[i] * rs);
            }
            if (df) { float* xd = lat ? (float*)xdl + (size_t)r * 1024 : xdc + (size_t)(r - ML) * 1024;
#pragma unroll
                for (int i = 0; i < 2; ++i) { const int c0 = 512 * i + 8 * lane;
                    *(f32x4*)(xd + c0) = (f32x4){xv[8 * i], xv[8 * i + 1], xv[8 * i + 2], xv[8 * i + 3]}; *(f32x4*)(xd + c0 + 4) = (f32x4){xv[8 * i + 4], xv[8 * i + 5], xv[8 * i + 6], xv[8 * i + 7]}; } }
            else { bf16_t* xd = (bf16_t*)xdl + (size_t)r * 1024;
#pragma unroll
                for (int i = 0; i < 2; ++i) { float f[8];
#pragma unroll
                    for (int j = 0; j < 8; ++j) f[j] = xv[8 * i + j];
                    *(u32x4*)(xd + 512 * i + 8 * lane) = pack8(f); } }
            if (has_next) {
                float ss = 0.f;
#pragma unroll
                for (int i = 0; i < 16; ++i) ss += xv[i] * xv[i];
                ss = wave_sum(ss, lane); const float rs = rsqrtf(ss * (1.0f / 1024.0f) + EPS);
#pragma unroll
                for (int i = 0; i < 2; ++i) { float f[8];
#pragma unroll
                    for (int j = 0; j < 8; ++j) f[j] = (xv[8 * i + j] * rs) * cB[8 * i + j] + cC[8 * i + j];
                    *(u32x4*)(U + (size_t)r * 1024 + 512 * i + 8 * lane) = pack8(f);
                    if (U8) *(u32x2*)(U8 + (size_t)r * 1024 + 512 * i + 8 * lane) = pack8_fp8(f); }
            }
#pragma unroll
            for (int i = 0; i < 4; ++i) xc[i] = xn[i];
            yc[0] = yn[0]; yc[1] = yn[1]; yc[2] = yn[2]; yc[3] = yn[3];
        }
#undef ROWS_LOAD
    }
}

__device__ __forceinline__ int blk_rowbase(int b, int blk) { return blk == 0 ? ML + b * 256 : b * SEQ + (blk - 1) * 256; }
__device__ __forceinline__ float scan256(LAS float* ws, float v, int tid, bool suffix) {
    const int lane = tid & 63, w = tid >> 6; float x = v;
    if (!suffix) {
#pragma unroll
        for (int o = 1; o < 64; o <<= 1) { const float yv = lshfl(x, (lane - o) & 63); if (lane >= o) x += yv; }
    } else {
#pragma unroll
        for (int o = 1; o < 64; o <<= 1) { const float yv = lshfl(x, (lane + o) & 63); if (lane + o < 64) x += yv; }
    }
    __syncthreads();
    if (w < 4 && lane == (suffix ? 0 : 63)) ws[w] = x;
    __syncthreads();
    if (w < 4) {
        if (!suffix) { for (int j = 0; j < w; ++j) x += ws[j]; }
        else { for (int j = w + 1; j < 4; ++j) x += ws[j]; }
    }
    return x;
}
__device__ __forceinline__ void conv_silu8(const u32x4 pv, const u32x4 cv, const u32x4 nv, const LAS float* w0, const LAS float* w1, const LAS float* w2, float scale, float (&o)[8]) {
    float p[8], c[8], n[8]; unpack8(pv, p); unpack8(cv, c); unpack8(nv, n);
#pragma unroll
    for (int i = 0; i < 8; ++i) { const float yv = p[i] * w0[i] + c[i] * w1[i] + n[i] * w2[i]; o[i] = siluf_(yv) * scale; }
}

__device__ __forceinline__ void lstm_pass1_unit(const Frame& F, const PView& V, int l, int ub) {
    const int tid = F.tid, lane = F.lane, w = F.wave, r = lane & 15, quad = lane >> 4;
    const int blk = ub % NBLK, h = (ub / NBLK) & 3, b = ub / (4 * NBLK);
    const int uf = ((b * 4 + h) * 2 + 0) * NBLK + blk, ubk = uf + NBLK;
    const int rowbase = blk_rowbase(b, blk); const bool seq_first = blk <= 1, seq_last = (blk == 0 || blk == 32);
    const bf16_t* PL = (const bf16_t*)(V.big + B_PLSTM);
    LAS float* wgt = (LAS float*)F.lds;
    LAS float* sws = wgt + 512;
    LAS float* cw = wgt + 528;
    LAS bf16_t* Kt = (LAS bf16_t*)(F.lds + 4096);
    LAS bf16_t* Vt = (LAS bf16_t*)(F.lds + 4096 + 128 * 264 * 2);
#define P1_LOAD(hb_, CV, PV, NV, VV) do { _Pragma("unroll") for (int it = 0; it < 2; ++it) { const int pt = ((hb_) * 2 + it) * 512 + tid, chunk = pt >> 7, tp = pt & 127; \
        _Pragma("unroll") for (int e = 0; e < 2; ++e) { const int tau = 2 * tp + e; const int row = rowbase + tau; \
            const bf16_t* kp = PL + (size_t)row * NLSTM + 512 + h * 128 + chunk * 8; \
            CV[it][e] = ldg16(kp); PV[it][e] = (u32x4){0u, 0u, 0u, 0u}; NV[it][e] = PV[it][e]; \
            if (!(seq_first && tau == 0)) PV[it][e] = ldg16(kp - NLSTM); \
            if (!(seq_last && tau == 255)) NV[it][e] = ldg16(kp + NLSTM); \
            VV[it][e] = ldg16(PL + (size_t)row * NLSTM + 1024 + h * 128 + chunk * 8); } } } while (0)
#define P1_STORE(hb_, CV, PV, NV, VV) do { _Pragma("unroll")         for (int it = 0; it < 2; ++it) { const int pt = ((hb_) * 2 + it) * 512 + tid, CH = pt >> 7, tp = pt & 127, kc2 = 2 * tp; \
            float o0[8], o1[8]; \
            conv_silu8(PV[it][0], CV[it][0], NV[it][0], cw + CH * 8, cw + 128 + CH * 8, cw + 256 + CH * 8, 0.08838834764831845f, o0); \
            conv_silu8(PV[it][1], CV[it][1], NV[it][1], cw + CH * 8, cw + 128 + CH * 8, cw + 256 + CH * 8, 0.08838834764831845f, o1); \
_Pragma("unroll")             for (int i = 0; i < 8; ++i) *(LAS unsigned*)(Kt + (CH * 8 + i) * 264 + kc2) = pk2(o0[i], o1[i]); \
            const u32x4 va = VV[it][0], vb = VV[it][1]; \
            *(LAS unsigned*)(Vt + ((CH) * 8 + 0) * 264 + kc2) = (va.x & 0xffffu) | (vb.x << 16); *(LAS unsigned*)(Vt + ((CH) * 8 + 1) * 264 + kc2) = (va.x >> 16) | (vb.x & 0xffff0000u); *(LAS unsigned*)(Vt + ((CH) * 8 + 2) * 264 + kc2) = (va.y & 0xffffu) | (vb.y << 16); *(LAS unsigned*)(Vt + ((CH) * 8 + 3) * 264 + kc2) = (va.y >> 16) | (vb.y & 0xffff0000u); *(LAS unsigned*)(Vt + ((CH) * 8 + 4) * 264 + kc2) = (va.z & 0xffffu) | (vb.z << 16); *(LAS unsigned*)(Vt + ((CH) * 8 + 5) * 264 + kc2) = (va.z >> 16) | (vb.z & 0xffff0000u); *(LAS unsigned*)(Vt + ((CH) * 8 + 6) * 264 + kc2) = (va.w & 0xffffu) | (vb.w << 16); *(LAS unsigned*)(Vt + ((CH) * 8 + 7) * 264 + kc2) = (va.w >> 16) | (vb.w & 0xffff0000u); } } while (0)
    u32x4 c0[2][2], p0[2][2], n0[2][2], v0[2][2]; P1_LOAD(0, c0, p0, n0, v0);
    __syncthreads();
    if (tid < 384) cw[tid] = V.in(8)[(size_t)l * 3072 + (tid >> 7) * 1024 + 512 + h * 128 + (tid & 127)];
    float gif = 0.f, gib = 0.f, lff = 0.f, lfb = 0.f;
    if (tid < 256) { const bf16_t* gp = PL + (size_t)(rowbase + tid) * NLSTM + 2048; const float* gb = V.in(9) + (size_t)l * 16;
        gif = bf2f(gp[h]) + gb[h]; gib = bf2f(gp[4 + h]) + gb[4 + h]; lff = logsigmoidf_(bf2f(gp[8 + h]) + gb[8 + h]); lfb = logsigmoidf_(bf2f(gp[12 + h]) + gb[12 + h]); }
    const float cif = scan256(sws, lff, tid, false);
    const float cib = scan256(sws + 4, lfb, tid, false);
    __syncthreads();
    if (tid == 255) { sws[8] = cif; sws[9] = cib; }
    __syncthreads();
    const float totf = sws[8], totb = sws[9];
    if (tid < 256) { wgt[tid] = __expf(totf - cif + gif); wgt[256 + tid] = __expf(cib - lfb + gib);
        float* gt = (float*)(V.big + B_GT); gt[(size_t)uf * 512 + tid] = cif; gt[(size_t)uf * 512 + 256 + tid] = gif;
        gt[(size_t)ubk * 512 + tid] = totb - cib + lfb; gt[(size_t)ubk * 512 + 256 + tid] = gib; }
    if (tid == 0) { float* dec = (float*)(V.ws + WS_DEC); dec[uf] = __expf(totf); dec[ubk] = __expf(totb); }
    __syncthreads();
    u32x4 c1[2][2], p1[2][2], n1[2][2], v1[2][2]; P1_LOAD(1, c1, p1, n1, v1);
    P1_STORE(0, c0, p0, n0, v0);
    P1_STORE(1, c1, p1, n1, v1);
#undef P1_LOAD
#undef P1_STORE
    __syncthreads();
    bf16x8 af[8];
#pragma unroll
    for (int ks = 0; ks < 8; ++ks) af[ks] = *(const LAS bf16x8*)(Kt + (16 * w + r) * 264 + 32 * ks + 8 * quad);
    const bf16x8 ones = {(short)0x3f80, (short)0x3f80, (short)0x3f80, (short)0x3f80, (short)0x3f80, (short)0x3f80, (short)0x3f80, (short)0x3f80};
    const bf16x8 zeros = {0, 0, 0, 0, 0, 0, 0, 0};
#pragma unroll 1
    for (int dir = 0; dir < 2; ++dir) {
        asm volatile("" ::: "memory");
        bf16x8 ad[8];
#pragma unroll
        for (int ks = 0; ks < 8; ++ks) { const f32x4 w0 = *(const LAS f32x4*)(wgt + dir * 256 + 32 * ks + 8 * quad), w1 = *(const LAS f32x4*)(wgt + dir * 256 + 32 * ks + 8 * quad + 4);
            float f[8]; unpack8(__builtin_bit_cast(u32x4, af[ks]), f);
            f[0] *= w0[0]; f[1] *= w0[1]; f[2] *= w0[2]; f[3] *= w0[3]; f[4] *= w1[0]; f[5] *= w1[1]; f[6] *= w1[2]; f[7] *= w1[3];
            ad[ks] = __builtin_bit_cast(bf16x8, pack8(f)); }
        bf16_t* st = (bf16_t*)(V.big + B_ST) + (size_t)(dir == 0 ? uf : ubk) * ST_ELEMS;
        u32x2 pwe = {0u, 0u};
#pragma unroll
        for (int db = 0; db < 9; ++db) { f32x4 acc = {0.f, 0.f, 0.f, 0.f};
#pragma unroll
            for (int ks = 0; ks < 8; ++ks) { bf16x8 bfr;
                if (db < 8) bfr = *(const LAS bf16x8*)(Vt + (16 * db + r) * 264 + 32 * ks + 8 * quad); else bfr = (r == 0) ? ones : zeros;
                acc = MFMA16(ad[ks], bfr, acc); }
            u32x2 pw; pw.x = pk2(acc[0], acc[1]); pw.y = pk2(acc[2], acc[3]);
            if (db < 8) { if ((db & 1) == 0) pwe = pw;
                else { const u32x4 wq = widen16(pwe, pw); const int odd = quad & 1;
                    *(u32x4*)(st + (size_t)(16 * (db - 1 + odd) + r) * 128 + 16 * w + 4 * (quad - odd)) = wq; } }
            else if (r == 0) *(u32x2*)(st + (size_t)128 * 128 + 16 * w + 4 * quad) = pw; }
    }
}
__device__ __forceinline__ void lstm_scan(const Frame& F, const PView& V) {
    bf16_t* ST = (bf16_t*)(V.big + B_ST); const float* DEC = (const float*)(V.ws + WS_DEC);
    const int per = ST_ELEMS / 8;
    for (int gid = F.bid * 512 + F.tid; gid < 32 * per; gid += F.G * 512) {
        const int chain = gid / per, e8 = gid % per, dir = chain & 1; const int ub = chain * NBLK;
        float sv[8];
#pragma unroll
        for (int q = 0; q < 8; ++q) sv[q] = 0.f;
#pragma unroll 1
        for (int g = 0; g < 3; ++g) { u32x4 tmp[11]; float dc[11];
#pragma unroll
            for (int j = 0; j < 11; ++j) { const int i = g * 11 + j; const int blk = (dir == 0 || i == 0) ? i : 33 - i;
                tmp[j] = *(const u32x4*)(ST + (size_t)(ub + blk) * ST_ELEMS + e8 * 8); dc[j] = DEC[ub + blk]; }
#pragma unroll
            for (int j = 0; j < 11; ++j) { const int i = g * 11 + j; const int blk = (dir == 0 || i == 0) ? i : 33 - i;
                *(u32x4*)(ST + (size_t)(ub + blk) * ST_ELEMS + e8 * 8) = pack8(sv); float f[8]; unpack8(tmp[j], f);
#pragma unroll
                for (int q = 0; q < 8; ++q) sv[q] = sv[q] * dc[j] + f[q]; } }
    }
}
__device__ __forceinline__ void lstm_pass2_unit(const Frame& F, const PView& V, int l, int b, int h, int blk, int qh) {
    const int tid = F.tid, lane = F.lane, w = F.wave, r = lane & 15, quad = lane >> 4;
    const int rowbase = blk_rowbase(b, blk); const bool seq_first = blk <= 1, seq_last = (blk == 0 || blk == 32);
    const bf16_t* PL = (const bf16_t*)(V.big + B_PLSTM);
    LAS float* cf = (LAS float*)F.lds; LAS float* cb = cf + 256; LAS float* igf = cf + 512; LAS float* igb = cf + 768;
    LAS float* sws = cf + 1024;
    LAS float* cwq = cf + 1056;
    LAS float* cwk = cwq + 384;
    LAS bf16_t* CTf = (LAS bf16_t*)(F.lds + 7424);
    LAS bf16_t* CTb = (LAS bf16_t*)(F.lds + 42512);
    LAS bf16_t* Kh = (LAS bf16_t*)(F.lds + 77600);
    LAS bf16_t* Vt = (LAS bf16_t*)(F.lds + 112416);
    const int qi = 8 * qh + w, t = 16 * qi + r; const int qrow = rowbase + t;
    __syncthreads();
    float cwq_v = 0.f, cwk_v = 0.f;
    if (tid < 384) { cwq_v = V.in(8)[(size_t)l * 3072 + (tid >> 7) * 1024 + h * 128 + (tid & 127)]; cwk_v = V.in(8)[(size_t)l * 3072 + (tid >> 7) * 1024 + 512 + h * 128 + (tid & 127)]; }
    float cfv = 0.f, cbv = 0.f, gif = 0.f, gib = 0.f;
    if (tid < 256) { const float* gtf = (const float*)(V.big + B_GT) + (size_t)(((b * 4 + h) * 2 + 0) * NBLK + blk) * 512; const float* gtb = gtf + (size_t)NBLK * 512;
        cfv = gtf[tid]; gif = gtf[256 + tid]; cbv = gtb[tid]; gib = gtb[256 + tid]; }
    u32x4 qc[4], qp_[4], qn[4];
#pragma unroll
    for (int ks = 0; ks < 4; ++ks) { const bf16_t* qp = PL + (size_t)qrow * NLSTM + h * 128 + 32 * ks + 8 * quad;
        qc[ks] = ldg16(qp); qp_[ks] = (u32x4){0u, 0u, 0u, 0u}; qn[ks] = qp_[ks];
        if (!(seq_first && t == 0)) qp_[ks] = ldg16(qp - NLSTM);
        if (!(seq_last && t == 255)) qn[ks] = ldg16(qp + NLSTM); }
    u32x2 og[8];
    const bf16_t* sf = (const bf16_t*)(V.big + B_ST) + (size_t)(((b * 4 + h) * 2 + 0) * NBLK + blk) * ST_ELEMS; const bf16_t* sb = sf + (size_t)NBLK * ST_ELEMS;
    const bool carried = blk != 0;
    if (tid < 384) { cwq[tid] = cwq_v; cwk[tid] = cwk_v; }
    if (tid < 256) { cf[tid] = cfv; cb[tid] = cbv; igf[tid] = gif; igb[tid] = gib; }
    __builtin_amdgcn_sched_barrier(0);
    if (carried) { u32x4 fa[5], fc[5];
#pragma unroll
        for (int it = 0; it < 5; ++it) { const int i = tid + 512 * it; fa[it] = (u32x4){0u, 0u, 0u, 0u}; fc[it] = fa[it];
            if (i < ST_ELEMS / 8) { fa[it] = *(const u32x4*)(sf + (size_t)i * 8); fc[it] = *(const u32x4*)(sb + (size_t)i * 8); } }
#pragma unroll
        for (int it = 0; it < 5; ++it) { const int i = tid + 512 * it; if (i < ST_ELEMS / 8) { const int row = i >> 4, c8 = (i & 15) * 8;
            *(LAS u32x4*)(CTf + row * 136 + c8) = fa[it]; *(LAS u32x4*)(CTb + row * 136 + c8) = fc[it]; } } }
    __builtin_amdgcn_sched_barrier(0);
    u32x4 kc[4], kp_[4], kn[4], vv[4];
#define P2_KV_LOAD(kh_) do { _Pragma("unroll") for (int it = 0; it < 4; ++it) { const int task = it * 512 + tid, chunk = task & 15, key = task >> 4, tau = 128 * (kh_) + key; \
        const bf16_t* kp = PL + (size_t)(rowbase + tau) * NLSTM + 512 + h * 128 + chunk * 8; \
        kc[it] = ldg16(kp); kp_[it] = (u32x4){0u, 0u, 0u, 0u}; kn[it] = kp_[it]; \
        if (!(seq_first && tau == 0)) kp_[it] = ldg16(kp - NLSTM); \
        if (!(seq_last && tau == 255)) kn[it] = ldg16(kp + NLSTM); \
        } } while (0)
#define P2_V_LOAD(kh_) do { _Pragma("unroll") for (int it = 0; it < 2; ++it) { const int pt = it * 512 + tid; \
        const bf16_t* vp = PL + (size_t)(rowbase + 128 * (kh_) + 2 * (pt & 63)) * NLSTM + 1024 + h * 128 + (pt >> 6) * 8; vv[2 * it] = ldg16(vp); vv[2 * it + 1] = ldg16(vp + NLSTM); } } while (0)
#define P2_KV_STORE(KD, VD) do { _Pragma("unroll") for (int it = 0; it < 4; ++it) { const int task = it * 512 + tid, chunk = task & 15, key = task >> 4; \
        float o[8]; conv_silu8(kp_[it], kc[it], kn[it], cwk + chunk * 8, cwk + 128 + chunk * 8, cwk + 256 + chunk * 8, 0.08838834764831845f, o); \
        *(LAS u32x4*)((KD) + key * 136 + chunk * 8) = pack8(o); } \
        _Pragma("unroll") for (int it = 0; it < 2; ++it) { const int pt = it * 512 + tid; const int CH = pt >> 6, kc2 = 2 * (pt & 63); LAS bf16_t* vd_ = (VD); const u32x4 va = vv[2 * it], vb = vv[2 * it + 1]; \
        *(LAS unsigned*)(vd_ + ((CH) * 8 + 0) * 136 + kc2) = (va.x & 0xffffu) | (vb.x << 16); \
         *(LAS unsigned*)(vd_ + ((CH) * 8 + 1) * 136 + kc2) = (va.x >> 16) | (vb.x & 0xffff0000u); \
         *(LAS unsigned*)(vd_ + ((CH) * 8 + 2) * 136 + kc2) = (va.y & 0xffffu) | (vb.y << 16); \
         *(LAS unsigned*)(vd_ + ((CH) * 8 + 3) * 136 + kc2) = (va.y >> 16) | (vb.y & 0xffff0000u); \
         *(LAS unsigned*)(vd_ + ((CH) * 8 + 4) * 136 + kc2) = (va.z & 0xffffu) | (vb.z << 16); \
         *(LAS unsigned*)(vd_ + ((CH) * 8 + 5) * 136 + kc2) = (va.z >> 16) | (vb.z & 0xffff0000u); \
         *(LAS unsigned*)(vd_ + ((CH) * 8 + 6) * 136 + kc2) = (va.w & 0xffffu) | (vb.w << 16); \
         *(LAS unsigned*)(vd_ + ((CH) * 8 + 7) * 136 + kc2) = (va.w >> 16) | (vb.w & 0xffff0000u); } } while (0)
    __syncthreads();
    bf16x8 qf[4];
#pragma unroll
    for (int ks = 0; ks < 4; ++ks) { const int c0 = 32 * ks + 8 * quad; float o[8]; conv_silu8(qp_[ks], qc[ks], qn[ks], cwq + c0, cwq + 128 + c0, cwq + 256 + c0, 1.0f, o);
        qf[ks] = __builtin_bit_cast(bf16x8, pack8(o)); }
    __builtin_amdgcn_sched_barrier(0);
    P2_KV_LOAD(0);
    __builtin_amdgcn_sched_barrier(0);
    const bf16x8 ones = {(short)0x3f80, (short)0x3f80, (short)0x3f80, (short)0x3f80, (short)0x3f80, (short)0x3f80, (short)0x3f80, (short)0x3f80};
    const bf16x8 zeros = {0, 0, 0, 0, 0, 0, 0, 0};
    f32x4 accf[9], accb[9];
#pragma unroll
    for (int db = 0; db < 9; ++db) { accf[db] = (f32x4){0.f, 0.f, 0.f, 0.f}; accb[db] = accf[db]; }
    if (carried) { const float ef = __expf(cf[t]), eb = __expf(cb[t]);
#pragma unroll
        for (int db = 0; db < 9; ++db) { f32x4 a = {0.f, 0.f, 0.f, 0.f}, c = {0.f, 0.f, 0.f, 0.f};
#pragma unroll
            for (int ks = 0; ks < 4; ++ks) { bf16x8 xf, xb;
                if (db < 8) { xf = *(const LAS bf16x8*)(CTf + (16 * db + r) * 136 + 32 * ks + 8 * quad); xb = *(const LAS bf16x8*)(CTb + (16 * db + r) * 136 + 32 * ks + 8 * quad); }
                else { xf = zeros; xb = zeros; if (r == 0) { xf = *(const LAS bf16x8*)(CTf + 128 * 136 + 32 * ks + 8 * quad); xb = *(const LAS bf16x8*)(CTb + 128 * 136 + 32 * ks + 8 * quad); } }
                a = MFMA16(xf, qf[ks], a); c = MFMA16(xb, qf[ks], c); }
            accf[db] = a * ef; accb[db] = c * eb; } }
    const float cft = cf[t], cbt = cb[t];
    P2_V_LOAD(0);
    P2_KV_STORE(Kh, Vt);
    __syncthreads();
    P2_KV_LOAD(1); P2_V_LOAD(1);
    P2_KV_STORE(CTf, CTf + 128 * 136);
    __syncthreads();
#pragma unroll 1
    for (int kh = 0; kh < 2; ++kh) {
        const LAS bf16_t* Kc = kh == 0 ? Kh : CTf; const LAS bf16_t* Vc = kh == 0 ? Vt : CTf + 128 * 136;
#pragma unroll
        for (int dir = 0; dir < 2; ++dir) {
            int s0, s1;
            if (dir == 0) { if (kh > qh) continue; s0 = 0; s1 = (kh < qh) ? 4 : (w >> 1) + 1; }
            else { if (kh < qh) continue; s1 = 4; s0 = (kh > qh) ? 0 : (w >> 1); }
            const LAS float* cs = dir == 0 ? cf : cb; const LAS float* gs = dir == 0 ? igf : igb; const float ct = dir == 0 ? cft : cbt;
#pragma unroll 1
            for (int st = s0; st < s1; ++st) {
                f32x4 T0 = {0.f, 0.f, 0.f, 0.f}, T1 = {0.f, 0.f, 0.f, 0.f};
#pragma unroll
                for (int ks = 0; ks < 4; ++ks) { const bf16x8 k0 = *(const LAS bf16x8*)(Kc + (32 * st + r) * 136 + 32 * ks + 8 * quad), k1 = *(const LAS bf16x8*)(Kc + (32 * st + 16 + r) * 136 + 32 * ks + 8 * quad);
                    T0 = MFMA16(k0, qf[ks], T0); T1 = MFMA16(k1, qf[ks], T1); }
                const int sg0 = 128 * kh + 32 * st + 4 * quad;
                const f32x4 c0 = *(const LAS f32x4*)(cs + sg0), c1 = *(const LAS f32x4*)(cs + sg0 + 16), e0 = *(const LAS f32x4*)(gs + sg0), e1 = *(const LAS f32x4*)(gs + sg0 + 16);
                float p[8];
#pragma unroll
                for (int j = 0; j < 4; ++j) { const int sa = sg0 + j, sb = sg0 + 16 + j;
                    const bool va = dir == 0 ? (sa <= t) : (sa >= t), vb = dir == 0 ? (sb <= t) : (sb >= t);
                    const float da = __expf(ct - c0[j] + e0[j]), dbb = __expf(ct - c1[j] + e1[j]);
                    p[j] = va ? T0[j] * da : 0.f; p[4 + j] = vb ? T1[j] * dbb : 0.f; }
                const bf16x8 pf = __builtin_bit_cast(bf16x8, pack8(p));
#pragma unroll
                for (int db = 0; db < 9; ++db) { bf16x8 vf;
                    if (db < 8) { const s16x4 lo = *(const LAS s16x4*)(Vc + (16 * db + r) * 136 + 32 * st + 4 * quad), hi = *(const LAS s16x4*)(Vc + (16 * db + r) * 136 + 32 * st + 16 + 4 * quad);
                        vf = __builtin_shufflevector(lo, hi, 0, 1, 2, 3, 4, 5, 6, 7); }
                    else vf = (r == 0) ? ones : zeros;
                    if (dir == 0) accf[db] = MFMA16(vf, pf, accf[db]); else accb[db] = MFMA16(vf, pf, accb[db]); }
            }
        }
    }
#undef P2_KV_LOAD
#undef P2_V_LOAD
#undef P2_KV_STORE
#pragma unroll
    for (int db = 0; db < 8; ++db) og[db] = *(const u32x2*)(PL + (size_t)qrow * NLSTM + 1536 + h * 128 + 16 * db + 4 * quad);
    const float denf = lshfl(accf[8][0], r), denb = lshfl(accb[8][0], r);
    const float invf = __builtin_amdgcn_rcpf(fmaxf(fabsf(denf), 1.0f)), invb = __builtin_amdgcn_rcpf(fmaxf(fabsf(denb), 1.0f));
    bf16_t* ya = (bf16_t*)(V.big + B_YSA);
    u32x2 wve = {0u, 0u};
#pragma unroll
    for (int db = 0; db < 8; ++db) { const u32x2 ov = og[db];
        const float o0 = lo16(ov.x), o1 = hi16(ov.x), o2 = lo16(ov.y), o3 = hi16(ov.y);
        const f32x4 hv = accf[db] * invf + accb[db] * invb;
        u32x2 wv; wv.x = pk2(sigmoidf_(o0) * hv[0], sigmoidf_(o1) * hv[1]); wv.y = pk2(sigmoidf_(o2) * hv[2], sigmoidf_(o3) * hv[3]);
        if ((db & 1) == 0) wve = wv;
        else { const u32x4 wq = widen16(wve, wv); const int odd = quad & 1;
            *(u32x4*)(ya + (size_t)qrow * 512 + h * 128 + 16 * (db - 1 + odd) + 4 * (quad - odd)) = wq; } }
}

__device__ __forceinline__ void krope_tasks(const Frame& F, const PView& V) {
    bf16_t* PR = (bf16_t*)(V.big + B_PREST); const float* rt = (const float*)(V.ws + WS_ROPE);
#pragma unroll 1
    for (int t = F.bid * 512 + F.tid; t < ML * 8; t += F.G * 512) { const int sfh = t & 1, sa = (t >> 1) & 1, g = (t >> 2) & 1, row = t >> 3, kpos = row & (SEQ - 1);
        bf16_t* kp = PR + (size_t)row * NREST + PR_AK + g * 64 + sa * 32 + sfh * 8;
        float x1[8], x2[8], o1[8], o2[8]; unpack8(ldg16(kp), x1); unpack8(ldg16(kp + 16), x2);
        const int pos = sa == 0 ? (kpos >> 6) : (kpos & 63); const float* rp = rt + (pos * 16 + sfh * 8) * 2;
#pragma unroll
        for (int j = 0; j < 8; ++j) { const float c = rp[2 * j], sn = rp[2 * j + 1]; o1[j] = x1[j] * c - x2[j] * sn; o2[j] = x1[j] * sn + x2[j] * c; }
        *(u32x4*)kp = pack8(o1); *(u32x4*)(kp + 16) = pack8(o2); }
}
__device__ __forceinline__ void attn_unit(const Frame& F, const PView& V, int l, bool isctx, int b, int g, int qs) {
    const int tid = F.tid, lane = F.lane, w = F.wave, r = lane & 15, quad = lane >> 4;
    const bf16_t* PR = (const bf16_t*)(V.big + B_PREST); const LAS float* ropel = (const LAS float*)(F.lds + 36864);
    LAS bf16_t* Ks = (LAS bf16_t*)F.lds;
    LAS bf16_t* Vt = (LAS bf16_t*)(F.lds + 18432);
    const int head = g * 4 + (w >> 1), qhalf = w & 1;
    const int qrow0 = isctx ? ML + b * 256 + qs * 64 : b * SEQ + qs * 64;
    const float sink = V.in(12)[l * 8 + head];
    const int qb = qs >> 1;
    const int skey = tid >> 2, sa = (tid >> 1) & 1, sfh = tid & 1;
    u32x4 pk1, pk2v, pv0, pv1;
#define ATT_LOAD(tl) do { const int _kr = (tl) < 2 ? ML + b * 256 + (tl) * 128 : b * SEQ + (qb + (tl) - 3) * 128; \
        const bf16_t* _kp = PR + (size_t)(_kr + skey) * NREST + PR_AK + g * 64 + sa * 32 + sfh * 8; pk1 = ldg16(_kp); pk2v = ldg16(_kp + 16); \
        const bf16_t* _vp = PR + (size_t)(_kr + 2 * (tid & 63)) * NREST + PR_AV + g * 64 + (tid >> 6) * 8; pv0 = ldg16(_vp); pv1 = ldg16(_vp + NREST); } while (0)
    ATT_LOAD(0);
    bf16x8 qf[2][2];
#pragma unroll
    for (int qk = 0; qk < 2; ++qk) { const int qi = qhalf * 32 + qk * 16 + r, tpos = qs * 64 + qi; const bf16_t* qp = PR + (size_t)(qrow0 + qi) * NREST + PR_AQ + head * 64;
#pragma unroll
        for (int ks = 0; ks < 2; ++ks) { const int d0 = 32 * ks + 8 * quad; float own[8], par[8], o[8]; unpack8(ldg16(qp + d0), own); unpack8(ldg16(qp + (d0 ^ 16)), par);
            if (!isctx) { const int pos = ks == 0 ? (tpos >> 6) : (tpos & 63); const LAS float* rp = ropel + (pos * 16 + 8 * (quad & 1)) * 2;
#pragma unroll
                for (int j = 0; j < 8; ++j) { const float c = rp[2 * j], sn = rp[2 * j + 1]; o[j] = (quad < 2) ? own[j] * c - par[j] * sn : par[j] * sn + own[j] * c; } }
            else {
#pragma unroll
                for (int j = 0; j < 8; ++j) o[j] = own[j]; }
#pragma unroll
            for (int j = 0; j < 8; ++j) o[j] *= 0.18033688011112042f;
            qf[qk][ks] = __builtin_bit_cast(bf16x8, pack8(o)); } }
    float mrun[2], lsum[2]; f32x4 acc[2][4];
    const float sinkl = sink * 1.4426950408889634f;
#pragma unroll
    for (int qk = 0; qk < 2; ++qk) { mrun[qk] = sinkl; lsum[qk] = 0.f;
#pragma unroll
        for (int db = 0; db < 4; ++db) acc[qk][db] = (f32x4){0.f, 0.f, 0.f, 0.f}; }
    const int ntile = isctx ? 2 : 5; const int ltm = 4 * quad - r - 32 * qhalf;
    const unsigned vmask = isctx ? 3u : (3u | (qb >= 1 ? 4u : 0u) | 8u | (qb <= 62 ? 16u : 0u));
#pragma unroll 1
    for (int tile = 0; tile < ntile; ++tile) {
        if (!((vmask >> tile) & 1u)) continue;
        int kb = 0, base = 0; bool band = false;
        if (tile >= 2) { kb = qb + tile - 3; band = true; base = 128 * kb - 64 * qs; }
        __syncthreads();
        *(LAS u32x4*)(Ks + skey * 72 + sa * 32 + sfh * 8) = pk1; *(LAS u32x4*)(Ks + skey * 72 + sa * 32 + 16 + sfh * 8) = pk2v;
        { const int CH = tid >> 6, kc2 = 2 * (tid & 63); *(LAS unsigned*)(Vt + ((CH) * 8 + 0) * 136 + kc2) = (pv0.x & 0xffffu) | (pv1.x << 16); *(LAS unsigned*)(Vt + ((CH) * 8 + 1) * 136 + kc2) = (pv0.x >> 16) | (pv1.x & 0xffff0000u); *(LAS unsigned*)(Vt + ((CH) * 8 + 2) * 136 + kc2) = (pv0.y & 0xffffu) | (pv1.y << 16); *(LAS unsigned*)(Vt + ((CH) * 8 + 3) * 136 + kc2) = (pv0.y >> 16) | (pv1.y & 0xffff0000u); *(LAS unsigned*)(Vt + ((CH) * 8 + 4) * 136 + kc2) = (pv0.z & 0xffffu) | (pv1.z << 16); *(LAS unsigned*)(Vt + ((CH) * 8 + 5) * 136 + kc2) = (pv0.z >> 16) | (pv1.z & 0xffff0000u); *(LAS unsigned*)(Vt + ((CH) * 8 + 6) * 136 + kc2) = (pv0.w & 0xffffu) | (pv1.w << 16); *(LAS unsigned*)(Vt + ((CH) * 8 + 7) * 136 + kc2) = (pv0.w >> 16) | (pv1.w & 0xffff0000u); }
        __syncthreads();
        { int nx = tile + 1; while (nx < ntile && !((vmask >> nx) & 1u)) ++nx; if (nx < ntile) ATT_LOAD(nx); }
        const bool domask = band && base != 0 && base != -64;
        f32x4 T[2][8];
#pragma unroll
        for (int kt = 0; kt < 8; ++kt) { f32x4 a0 = {0.f, 0.f, 0.f, 0.f}, a1 = {0.f, 0.f, 0.f, 0.f};
#pragma unroll
            for (int ks = 0; ks < 2; ++ks) { const bf16x8 kf = *(const LAS bf16x8*)(Ks + (16 * kt + r) * 72 + 32 * ks + 8 * quad); a0 = MFMA16(kf, qf[0][ks], a0); a1 = MFMA16(kf, qf[1][ks], a1); }
            T[0][kt] = a0; T[1][kt] = a1; }
        bf16x8 pf[2][4];
#pragma unroll
        for (int qk = 0; qk < 2; ++qk) {
            if (domask) {
#pragma unroll
                for (int kt = 0; kt < 8; ++kt)
#pragma unroll
                    for (int j = 0; j < 4; ++j) { const int dlt = base + (16 * kt + j - 16 * qk) + ltm; if (dlt > 128 || dlt < -128) T[qk][kt][j] = -8e30f; }
            }
            float tmax = -1e30f;
#pragma unroll
            for (int kt = 0; kt < 8; ++kt)
#pragma unroll
                for (int j = 0; j < 4; ++j) tmax = fmaxf(tmax, T[qk][kt][j]);
            tmax = fmaxf(tmax, lshfl(tmax, lane ^ 16)); tmax = fmaxf(tmax, lshfl(tmax, lane ^ 32));
            const float mnew = fmaxf(mrun[qk], tmax), alpha = __builtin_amdgcn_exp2f(mrun[qk] - mnew); mrun[qk] = mnew;
            float psum = 0.f;
#pragma unroll
            for (int kt = 0; kt < 8; ++kt)
#pragma unroll
                for (int j = 0; j < 4; ++j) { const float pv = __builtin_amdgcn_exp2f(T[qk][kt][j] - mnew); T[qk][kt][j] = pv; psum += pv; }
            lsum[qk] = lsum[qk] * alpha + psum;
#pragma unroll
            for (int db = 0; db < 4; ++db) acc[qk][db] = acc[qk][db] * alpha;
#pragma unroll
            for (int st = 0; st < 4; ++st) { float p[8];
#pragma unroll
                for (int j = 0; j < 4; ++j) { p[j] = T[qk][2 * st][j]; p[4 + j] = T[qk][2 * st + 1][j]; }
                pf[qk][st] = __builtin_bit_cast(bf16x8, pack8(p)); }
        }
#pragma unroll
        for (int st = 0; st < 4; ++st)
#pragma unroll
            for (int db = 0; db < 4; ++db) { const s16x4 lo = *(const LAS s16x4*)(Vt + (16 * db + r) * 136 + 32 * st + 4 * quad), hi = *(const LAS s16x4*)(Vt + (16 * db + r) * 136 + 32 * st + 16 + 4 * quad);
                const bf16x8 vf = __builtin_shufflevector(lo, hi, 0, 1, 2, 3, 4, 5, 6, 7);
                acc[0][db] = MFMA16(vf, pf[0][st], acc[0][db]); acc[1][db] = MFMA16(vf, pf[1][st], acc[1][db]); }
    }
    bf16_t* yc = (bf16_t*)(V.big + B_YSB + 1 * YS_STRIDE);
#pragma unroll
    for (int qk = 0; qk < 2; ++qk) { const int qi = qhalf * 32 + qk * 16 + r; float lt = lsum[qk]; lt += lshfl(lt, lane ^ 16); lt += lshfl(lt, lane ^ 32); lt += __builtin_amdgcn_exp2f(sinkl - mrun[qk]);
        const float inv = __builtin_amdgcn_rcpf(lt);
        u32x2 wve = {0u, 0u};
#pragma unroll
        for (int db = 0; db < 4; ++db) { const f32x4 o = acc[qk][db] * inv; u32x2 wv; wv.x = pk2(o[0], o[1]); wv.y = pk2(o[2], o[3]);
            if ((db & 1) == 0) wve = wv;
            else { const u32x4 wq = widen16(wve, wv); const int odd = quad & 1;
                *(u32x4*)(yc + (size_t)(qrow0 + qi) * 512 + head * 64 + 16 * (db - 1 + odd) + 4 * (quad - odd)) = wq; } } }
#undef ATT_LOAD
}
__device__ __forceinline__ void seq_of_row(int row0, int& seqbase, int& T) { seqbase = row0 < ML ? (row0 & ~(SEQ - 1)) : ML + ((row0 - ML) & ~(CTX - 1)); T = row0 < ML ? SEQ : CTX; }
__device__ __forceinline__ void pool_tasks(const Frame& F, const PView& V, int Mrows) {
    const bf16_t* PR = (const bf16_t*)(V.big + B_PREST); bf16_t* yb = (bf16_t*)(V.big + B_YSB + 0 * YS_STRIDE);
    const int ntask = (Mrows / 8) * 64;
#pragma unroll 1
    for (int t = F.bid * 512 + F.tid; t < ntask; t += F.G * 512) {
        const int cg = t & 15, rbl = (t >> 4) & 3, g = (t >> 6) & 3, rb = ((t >> 8) << 2) + rbl, half = 1 << g;
        const int row0 = rb * 8; int seqbase, T; seq_of_row(row0, seqbase, T); const int t0 = row0 - seqbase;
        const bf16_t* base = PR + (size_t)row0 * NREST + PR_POOL + (g * 16 + cg) * 8;
        u32x4 rw[24];
#pragma unroll
        for (int i = 0; i < 24; ++i) { const int tt = t0 - half + i; rw[i] = (u32x4){0u, 0u, 0u, 0u};
            if (i < 8 + 2 * half && tt >= 0 && tt < T) rw[i] = ldg16(base + (ptrdiff_t)(i - half) * NREST); }
        float sum[8];
#pragma unroll
        for (int j = 0; j < 8; ++j) sum[j] = 0.f;
#pragma unroll
        for (int i = 0; i < 16; ++i) if (i < 2 * half) { float f[8]; unpack8(rw[i], f);
#pragma unroll
            for (int j = 0; j < 8; ++j) sum[j] += f[j]; }
#pragma unroll
        for (int i = 0; i < 8; ++i) {
            const int tc = t0 + i, lo = tc - half < 0 ? 0 : tc - half, hi = tc + half > T ? T : tc + half; const float inv = __builtin_amdgcn_rcpf((float)(hi - lo));
            float c[8], o[8];
            if (g == 0) unpack8(rw[i + 1], c); else if (g == 1) unpack8(rw[i + 2], c); else if (g == 2) unpack8(rw[i + 4], c); else unpack8(rw[i + 8], c);
#pragma unroll
            for (int j = 0; j < 8; ++j) o[j] = sum[j] * inv - c[j];
            *(u32x4*)(yb + (size_t)(row0 + i) * 512 + (g * 16 + cg) * 8) = pack8(o);
            if (i < 7) { float fa[8], fs[8]; unpack8(rw[i], fs);
                if (g == 0) unpack8(rw[i + 2], fa); else if (g == 1) unpack8(rw[i + 4], fa); else if (g == 2) unpack8(rw[i + 8], fa); else unpack8(rw[i + 16], fa);
#pragma unroll
                for (int j = 0; j < 8; ++j) sum[j] += fa[j] - fs[j]; }
        }
    }
}
__device__ __forceinline__ void sconv_tasks(const Frame& F, const PView& V, int l, int Mrows) {
    const bf16_t* PR = (const bf16_t*)(V.big + B_PREST); bf16_t* yd = (bf16_t*)(V.big + B_YSB + 2 * YS_STRIDE);
    const int ntask = (Mrows / 8) * 64;
#pragma unroll 1
    for (int t = F.bid * 512 + F.tid; t < ntask; t += F.G * 512) {
        const int chunk = t & 63, rb = t >> 6; const int row0 = rb * 8; int seqbase, T; seq_of_row(row0, seqbase, T); const int t0 = row0 - seqbase;
        const float* cw = V.in(13) + (size_t)l * 1536 + chunk * 8;
        const bf16_t* base = PR + (size_t)row0 * NREST + chunk * 8;
        u32x4 cr[10], xr[10], br[8];
#pragma unroll
        for (int i = 0; i < 10; ++i) { const int tt = t0 - 1 + i; cr[i] = (u32x4){0u, 0u, 0u, 0u}; xr[i] = cr[i];
            if (tt >= 0 && tt < T) { cr[i] = ldg16(base + (ptrdiff_t)(i - 1) * NREST + PR_SC); xr[i] = ldg16(base + (ptrdiff_t)(i - 1) * NREST + PR_SX); } }
#pragma unroll
        for (int i = 0; i < 8; ++i) br[i] = ldg16(base + (size_t)i * NREST + PR_SB);
        float w0[8], w1[8], w2[8];
#pragma unroll
        for (int j = 0; j < 8; ++j) { w0[j] = cw[j]; w1[j] = cw[512 + j]; w2[j] = cw[1024 + j]; }
        float pa[8], pb[8], pc[8], c[8], x[8];
        unpack8(cr[0], c); unpack8(xr[0], x);
#pragma unroll
        for (int j = 0; j < 8; ++j) pa[j] = c[j] * x[j];
        unpack8(cr[1], c); unpack8(xr[1], x);
#pragma unroll
        for (int j = 0; j < 8; ++j) pb[j] = c[j] * x[j];
#pragma unroll
        for (int i = 0; i < 8; ++i) { unpack8(cr[i + 2], c); unpack8(xr[i + 2], x); float bv[8], o[8]; unpack8(br[i], bv);
#pragma unroll
            for (int j = 0; j < 8; ++j) { pc[j] = c[j] * x[j]; o[j] = bv[j] * (w0[j] * pa[j] + w1[j] * pb[j] + w2[j] * pc[j]); pa[j] = pb[j]; pb[j] = pc[j]; }
            *(u32x4*)(yd + (size_t)(row0 + i) * 512 + chunk * 8) = pack8(o); }
    }
}
constexpr int PH_PER_LAYER = 16, N_PHASES = 2 + DEPTH * PH_PER_LAYER - 1;
constexpr int F3C_WGS = ((MT - ML) / 256) * 4;
constexpr size_t B_FXB = B_FX + (size_t)MT * 1024 * 2;
static_assert((DFF / 2) % 128 == 0, "K halves of the down projection");
__device__ __forceinline__ void ph_prologue(Frame F0) { const Frame F = uniform_frame(F0); const PView V = pview(F);
    if (F.G > 192) { if (F.bid < 96) mod_unit(F, V, 0, F.bid); }
    else for (int u = F.bid; u < DEPTH * 96; u += F.G) mod_unit(F, V, u / 96, u % 96);
    if (F.bid == F.G - 1) rope_table(F, V);
    if (F.G > 192) { if (F.bid >= 96) prep_weights(F, V, 0, 0, PREP_NT, F.bid - 96, F.G - 96, true); }
    else prep_weights(F, V, 0, 0, PREP_NT, F.bid, F.G, true);
}
__device__ __forceinline__ void ph_rows(Frame F0, int kind, int l) { const Frame F = uniform_frame(F0); const PView V = pview(F); kind = RFL(kind); l = RFL(l);
    const float* modall = (const float*)(V.ws + WS_MOD); const float* modl = modall + (size_t)l * 5 * 6144; const float* ng = V.in(6) + (size_t)l * 4 * 1024;
    bf16_t* U = (bf16_t*)V.out; unsigned char* U8 = (unsigned char*)V.out + OUT_U8; bf16_t* X = (bf16_t*)(V.ws + WS_X);
    float* H = (float*)(V.ws + WS_H); const bool ctx_out = l < DEPTH - 1;
    if (kind == 0) rows_phase(F, V, MT, V.in(0), true, V.in(2), X, false, H, nullptr, nullptr, nullptr, 0, true, ng, modl, 0, 1, U, F.bid, F.G, 0, 2, nullptr, U8);
    else if (kind == 1) { const int skip = ctx_out ? F3C_WGS : 0;
        if (F.bid >= skip) rows_phase(F, V, ML, X, false, H, X, false, H, (const bf16_t*)(V.big + B_MX), ng + 1024, modl, 2, true, ng + 2048, modl, 3, 4, U, F.bid - skip, F.G - skip, 0, 1); }
    else if (kind == 4) rows_phase(F, V, MT, X, false, H, X, false, H, (const bf16_t*)(V.big + B_MX), ng + 1024, modl, 2, true, ng + 2048, modl, 3, 4, U, F.bid, F.G, 1, 2);
    else if (kind == 2) { const int skip = ctx_out ? 2 * F3C_WGS : 0;
        if (F.bid >= skip) rows_phase(F, V, ML, X, false, H, ctx_out ? (void*)X : (void*)V.out, !ctx_out, H, (const bf16_t*)(V.big + B_FX), ng + 3072, modl, 5, ctx_out, ng + 4096, modl + 5 * 6144, 0, 1, U, F.bid - skip, F.G - skip, 0, 1, nullptr, U8); }
    else rows_phase(F, V, MT, X, false, H, X, false, H, (const bf16_t*)(V.big + B_FX), ng + 3072, modl, 5, true, ng + 4096, modl + 5 * 6144, 0, 1, U, F.bid, F.G, 1, 2, (const bf16_t*)(V.big + B_FXB), U8);
}
__device__ __forceinline__ void ph_gemm_store(Frame F0, int which, int l) { const Frame F = uniform_frame(F0); const PView V = pview(F); which = RFL(which); l = RFL(l);
    unsigned char* ws = V.ws; unsigned char* big = V.big; const char* U = (const char*)V.out; const int nMr = (l < DEPTH - 1 ? MT : ML) / 256;
    pg8::Sched S; pg8::EpiStore E; int K = 1024;
    S.A0 = U; S.A1 = U; S.A2 = U; S.A3 = U; S.lda = 1024; S.ldb = 1024; S.G = F.G; S.c = F.bid;
    if (which == 0) { S.B = (const char*)(ws + W_LSTM); S.nM = MT / 256; S.nN = NLSTM / 256; S.grp = S.nN; E.O = (bf16_t*)(big + B_PLSTM); E.ldc = NLSTM; }
    else if (which == 1 || which == 9) { S.B = (const char*)(ws + W_REST); S.nM = MT / 256; S.nN = NREST / 256; S.grp = S.nN; E.O = (bf16_t*)(big + B_PREST); E.ldc = NREST;
        const int nb1 = ((MT / 256) * (NLSTM / 256)) % F.G, b2a = nb1 == 0 ? 0 : F.G - nb1;
        if (which == 9) { S.G = 1 << 20; S.c = F.bid >= nb1 && nb1 > 0 ? F.bid - nb1 : (1 << 20); } else S.c = F.bid + b2a; }
    else if (which == 2) { const char* ys = (const char*)(big + B_YSB); S.A0 = (const char*)(big + B_YSA); S.A1 = ys; S.A2 = ys + YS_STRIDE; S.A3 = ys + 2 * YS_STRIDE; S.B = (const char*)(ws + W_B); S.lda = 512; S.ldb = 512;
        S.nM = nMr; S.nN = 16; S.grp = 4; E.O = (bf16_t*)(big + B_PROJ); E.ldc = PROJ_LD; K = 512; }
    else if (which == 3 || which == 8) { const size_t p0 = which == 8 ? (size_t)ML : 0;
        const char* a = (const char*)(big + B_MERGED) + p0 * 1024 * 2; S.A0 = a; S.A1 = a; S.A2 = a; S.A3 = a; S.B = (const char*)(ws + W_O); S.nM = which == 8 ? (MT - ML) / 256 : ML / 256; S.nN = 4; S.grp = 4; E.O = (bf16_t*)(big + B_MX) + p0 * 1024; E.ldc = 1024; }
    else { const size_t p0 = which == 7 ? (size_t)ML : 0;
        const int half = (which == 7 && F.bid < 2 * F3C_WGS) ? F.bid / F3C_WGS : 0; const size_t koff = (size_t)half * (DFF / 2) * 2;
        const char* a = (const char*)(big + B_ACT) + p0 * DFF * 2 + koff; S.A0 = a; S.A1 = a; S.A2 = a; S.A3 = a; S.B = (const char*)(ws + W_DN) + koff; S.lda = DFF; S.ldb = DFF; S.nM = which == 7 ? (MT - ML) / 256 : ML / 256; S.nN = 4; S.grp = 4;
        E.O = (bf16_t*)(big + B_FX) + p0 * 1024 + (size_t)half * (B_FXB - B_FX - (size_t)ML * 1024 * 2) / 2; E.ldc = 1024; K = which == 7 ? DFF / 2 : DFF;
        if (which == 7) S.c = F.bid < 2 * F3C_WGS ? F.bid % F3C_WGS : F.bid; }
    pg8::gemm_phase(F.lds, F.tid, K, S, E);
    if (which == 2) { const Frame F2 = uniform_frame(F0); const int nbusy = (S.nM * S.nN) % F2.G;
        if (l < DEPTH - 1 && nbusy > 0 && F2.G > 192 && F2.G - nbusy >= 2 * 96) {
            if (F2.bid >= nbusy && F2.bid < nbusy + 96) mod_unit(F2, V, l + 1, F2.bid - nbusy);
            else if (F2.bid >= nbusy + 96 && l > 0) prep_weights(F2, V, l, PREP_T4, PREP_T5, F2.bid - nbusy - 96, F2.G - nbusy - 96, false); }
        else { if (l > 0) tail_prep(F2, V, l, S.nM * S.nN, PREP_T4, PREP_T5, 0, 0, false);
            if (l < DEPTH - 1 && F2.G > 192) for (int u = F2.bid; u < 96; u += F2.G) mod_unit(F2, V, l + 1, u); } }
}
__device__ __forceinline__ void ph_gemm_ffn(Frame F0, int l) { const Frame F = uniform_frame(F0); const PView V = pview(F); l = RFL(l);
    const char* U = (const char*)V.out; const int nMr = (l < DEPTH - 1 ? MT : ML) / 256;
    pg8::Sched S{U, U, U, U, (const char*)(V.ws + W_UP), 1024, 1024, nMr, 22, 22, F.G, F.bid};
    pg8::EpiFfn E{(bf16_t*)(V.big + B_ACT), (float*)(V.big + B_HB), V.in(17) + (size_t)l * 3 * 5632, (LAS float*)(F.lds + 132096)};
    pg8::gemm_phase(F.lds, F.tid, 1024, S, E);
    if (l > 0) tail_prep(uniform_frame(F0), V, l, S.nM * S.nN, PREP_T5, PREP_NT, 0, 0, false);
    if (l < DEPTH - 1) tail_prep(uniform_frame(F0), V, l + 1, S.nM * S.nN, PREP_T1, PREP_T2, PREP_T3, PREP_T4, false);
}
__device__ __forceinline__ void ph_ffn_fix(Frame F0, int l) { const Frame F = uniform_frame(F0); const PView V = pview(F); l = RFL(l);
    const int nMr = (l < DEPTH - 1 ? MT : ML) / 256; const float* HB = (const float*)(V.big + B_HB); bf16_t* act = (bf16_t*)(V.big + B_ACT); const float* cw = V.in(17) + (size_t)l * 3 * 5632;
    const int ntask = nMr * 2 * 352;
#pragma unroll 1
    for (int t = F.bid * 512 + F.tid; t < ntask; t += F.G * 512) { const int chunk = t % 352, q = t / 352, which = q & 1, pm = q >> 1, c0 = chunk * 8;
        const bool first = pm >= 128 || (pm & 31) == 0, last = pm >= 128 || (pm & 31) == 31;
        const float* hp = HB + (size_t)pm * 4 * 5632;
        const float* rp = which == 0 ? (first ? nullptr : hp - 5632) : hp + 2 * 5632;
        const float* rc = which == 0 ? hp : hp + 3 * 5632;
        const float* rn = which == 0 ? hp + 5632 : (last ? nullptr : hp + 4 * 5632);
        float o[8];
#pragma unroll
        for (int half = 0; half < 2; ++half) { float res[2][4];
#pragma unroll
            for (int bj = 0; bj < 2; ++bj) { const int col = bj * 2816 + c0 + 4 * half; const f32x4 z = {0.f, 0.f, 0.f, 0.f};
                const f32x4 p = rp ? *(const f32x4*)(rp + col) : z, c = *(const f32x4*)(rc + col), n = rn ? *(const f32x4*)(rn + col) : z;
                const f32x4 w0 = *(const f32x4*)(cw + col), w1 = *(const f32x4*)(cw + 5632 + col), w2 = *(const f32x4*)(cw + 2 * 5632 + col);
#pragma unroll
                for (int j = 0; j < 4; ++j) res[bj][j] = w0[j] * p[j] + w1[j] * c[j] + w2[j] * n[j]; }
#pragma unroll
            for (int j = 0; j < 4; ++j) o[4 * half + j] = siluf_(res[0][j]) * res[1][j]; }
        *(u32x4*)(act + (size_t)(pm * 256 + (which ? 255 : 0)) * DFF + c0) = pack8(o); }
}
__device__ __forceinline__ void ph_gemm_merge(Frame F0, int l) { const Frame F = uniform_frame(F0); const PView V = pview(F); l = RFL(l);
    const char* U = (const char*)V.out; const int nMr = (l < DEPTH - 1 ? MT : ML) / 256;
    const char* U8 = (const char*)V.out + OUT_U8;
    pg8::Sched S{U8, U8, U8, U8, (const char*)(V.ws + W_GATE), 512, 512, nMr, 16, 16, F.G, F.bid};
    pg8::EpiMerge E{(const bf16_t*)(V.big + B_PROJ), (bf16_t*)(V.big + B_MERGED)}; pg8::gemm_phase(F.lds, F.tid, 512, S, E);
    if (l < DEPTH - 1) tail_prep(uniform_frame(F0), V, l + 1, S.nM * S.nN, 0, PREP_T1, PREP_T2, PREP_T3, true);
}
__device__ __forceinline__ void ph_pass1(Frame F0, int l) { const Frame F = uniform_frame(F0); const PView V = pview(F); l = RFL(l);
    for (int u = F.G - 1 - F.bid; u < NCHAIN_UNITS / 2; u += F.G) lstm_pass1_unit(unit_frame(F), V, l, u); }
__device__ __forceinline__ void ph_scan(Frame F0) { const Frame F = uniform_frame(F0); const PView V = pview(F); lstm_scan(F, V); krope_tasks(uniform_frame(F0), V); }
__device__ __forceinline__ void ph_pass2(Frame F0, int l) { const Frame F = uniform_frame(F0); const PView V = pview(F); l = RFL(l);
    const int nlat = NB * 4 * 32 * 2, nu = nlat + ((l < DEPTH - 1) ? NB * 4 * 2 : 0);
    for (int u = F.bid; u < nu; u += F.G) { const int qh = u & 1; int blk, bh;
        if (u < nlat) { const int r = u >> 1; blk = 1 + (r & 31); bh = r >> 5; } else { blk = 0; bh = (u - nlat) >> 1; }
        lstm_pass2_unit(unit_frame(F), V, l, bh >> 2, bh & 3, blk, qh); } }
__device__ __forceinline__ void ph_attn(Frame F0, int l) { const Frame F = uniform_frame(F0); const PView V = pview(F); l = RFL(l);
    { const f32x4* rt = (const f32x4*)(V.ws + WS_ROPE); LAS f32x4* rl = (LAS f32x4*)(F.lds + 36864); __syncthreads(); rl[F.tid] = rt[F.tid]; rl[512 + F.tid] = rt[512 + F.tid]; __syncthreads(); }
    const int nlat = NB * 2 * 128, nctx = (l < DEPTH - 1) ? NB * 2 * 4 : 0;
    for (int u = F.bid; u < nlat; u += F.G) attn_unit(unit_frame(F), V, l, false, u >> 8, (u >> 7) & 1, u & 127);
    for (int q = F.G - 1 - F.bid; q < nctx; q += F.G) attn_unit(unit_frame(F), V, l, true, q >> 3, (q >> 2) & 1, q & 3); }
__device__ __forceinline__ void ph_poolconv(Frame F0, int l) { const Frame F = uniform_frame(F0); const PView V = pview(F); l = RFL(l);
    const int Mrows = (l < DEPTH - 1) ? MT : ML; pool_tasks(F, V, Mrows); sconv_tasks(F, V, l, Mrows); }

__global__ void __launch_bounds__(512, 2) fwd(Params P) {
    extern __shared__ __attribute__((aligned(16))) unsigned char lds_raw[];
    Frame F; F.lds = (LAS unsigned char*)lds_raw; F.wave = __builtin_amdgcn_readfirstlane((int)threadIdx.x >> 6); F.tid = 0; F.lane = 0; F.G = gridDim.x; F.bid = blockIdx.x; F.P = &P;
    volatile LAS unsigned* ctlw = (volatile LAS unsigned*)(F.lds + LDS_WORK);
    { const int t0 = F.wave * 64 + hw_lane(); if (t0 < 16) ctlw[t0] = 0u; }
    __syncthreads();
    const size_t bar_off = WS_CTL + (size_t)P.bar_region * 16384;
    XcdBarrier bar; bar.bar = (unsigned*)(P.ws + bar_off); bar.x = 0; bar.st = ctlw;
    const int lo = P.ph_lo, hi = P.ph_hi;
    if (hi - lo > 1) bar = xcd_barrier_post((unsigned*)(P.ws + bar_off), ctlw, F.wave == 0 && hw_lane() == 0);
#define IN(k) (lo <= (k) && (k) < hi)
#pragma unroll 1
    for (int step = lo; step < hi; ++step) {
        const int l = step < 2 ? 0 : (step - 2) / PH_PER_LAYER, k = step < 2 ? step - 2 : (step - 2) % PH_PER_LAYER;
        if (l == DEPTH - 1 && k == 10) continue;
        switch (k) {
            case -2: if (KON(0)) ph_prologue(F); break;
            case -1: if (KON(1)) ph_rows(F, 0, 0); break;
            case 0: case 1: case 2: case 6: case 8: case 9: case 13: case 14:
                if (k == 2 && KON(3)) ph_pass1(F, l);
                if (KON(2) && !((k == 9 || k == 14) && l == DEPTH - 1)) ph_gemm_store(F, k == 0 ? 0 : (k == 1 ? 9 : (k == 2 ? 1 : (k == 6 ? 2 : (k == 8 ? 3 : (k == 9 ? 8 : (k == 13 ? 6 : 7)))))), l);
                if ((k == 9 || k == 14) && KON(1)) ph_rows(F, k == 9 ? 1 : 2, l);
                break;
            case 11: if (KON(8)) ph_gemm_ffn(F, l); break;
            case 12: if (KON(8)) ph_ffn_fix(F, l); break;
            case 3: if (KON(4)) ph_scan(F); break;
            case 4: if (KON(5)) ph_pass2(F, l); break;
            case 5: if (KON(6)) ph_attn(F, l); if (KON(9)) ph_poolconv(F, l); break;
            case 7: if (KON(7)) ph_gemm_merge(F, l); break;
            default: if (KON(1)) ph_rows(F, k == 10 ? 4 : 3, l); break;
        }
        if (k == 0) continue;
        if (step + 1 < hi) { unsigned long long bp = (unsigned long long)(P.ws + bar_off); asm volatile("" : "+v"(bp)); bar.bar = (unsigned*)bp; xcd_barrier(bar, F.wave == 0 && hw_lane() == 0); }
    }
#undef IN
}

extern "C" void kernel_launch(void* const* d_in, const int* in_sizes, int n_in, void* d_out, int out_size, void* d_ws, size_t ws_size, hipStream_t stream) {
    static int grid = 0;
    if (grid == 0) {
        if (n_in != 19 || out_size != ML * D || ws_size < WS_END) { fprintf(stderr, "kernel_launch: need 19 inputs, out %d, ws >= %zu; got %d, %d, %zu\n", ML * D, (size_t)WS_END, n_in, out_size, ws_size); grid = -1; return; }
        int dev = 0, cus = 0, per_cu = 0;
        if (hipGetDevice(&dev) != hipSuccess || hipDeviceGetAttribute(&cus, hipDeviceAttributeMultiprocessorCount, dev) != hipSuccess) { grid = -1; return; }
        if (hipFuncSetAttribute((const void*)fwd, hipFuncAttributeMaxDynamicSharedMemorySize, LDS_BYTES) != hipSuccess) { fprintf(stderr, "kernel_launch: hipFuncSetAttribute failed\n"); grid = -1; return; }
        if (hipOccupancyMaxActiveBlocksPerMultiprocessor(&per_cu, (const void*)fwd, 512, LDS_BYTES) != hipSuccess || per_cu < 1) { fprintf(stderr, "kernel_launch: occupancy query says %d\n", per_cu); (void)hipGetLastError(); }
        grid = cus;
    }
    if (grid < 0) return;
    (void)hipMemsetAsync((char*)d_ws + WS_CTL, 0, 131072, stream);
    Params p{};
    for (int i = 0; i < 19; ++i) p.in[i] = (const float*)d_in[i];
    p.out = (float*)d_out; p.ws = (unsigned char*)d_ws;
#if MK_PER_PHASE
    for (int k = 0; k < N_PHASES; ++k) { p.ph_lo = k; p.ph_hi = k + 1; hipLaunchKernelGGL(fwd, dim3(grid), dim3(512), LDS_BYTES, stream, p); }
#elif defined(PROBE_K)
    { int lo = 0, reg = 0;
      for (int l = 0; l < DEPTH; ++l) { const int st = (PROBE_K < 0) ? PROBE_K + 2 : 2 + l * PH_PER_LAYER + PROBE_K; if (PROBE_K < 0 && l > 0) break;
          p.ph_lo = lo; p.ph_hi = st + 1; p.bar_region = reg++; hipLaunchKernelGGL(fwd, dim3(grid), dim3(512), LDS_BYTES, stream, p);
          for (int r = 0; r < PROBE_R; ++r) { p.ph_lo = st; p.ph_hi = st + 1; p.bar_region = 7; hipLaunchKernelGGL(fwd, dim3(grid), dim3(512), LDS_BYTES, stream, p); }
          lo = st + 1; }
      if (lo < N_PHASES) { p.ph_lo = lo; p.ph_hi = N_PHASES; p.bar_region = reg++; hipLaunchKernelGGL(fwd, dim3(grid), dim3(512), LDS_BYTES, stream, p); } }
#else
    p.ph_lo = 0; p.ph_hi = N_PHASES; p.bar_region = 0;
    hipLaunchKernelGGL(fwd, dim3(grid), dim3(512), LDS_BYTES, stream, p);
#endif
}
```
